# Optimizing an MI355X kernel written in HIP

```python
import jax, jax.numpy as jnp
from jax import lax
import numpy as np

D_MODEL = 1024
BATCH = 8
SEQ = 4096
DEPTH = 2

CTX_LEN = 256
GRID_W = 64

RNN_WIDTH = 1024
RNN_HEADS = 8
RNN_BLOCK = RNN_WIDTH // RNN_HEADS
CONV_WIDTH = 4
CONV_LEFT = 2
LRU_C = 8.0

FOURIER_WIDTH = 512
FOURIER_GROUPS = 4
FOURIER_GROUP_DIM = FOURIER_WIDTH // FOURIER_GROUPS

N_BRANCHES = 2
IN_PROJ_WIDTH = 2 * RNN_WIDTH + FOURIER_WIDTH + N_BRANCHES * D_MODEL

N_EXPERTS = 16
N_EXPERT_GROUPS = 4
EXPERTS_PER_GROUP = N_EXPERTS // N_EXPERT_GROUPS
TOP_K = 2
D_EXPERT = 1024

N_MOD = 6
RMS_EPS = 1e-6

kernel_name = "hybrid_rglru_fourier_grouped_moe_dit"


def rms_norm(x, g):
    xf = x.astype(jnp.float32)
    y = xf * lax.rsqrt(jnp.mean(xf * xf, axis=-1, keepdims=True) + RMS_EPS)
    return (y * g.astype(jnp.float32)).astype(x.dtype)


def modulate(x, shift, scale):
    return x * (1 + scale) + shift


def centred_dwconv(u, w, b):
    L = u.shape[-2]
    pad = [(0, 0)] * (u.ndim - 2) + [(CONV_LEFT, CONV_WIDTH - 1 - CONV_LEFT), (0, 0)]
    up = jnp.pad(u, pad)
    out = b
    for k in range(CONV_WIDTH):
        out = out + up[..., k:k + L, :] * w[k]
    return out


def conv_tokens(u, w, b, on_grid):
    if on_grid:
        n_b, n_tok, ch = u.shape
        rows = n_tok // GRID_W
        return centred_dwconv(u.reshape(n_b, rows, GRID_W, ch), w, b).reshape(n_b, n_tok, ch)
    return centred_dwconv(u, w, b)


def rglru_coeffs(u, w_a, b_a, w_x, b_x, lam):
    n_b, n_tok, _ = u.shape
    uh = u.reshape(n_b, n_tok, RNN_HEADS, RNN_BLOCK)
    r = jax.nn.sigmoid(jnp.einsum('blhi,hij->blhj', uh, w_a) + b_a).reshape(n_b, n_tok, RNN_WIDTH)
    i = jax.nn.sigmoid(jnp.einsum('blhi,hij->blhj', uh, w_x) + b_x).reshape(n_b, n_tok, RNN_WIDTH)
    log_a = -LRU_C * r.astype(jnp.float32) * jax.nn.softplus(-lam.astype(jnp.float32))
    a = jnp.exp(log_a)
    mult = jnp.sqrt(-jnp.expm1(2.0 * log_a))
    return a, mult * (i * u).astype(jnp.float32)


def linear_scan(a, b, h0):
    b = b.at[:, 0].add(a[:, 0] * h0)

    def combine(left, right):
        a_l, b_l = left
        a_r, b_r = right
        return a_l * a_r, a_r * b_l + b_r

    _, h = lax.associative_scan(combine, (a, b), axis=1)
    return h


def rglru_bidirectional(u, h0_f, h0_b, lru_f, lru_b):
    a_f, b_f = rglru_coeffs(u, *lru_f)
    h_f = linear_scan(a_f, b_f, h0_f)
    a_b, b_b = rglru_coeffs(jnp.flip(u, 1), *lru_b)
    h_b = jnp.flip(linear_scan(a_b, b_b, h0_b), 1)
    return h_f, h_b


def fourier_mix(u):
    n_b, n_tok, _ = u.shape
    ug = u.astype(jnp.float32).reshape(n_b, n_tok, FOURIER_GROUPS, FOURIER_GROUP_DIM)
    y = jnp.fft.fft2(ug, axes=(1, 3), norm="ortho").real
    return y.reshape(n_b, n_tok, FOURIER_WIDTH).astype(u.dtype)


def mixer(h, on_grid, h0_f, h0_b, w_in, conv_w, conv_b, lru_f, lru_b, w_proj_rnn, w_proj_fourier, w_out):
    proj = h @ w_in
    s1 = RNN_WIDTH
    s2 = 2 * RNN_WIDTH
    s3 = s2 + FOURIER_WIDTH
    s4 = s3 + D_MODEL
    u_rnn, u_gate, u_four, g_rnn, g_four = jnp.split(proj, [s1, s2, s3, s4], axis=-1)
    u = conv_tokens(u_rnn, conv_w, conv_b, on_grid)
    h_f, h_b = rglru_bidirectional(u, h0_f, h0_b, lru_f, lru_b)
    y_rnn = ((h_f + h_b).astype(h.dtype) * jax.nn.gelu(u_gate)) @ w_proj_rnn
    y_four = fourier_mix(u_four) @ w_proj_fourier
    merged = jax.nn.sigmoid(g_rnn) * y_rnn + jax.nn.sigmoid(g_four) * y_four
    return merged @ w_out, h_f[:, -1], h_b[:, 0]


def context_scan_states(h, w_in, conv_w, conv_b, lru_f, lru_b):
    u = conv_tokens(h @ w_in[:, :RNN_WIDTH], conv_w, conv_b, False)
    zeros = jnp.zeros((h.shape[0], RNN_WIDTH), jnp.float32)
    h_f, h_b = rglru_bidirectional(u, zeros, zeros, lru_f, lru_b)
    return h_f[:, -1], h_b[:, 0]


def grouped_moe(h, router_w, router_b, w1, w3, w2):
    n_b, n_tok, d = h.shape
    t = h.reshape(-1, d)
    n_t = t.shape[0]
    aff = jax.nn.sigmoid((t @ router_w).astype(jnp.float32))
    sel = (aff + router_b.astype(jnp.float32)).reshape(n_t, N_EXPERT_GROUPS, EXPERTS_PER_GROUP)
    group_score = lax.top_k(sel, TOP_K)[0].sum(-1)
    grp = jnp.argmax(group_score, axis=-1)
    in_group = jax.nn.one_hot(grp, N_EXPERT_GROUPS, dtype=jnp.bool_)[:, :, None]
    masked = jnp.where(in_group, sel, -jnp.inf).reshape(n_t, N_EXPERTS)
    _, expert_idx = lax.top_k(masked, TOP_K)
    w_sel = jnp.take_along_axis(aff, expert_idx, axis=1)
    w_sel = w_sel / jnp.sum(w_sel, axis=-1, keepdims=True)
    gates = jnp.sum(jax.nn.one_hot(expert_idx, N_EXPERTS, dtype=jnp.float32) * w_sel[..., None], axis=1)
    gates = gates.astype(t.dtype)
    y = jnp.zeros_like(t)
    for e in range(N_EXPERTS):
        he = jax.nn.silu(t @ w1[e]) * (t @ w3[e])
        y = y + gates[:, e:e + 1] * (he @ w2[e])
    return y.reshape(n_b, n_tok, d)


def setup_inputs(seed: int = 0) -> dict:
    key = jax.random.key(seed)
    ks = jax.random.split(key, 32)
    f32 = jnp.float32

    def nrm(k, shape, scale):
        return jax.random.normal(k, shape, f32) * scale

    u_decay = jax.random.uniform(ks[20], (DEPTH, 2, RNN_WIDTH), f32, 0.9, 0.999)
    s = u_decay ** (1.0 / LRU_C)
    lru_lambda = jnp.log(s) - jnp.log1p(-s)

    return {
        "x": nrm(ks[0], (BATCH, SEQ, D_MODEL), 1.0),
        "c": nrm(ks[1], (BATCH, D_MODEL), 1.0),
        "ctx": nrm(ks[2], (BATCH, CTX_LEN, D_MODEL), 1.0),
        "c_ctx": nrm(ks[3], (D_MODEL,), 1.0),
        "ada_w": nrm(ks[4], (DEPTH, D_MODEL, N_MOD * D_MODEL), 0.5 * D_MODEL ** -0.5),
        "ada_b": nrm(ks[5], (DEPTH, N_MOD * D_MODEL), 0.02),
        "norm_mix_g": 1.0 + nrm(ks[6], (DEPTH, D_MODEL), 0.02),
        "w_in": nrm(ks[7], (DEPTH, D_MODEL, IN_PROJ_WIDTH), D_MODEL ** -0.5),
        "conv_w": nrm(ks[8], (DEPTH, CONV_WIDTH, RNN_WIDTH), CONV_WIDTH ** -0.5),
        "conv_b": nrm(ks[9], (DEPTH, RNN_WIDTH), 0.02),
        "lru_w_a": nrm(ks[10], (DEPTH, 2, RNN_HEADS, RNN_BLOCK, RNN_BLOCK), RNN_BLOCK ** -0.5),
        "lru_b_a": nrm(ks[11], (DEPTH, 2, RNN_HEADS, RNN_BLOCK), 0.02),
        "lru_w_x": nrm(ks[12], (DEPTH, 2, RNN_HEADS, RNN_BLOCK, RNN_BLOCK), RNN_BLOCK ** -0.5),
        "lru_b_x": nrm(ks[13], (DEPTH, 2, RNN_HEADS, RNN_BLOCK), 0.02),
        "lru_lambda": lru_lambda,
        "w_proj_rnn": nrm(ks[14], (DEPTH, RNN_WIDTH, D_MODEL), RNN_WIDTH ** -0.5),
        "w_proj_fourier": nrm(ks[15], (DEPTH, FOURIER_WIDTH, D_MODEL), FOURIER_WIDTH ** -0.5),
        "w_out": nrm(ks[16], (DEPTH, D_MODEL, D_MODEL), D_MODEL ** -0.5),
        "norm_ffn_g": 1.0 + nrm(ks[17], (DEPTH, D_MODEL), 0.02),
        "router_w": nrm(ks[18], (D_MODEL, N_EXPERTS), D_MODEL ** -0.5),
        "router_b": nrm(ks[19], (N_EXPERTS,), 0.01),
        "moe_w1": nrm(ks[21], (DEPTH, N_EXPERTS, D_MODEL, D_EXPERT), D_MODEL ** -0.5),
        "moe_w3": nrm(ks[22], (DEPTH, N_EXPERTS, D_MODEL, D_EXPERT), D_MODEL ** -0.5),
        "moe_w2": nrm(ks[23], (DEPTH, N_EXPERTS, D_EXPERT, D_MODEL), D_EXPERT ** -0.5),
        "final_norm_g": 1.0 + nrm(ks[24], (D_MODEL,), 0.02),
    }


def reference(x, c, ctx, c_ctx, ada_w, ada_b, norm_mix_g, w_in, conv_w, conv_b, lru_w_a, lru_b_a,
              lru_w_x, lru_b_x, lru_lambda, w_proj_rnn, w_proj_fourier, w_out, norm_ffn_g,
              router_w, router_b, moe_w1, moe_w3, moe_w2, final_norm_g):
    h_ctx = ctx
    n_b = x.shape[0]
    zeros = jnp.zeros((n_b, RNN_WIDTH), jnp.float32)
    for l in range(DEPTH):
        last = l == DEPTH - 1
        mod_x = (jax.nn.silu(c) @ ada_w[l] + ada_b[l])[:, None, :]
        mod_c = (jax.nn.silu(c_ctx) @ ada_w[l] + ada_b[l])[None, None, :]
        sh1_x, sc1_x, g1_x, sh2_x, sc2_x, g2_x = jnp.split(mod_x, N_MOD, axis=-1)
        sh1_c, sc1_c, g1_c, sh2_c, sc2_c, g2_c = jnp.split(mod_c, N_MOD, axis=-1)
        lru_f = (lru_w_a[l, 0], lru_b_a[l, 0], lru_w_x[l, 0], lru_b_x[l, 0], lru_lambda[l, 0])
        lru_b = (lru_w_a[l, 1], lru_b_a[l, 1], lru_w_x[l, 1], lru_b_x[l, 1], lru_lambda[l, 1])

        hc = modulate(rms_norm(h_ctx, norm_mix_g[l]), sh1_c, sc1_c)
        if last:
            state_f, state_b = context_scan_states(hc, w_in[l], conv_w[l], conv_b[l], lru_f, lru_b)
        else:
            out_c, state_f, state_b = mixer(hc, False, zeros, zeros, w_in[l], conv_w[l], conv_b[l],
                                            lru_f, lru_b, w_proj_rnn[l], w_proj_fourier[l], w_out[l])
            h_ctx = h_ctx + g1_c * out_c

        hx = modulate(rms_norm(x, norm_mix_g[l]), sh1_x, sc1_x)
        out_x, _, _ = mixer(hx, True, state_f, state_b, w_in[l], conv_w[l], conv_b[l],
                            lru_f, lru_b, w_proj_rnn[l], w_proj_fourier[l], w_out[l])
        x = x + g1_x * out_x

        if not last:
            hc2 = modulate(rms_norm(h_ctx, norm_ffn_g[l]), sh2_c, sc2_c)
            h_ctx = h_ctx + g2_c * grouped_moe(hc2, router_w, router_b, moe_w1[l], moe_w3[l], moe_w2[l])
        hx2 = modulate(rms_norm(x, norm_ffn_g[l]), sh2_x, sc2_x)
        x = x + g2_x * grouped_moe(hx2, router_w, router_b, moe_w1[l], moe_w3[l], moe_w2[l])

    return rms_norm(x, final_norm_g)
```

```cpp
#include <hip/hip_runtime.h>
#include <cstdio>
#include <cstdint>

#ifndef MK_N_LAUNCHES
#define MK_N_LAUNCHES 0
#endif

#define GAS __attribute__((address_space(1)))
#define LAS __attribute__((address_space(3)))
typedef unsigned short bf16;
typedef unsigned v4u __attribute__((ext_vector_type(4)));
typedef unsigned v2u __attribute__((ext_vector_type(2)));
typedef float f32x4 __attribute__((ext_vector_type(4)));
typedef short bf16x8 __attribute__((ext_vector_type(8)));

constexpr int D = 1024, NB = 8, SEQ = 4096, CTX = 256, NL = NB * SEQ, NC = NB * CTX, NT = NL + NC;
constexpr int NPAN = NT / 256;
constexpr int INW = 4608, NE = 16, NMOD = 6;
constexpr float RMS_EPS = 1e-6f;
constexpr int NWAVES = 8, NTHR = 512;

constexpr size_t MiB = 1u << 20;
constexpr size_t WS_CTL = 0, CTL_ZERO_BYTES = 1 * MiB;
constexpr size_t WS_MODS = 1 * MiB;
constexpr size_t WS_WIN = 2 * MiB;
constexpr size_t WS_WR = 20 * MiB, WS_WF = 24 * MiB, WS_WO = 28 * MiB;
constexpr size_t WS_LRU = 32 * MiB;
constexpr size_t WS_CSC = 34 * MiB;
constexpr size_t WS_HCTX = 35 * MiB;
constexpr size_t WS_LIST = 43 * MiB;
constexpr size_t WS_CSL = 48 * MiB;
constexpr size_t WS_RA = 112 * MiB;
constexpr size_t WS_RB = 180 * MiB;
constexpr size_t WS_RC = 248 * MiB;
constexpr size_t WS_RD = 316 * MiB;
constexpr size_t WS_RE = 384 * MiB;
constexpr size_t WS_RF = 452 * MiB;
constexpr size_t WS_RG = 486 * MiB;
constexpr size_t WS_RH = 520 * MiB;
constexpr size_t WS_END = 588 * MiB;
constexpr size_t WS_MOEW = 180 * MiB;
constexpr size_t WS_HE = 276 * MiB;
constexpr size_t WS_C01 = 420 * MiB;
static_assert(WS_C01 + (size_t)2 * NT * D * 2 <= WS_END, "map");
static_assert(WS_RA + (size_t)NT * D * 2 <= WS_RB && WS_RH + (size_t)NT * D * 2 <= WS_END, "map");

constexpr int CW_TMO = 0;
constexpr int CW_CNT = 64;
constexpr int CW_BAR = 4096;

constexpr int LDS_BYTES = 147456;
constexpr int MISC_OFF = 131072 + 8192;

__device__ __forceinline__ unsigned f2bf(float f) { unsigned u = __builtin_bit_cast(unsigned, f); return (u + 0x7fffu + ((u >> 16) & 1u)) >> 16; }
__device__ __forceinline__ unsigned pk2(float lo, float hi) { return f2bf(lo) | (f2bf(hi) << 16); }
__device__ __forceinline__ float bflo(unsigned w) { return __builtin_bit_cast(float, w << 16); }
__device__ __forceinline__ float bfhi(unsigned w) { return __builtin_bit_cast(float, w & 0xffff0000u); }
__device__ __forceinline__ float bf2f(bf16 h) { return __builtin_bit_cast(float, ((unsigned)h) << 16); }
__device__ __forceinline__ v4u pack8(const float* v) { v4u o; o.x = pk2(v[0], v[1]); o.y = pk2(v[2], v[3]); o.z = pk2(v[4], v[5]); o.w = pk2(v[6], v[7]); return o; }
__device__ __forceinline__ void unpack8(v4u w, float* v) { v[0] = bflo(w.x); v[1] = bfhi(w.x); v[2] = bflo(w.y); v[3] = bfhi(w.y); v[4] = bflo(w.z); v[5] = bfhi(w.z); v[6] = bflo(w.w); v[7] = bfhi(w.w); }
__device__ __forceinline__ float sigmoidf_(float x) { return 1.f / (1.f + __expf(-x)); }
__device__ __forceinline__ float siluf_(float x) { return x / (1.f + __expf(-x)); }
__device__ __forceinline__ float gelu_tanh(float x) { const float u = 0.7978845608028654f * (x + 0.044715f * x * x * x); const float e = __expf(2.f * u); const float t = 1.f - 2.f / (e + 1.f); return 0.5f * x * (1.f + t); }
__device__ __forceinline__ float wave_sum(float v) {
#pragma unroll
    for (int o = 1; o < 64; o <<= 1) v += __shfl_xor(v, o);
    return v;
}
#define LDS_WAIT() asm volatile("s_waitcnt lgkmcnt(0)" ::: "memory")
#define VM_WAIT() asm volatile("s_waitcnt vmcnt(0)" ::: "memory")

#define XB_TMO      128
#define XB_XCNT(j)  (256  + 64 * (j))
#define XB_XSUB(j)  (1280 + 64 * (j))
#define XB_XGEN(j)  (2304 + 64 * (j))
#define XB_TOP      3328
#define XB_TOPGEN   3392
#define XCD_BAR_WORDS 3456
#define XB_SPIN_CAP (1u << 18)
__device__ __forceinline__ unsigned xb_ld(unsigned* p)              { return __hip_atomic_load(p, __ATOMIC_RELAXED, __HIP_MEMORY_SCOPE_AGENT); }
__device__ __forceinline__ unsigned xb_add(unsigned* p, unsigned v) { return __hip_atomic_fetch_add(p, v, __ATOMIC_RELAXED, __HIP_MEMORY_SCOPE_AGENT); }
__device__ __forceinline__ unsigned xb_xcc_id() { return (unsigned)__builtin_amdgcn_s_getreg((3 << 11) | 20) & 0xFu; }
#define XB_SPIN(cond, bar) do { unsigned _sp = 0; while (cond) { __builtin_amdgcn_s_sleep(1); \
    if ((++_sp & 255u) == 0u) { if (xb_ld(&(bar)[XB_TMO])) break; if (_sp > XB_SPIN_CAP) { atomicAdd(&(bar)[XB_TMO], 1u); break; } } } } while (0)
struct XcdBarrier { unsigned* bar; unsigned x; volatile LAS unsigned* st; };
__device__ __forceinline__ XcdBarrier xcd_barrier_post(unsigned* bar, volatile LAS unsigned* st) {
    XcdBarrier b; b.bar = bar; b.x = xb_xcc_id(); b.st = st;
    if (threadIdx.x == 0) (void)xb_add(&bar[XB_XCNT(b.x)], 1u);
    return b;
}
__device__ __forceinline__ void xcd_barrier_complete(unsigned* bar, unsigned x, unsigned& nloc, unsigned& nx) {
    const unsigned G = gridDim.x * gridDim.y * gridDim.z;
    unsigned sum, cnt, mine, sp = 0u;
    for (;;) {
        sum = 0u; cnt = 0u; mine = 0u;
#pragma unroll
        for (unsigned j = 0; j < 16; ++j) { const unsigned c = xb_ld(&bar[XB_XCNT(j)]); sum += c; cnt += (c > 0u) ? 1u : 0u; mine = (j == x) ? c : mine; }
        if (sum == G) break;
        __builtin_amdgcn_s_sleep(1);
        if ((++sp & 255u) == 0u) { if (xb_ld(&bar[XB_TMO])) break; if (sp > XB_SPIN_CAP) { atomicAdd(&bar[XB_TMO], 1u); break; } }
    }
    nloc = mine > 0u ? mine : 1u; nx = cnt > 0u ? cnt : 1u;
}
__device__ __forceinline__ void xcd_barrier(const XcdBarrier& b) {
    asm volatile("s_waitcnt vmcnt(0)" ::: "memory");
    __syncthreads();
    if (threadIdx.x == 0) {
        unsigned* bar = b.bar;
        __builtin_amdgcn_s_waitcnt(0);
        unsigned nloc = b.st[0], nx = b.st[1];
        if (nloc == 0u) { xcd_barrier_complete(bar, b.x, nloc, nx); b.st[0] = nloc; b.st[1] = nx; }
        const unsigned old = xb_add(&bar[XB_XSUB(b.x)], 1u);
        const unsigned gen = old / nloc;
        if (old + 1u == (gen + 1u) * nloc) {
            __builtin_amdgcn_fence(__ATOMIC_RELEASE, "agent");
            asm volatile("s_waitcnt vmcnt(0)" ::: "memory");
            const unsigned og = xb_add(&bar[XB_TOP], 1u);
            const unsigned tg = og / nx;
            if (og + 1u == (tg + 1u) * nx) xb_add(&bar[XB_TOPGEN], 1u);
            else XB_SPIN(xb_ld(&bar[XB_TOPGEN]) == tg, bar);
            __builtin_amdgcn_fence(__ATOMIC_ACQUIRE, "agent");
            xb_add(&bar[XB_XGEN(b.x)], 1u);
            asm volatile("s_waitcnt vmcnt(0)" ::: "memory");
        } else {
            XB_SPIN(xb_ld(&bar[XB_XGEN(b.x)]) == gen, bar);
            __builtin_amdgcn_fence(__ATOMIC_ACQUIRE, "agent");
            asm volatile("s_waitcnt vmcnt(0)" ::: "memory");
        }
    }
    __syncthreads();
}

struct Frame {
    LAS unsigned char* lds;
    int tid, lane, wave, G, bid;
    unsigned* ctl;
    const float* const __attribute__((address_space(4)))* kin;
    float* out;
    unsigned char* ws;
};
__device__ __forceinline__ const float* modp(const Frame& F, int l, int mb, int which) { return (const float*)(F.ws + WS_MODS) + ((size_t)(l * 9 + mb) * NMOD + which) * D; }
__device__ __forceinline__ int mb_of(int r) { return r < NL ? (r >> 12) : 8; }

struct Unit { const bf16* A; const bf16* B; int lda, ldb, K; int pm, pn, x0, x1, x2; };

template <class P> __device__ __forceinline__ void simple_gemm_phase(Frame& F, const P& p) {
    LAS float* As = (LAS float*)F.lds;
    LAS float* Bs = As + 32 * 128;
    const int tid = F.tid, rg = tid >> 4, cg = tid & 15;
    Unit u;
    for (int i = 0; p.next(i, u); ++i) {
        for (int half = 0; half < 2; ++half) {
            float acc[4][16];
#pragma unroll
            for (int a = 0; a < 4; ++a)
#pragma unroll
                for (int b = 0; b < 16; ++b) acc[a][b] = 0.f;
            const int arow_i = tid >> 2, ak = (tid & 3) * 8, brow_i = tid >> 1, bk = (tid & 1) * 16;
            const bf16* arow = p.a_row(u, half * 128 + arow_i);
            const bf16* brow = u.B + (size_t)brow_i * u.ldb;
            for (int k0 = 0; k0 < u.K; k0 += 32) {
                const v4u a0 = *(const GAS v4u*)(arow + k0 + ak);
                const v4u b0 = *(const GAS v4u*)(brow + k0 + bk), b1 = *(const GAS v4u*)(brow + k0 + bk + 8);
                __syncthreads();
                float t[8];
                unpack8(a0, t);
#pragma unroll
                for (int j = 0; j < 8; ++j) As[(ak + j) * 128 + arow_i] = t[j];
                unpack8(b0, t);
#pragma unroll
                for (int j = 0; j < 8; ++j) Bs[(bk + j) * 256 + brow_i] = t[j];
                unpack8(b1, t);
#pragma unroll
                for (int j = 0; j < 8; ++j) Bs[(bk + 8 + j) * 256 + brow_i] = t[j];
                __syncthreads();
#pragma unroll 2
                for (int k = 0; k < 32; ++k) {
                    const f32x4 x0 = *(const LAS f32x4*)(As + k * 128 + rg * 4);
                    const f32x4 y0 = *(const LAS f32x4*)(Bs + k * 256 + cg * 8), y1 = *(const LAS f32x4*)(Bs + k * 256 + cg * 8 + 4);
                    const f32x4 y2 = *(const LAS f32x4*)(Bs + k * 256 + 128 + cg * 8), y3 = *(const LAS f32x4*)(Bs + k * 256 + 128 + cg * 8 + 4);
                    const float xa[4] = {x0[0], x0[1], x0[2], x0[3]};
                    const float yb[16] = {y0[0], y0[1], y0[2], y0[3], y1[0], y1[1], y1[2], y1[3], y2[0], y2[1], y2[2], y2[3], y3[0], y3[1], y3[2], y3[3]};
#pragma unroll
                    for (int a = 0; a < 4; ++a)
#pragma unroll
                        for (int b = 0; b < 16; ++b) acc[a][b] = __builtin_fmaf(xa[a], yb[b], acc[a][b]);
                }
            }
#pragma unroll
            for (int a = 0; a < 4; ++a) p.epi(u, half * 128 + rg * 4 + a, cg * 8, &acc[a][0], &acc[a][8]);
        }
    }
    __syncthreads();
}

struct PInproj {
    int G, c, l; const bf16* hx; const bf16* wt; bf16 *urnn, *gate, *ufour, *sgr, *sgf;
    __device__ __forceinline__ bool next(int i, Unit& u) const {
        const int idx = i * G + c; if (idx >= NPAN * 18) return false;
        u.pm = idx / 18; u.pn = idx % 18; u.A = hx + (size_t)u.pm * 256 * D; u.lda = D; u.B = wt + (size_t)u.pn * 256 * D; u.ldb = D; u.K = D; return true; }
    __device__ __forceinline__ const bf16* a_row(const Unit& u, int row) const { return u.A + (size_t)row * D; }
    __device__ __forceinline__ void epi(const Unit& u, int row, int c8, const float* v0, const float* v1) const {
        const size_t r = (size_t)u.pm * 256 + row; const int col = u.pn * 256 + c8;
        float a[8], b[8];
        if (col < 1024) { *(GAS v4u*)(urnn + r * D + col) = pack8(v0); *(GAS v4u*)(urnn + r * D + col + 128) = pack8(v1); }
        else if (col < 2048) {
#pragma unroll
            for (int j = 0; j < 8; ++j) { a[j] = gelu_tanh(v0[j]); b[j] = gelu_tanh(v1[j]); }
            *(GAS v4u*)(gate + r * D + col - 1024) = pack8(a); *(GAS v4u*)(gate + r * D + col - 1024 + 128) = pack8(b); }
        else if (col < 2560) { *(GAS v4u*)(ufour + r * 512 + col - 2048) = pack8(v0); *(GAS v4u*)(ufour + r * 512 + col - 2048 + 128) = pack8(v1); }
        else {
#pragma unroll
            for (int j = 0; j < 8; ++j) { a[j] = sigmoidf_(v0[j]); b[j] = sigmoidf_(v1[j]); }
            bf16* dst = col < 3584 ? sgr + r * D + (col - 2560) : sgf + r * D + (col - 3584);
            *(GAS v4u*)dst = pack8(a); *(GAS v4u*)(dst + 128) = pack8(b); }
    }
};
struct PDft {
    int G, c; const bf16 *csl, *csc, *ut; bf16* g;
    __device__ __forceinline__ bool next(int i, Unit& u) const {
        const int idx = i * G + c; if (idx >= 544) return false;
        if (idx < 512) { const int b = idx >> 6, rem = idx & 63; u.pm = rem >> 1; u.pn = rem & 1; u.x0 = b; u.x1 = 0;
            u.A = csl + (size_t)u.pm * 256 * 4096; u.lda = 4096; u.B = ut + ((size_t)b * 512 + u.pn * 256) * 4096; u.ldb = 4096; u.K = 4096; }
        else { const int j = idx - 512, b = j >> 2, rem = j & 3; u.pm = rem >> 1; u.pn = rem & 1; u.x0 = b; u.x1 = 1;
            u.A = csc + (size_t)u.pm * 256 * 256; u.lda = 256; u.B = ut + (size_t)8 * 512 * 4096 + ((size_t)b * 512 + u.pn * 256) * 256; u.ldb = 256; u.K = 256; }
        return true; }
    __device__ __forceinline__ const bf16* a_row(const Unit& u, int row) const { return u.A + (size_t)row * u.lda; }
    __device__ __forceinline__ void epi(const Unit& u, int row, int c8, const float* v0, const float* v1) const {
        size_t r; int col;
        if (u.x1 == 0) { r = (size_t)u.x0 * 4096 + (u.pm & 15) * 256 + row; col = (u.pm >> 4) * 512 + u.pn * 256 + c8; }
        else { r = (size_t)NL + u.x0 * 256 + row; col = u.pm * 512 + u.pn * 256 + c8; }
        *(GAS v4u*)(g + r * D + col) = pack8(v0); *(GAS v4u*)(g + r * D + col + 128) = pack8(v1);
    }
};
struct PMerge {
    int G, c; const bf16 *gm, *y, *wf, *wr, *sgr, *sgf; bf16 *t1, *mg;
    __device__ __forceinline__ bool next(int i, Unit& u) const {
        const int tile = (i >> 1) * G + c; if (tile >= NPAN * 4) return false;
        u.pm = tile >> 2; u.pn = tile & 3; u.x0 = i & 1; u.lda = D; u.ldb = D; u.K = D;
        u.A = (u.x0 ? y : gm) + (size_t)u.pm * 256 * D; u.B = (u.x0 ? wr : wf) + (size_t)u.pn * 256 * D; return true; }
    __device__ __forceinline__ const bf16* a_row(const Unit& u, int row) const { return u.A + (size_t)row * D; }
    __device__ __forceinline__ void epi(const Unit& u, int row, int c8, const float* v0, const float* v1) const {
        const size_t o = ((size_t)u.pm * 256 + row) * D + u.pn * 256 + c8;
#pragma unroll
        for (int h = 0; h < 2; ++h) { const float* v = h ? v1 : v0; const size_t oo = o + h * 128; float s[8], r[8];
            if (u.x0 == 0) { unpack8(*(const GAS v4u*)(sgf + oo), s);
#pragma unroll
                for (int j = 0; j < 8; ++j) r[j] = s[j] * v[j];
                *(GAS v4u*)(t1 + oo) = pack8(r); }
            else { float t[8]; unpack8(*(const GAS v4u*)(sgr + oo), s); unpack8(*(const GAS v4u*)(t1 + oo), t);
#pragma unroll
                for (int j = 0; j < 8; ++j) r[j] = s[j] * v[j] + t[j];
                *(GAS v4u*)(mg + oo) = pack8(r); } }
    }
};
struct PWout {
    int G, c; const bf16 *mg, *wo; const float *xold_l, *xold_c; float *xnew_l, *xnew_c; const float* g1;
    __device__ __forceinline__ bool next(int i, Unit& u) const {
        const int idx = i * G + c; if (idx >= NPAN * 4) return false;
        u.pm = idx >> 2; u.pn = idx & 3; u.lda = D; u.ldb = D; u.K = D; u.A = mg + (size_t)u.pm * 256 * D; u.B = wo + (size_t)u.pn * 256 * D; return true; }
    __device__ __forceinline__ const bf16* a_row(const Unit& u, int row) const { return u.A + (size_t)row * D; }
    __device__ __forceinline__ void epi(const Unit& u, int row, int c8, const float* v0, const float* v1) const {
        const int r = u.pm * 256 + row; const int mb = mb_of(r);
        const float* xo = r < NL ? xold_l + (size_t)r * D : xold_c + (size_t)(r - NL) * D;
        float* xn = r < NL ? xnew_l + (size_t)r * D : xnew_c + (size_t)(r - NL) * D;
        const float* gg = g1 + (size_t)mb * NMOD * D;
#pragma unroll
        for (int h = 0; h < 2; ++h) { const float* v = h ? v1 : v0; const int col = u.pn * 256 + c8 + h * 128;
#pragma unroll
            for (int q = 0; q < 2; ++q) { const f32x4 xv = *(const GAS f32x4*)(xo + col + 4 * q), gv = *(const GAS f32x4*)(gg + col + 4 * q);
                f32x4 o; o[0] = xv[0] + gv[0] * v[4 * q]; o[1] = xv[1] + gv[1] * v[4 * q + 1]; o[2] = xv[2] + gv[2] * v[4 * q + 2]; o[3] = xv[3] + gv[3] * v[4 * q + 3];
                *(GAS f32x4*)(xn + col + 4 * q) = o; } }
    }
};
struct PMoe1 {
    int G, c; const bf16* hx2; const bf16* w; const int2* list; bf16* he; const LAS int* ts; const LAS int* cn;
    __device__ __forceinline__ bool next(int i, Unit& u) const {
        const int idx = i * G + c; if (idx >= ts[16] * 8) return false;
        const int tile = idx >> 3; u.pn = idx & 7; u.pm = tile; int e = 0;
#pragma unroll
        for (int j = 1; j < 16; ++j) e += (tile >= ts[j]) ? 1 : 0;
        u.x0 = e; u.x1 = (tile - ts[e]) * 256; u.x2 = cn[e];
        u.A = hx2; u.lda = D; u.B = w + (size_t)e * 3 * D * D + (size_t)u.pn * 256 * D; u.ldb = D; u.K = D; return true; }
    __device__ __forceinline__ const bf16* a_row(const Unit& u, int row) const {
        const int p = u.x1 + row; int r = 0; if (p < u.x2) r = list[(size_t)u.x0 * NT + p].x & 0x7fffffff; return hx2 + (size_t)r * D; }
    __device__ __forceinline__ void epi(const Unit& u, int row, int c8, const float* v0, const float* v1) const {
        float r[8];
#pragma unroll
        for (int j = 0; j < 8; ++j) r[j] = siluf_(v0[j]) * v1[j];
        *(GAS v4u*)(he + ((size_t)u.pm * 256 + row) * D + u.pn * 128 + c8) = pack8(r);
    }
};
struct PMoe2 {
    int G, c; const bf16* he; const bf16* w; const int2* list; bf16* c01; const LAS int* ts; const LAS int* cn;
    __device__ __forceinline__ bool next(int i, Unit& u) const {
        const int idx = i * G + c; if (idx >= ts[16] * 4) return false;
        const int tile = idx >> 2; u.pn = idx & 3; u.pm = tile; int e = 0;
#pragma unroll
        for (int j = 1; j < 16; ++j) e += (tile >= ts[j]) ? 1 : 0;
        u.x0 = e; u.x1 = (tile - ts[e]) * 256; u.x2 = cn[e];
        u.A = he + (size_t)tile * 256 * D; u.lda = D; u.B = w + (size_t)e * 3 * D * D + (size_t)2 * D * D + (size_t)u.pn * 256 * D; u.ldb = D; u.K = D; return true; }
    __device__ __forceinline__ const bf16* a_row(const Unit& u, int row) const { return u.A + (size_t)row * D; }
    __device__ __forceinline__ void epi(const Unit& u, int row, int c8, const float* v0, const float* v1) const {
        const int p = u.x1 + row; if (p >= u.x2) return;
        const int2 en = list[(size_t)u.x0 * NT + p]; const int r = en.x & 0x7fffffff, s = (en.x >> 31) & 1; const float w8 = __builtin_bit_cast(float, en.y);
        bf16* dst = c01 + ((size_t)s * NT + r) * D + u.pn * 256 + c8; float a[8], b[8];
#pragma unroll
        for (int j = 0; j < 8; ++j) { a[j] = w8 * v0[j]; b[j] = w8 * v1[j]; }
        *(GAS v4u*)dst = pack8(a); *(GAS v4u*)(dst + 128) = pack8(b);
    }
};

__device__ __forceinline__ void transpose_item(const float* W, int K, int N, bf16* WT, int k0, int n0, int drow0, LAS float* scr, int lane) {
#pragma unroll 8
    for (int i = 0; i < 32; ++i) { const int kk = 2 * i + (lane >> 5); scr[kk * 33 + (lane & 31)] = W[(size_t)(k0 + kk) * N + n0 + (lane & 31)]; }
    LDS_WAIT(); asm volatile("" ::: "memory");
    const int c = lane & 7;
#pragma unroll
    for (int j = 0; j < 4; ++j) { const int n = (lane >> 3) + 8 * j; const LAS float* s = scr + (8 * c) * 33 + n;
        v4u o; o.x = pk2(s[0 * 33], s[1 * 33]); o.y = pk2(s[2 * 33], s[3 * 33]); o.z = pk2(s[4 * 33], s[5 * 33]); o.w = pk2(s[6 * 33], s[7 * 33]);
        *(GAS v4u*)(WT + (size_t)(drow0 + n) * K + k0 + 8 * c) = o; }
    LDS_WAIT(); asm volatile("" ::: "memory");
}
__device__ __forceinline__ void p_prologue(Frame& F) {
    const int gw = F.bid * NWAVES + F.wave, NGW = F.G * NWAVES;
    LAS float* scr = (LAS float*)(F.lds + F.wave * 16384);
    constexpr int I_IN = 16 * 144, I_SQ = 16 * 32;
    constexpr int NIT = 2 * (I_IN + 2 * I_SQ);
    for (int it = gw; it < NIT; it += NGW) {
        int r = it; const int l = r / (I_IN + 2 * I_SQ); r -= l * (I_IN + 2 * I_SQ);
        if (r < I_IN) { const int kb = r / 144, nb = r % 144; transpose_item(F.kin[7] + (size_t)l * D * INW, D, INW, (bf16*)(F.ws + WS_WIN) + (size_t)l * INW * D, kb * 64, nb * 32, nb * 32, scr, F.lane); continue; }
        r -= I_IN;
        const int which = r / I_SQ; r -= which * I_SQ; const int kb = r / 32, nb = r % 32;
        transpose_item(F.kin[which ? 17 : 15] + (size_t)l * D * D, D, D, (bf16*)(F.ws + (which ? WS_WO : WS_WR)) + (size_t)l * D * D, kb * 64, nb * 32, nb * 32, scr, F.lane);
    }
    for (int o = F.bid * NTHR + F.tid; o < 2 * D * D; o += F.G * NTHR) {
        const int l = o >> 20, rem = o & (D * D - 1), kk = rem >> 10, n = rem & 1023;
        const int ch = kk & 511, g = ch >> 7, cc = ch & 127; const bool sn = kk >= 512;
        const float* wf = F.kin[16] + (size_t)l * 512 * D + (size_t)(g * 128) * D + n; float s = 0.f;
        for (int m = 0; m < 128; ++m) { const int ph = (cc * m) & 127; const float ang = (float)ph * (2.0f / 128.0f);
            const float co = sn ? -sinpif(ang) : cospif(ang); s += co * wf[(size_t)m * D]; }
        ((bf16*)(F.ws + WS_WF))[(size_t)l * D * D + (size_t)n * D + kk] = (bf16)f2bf(s);
    }
    { const float scl = 1.0f / sqrtf(4096.f * 128.f), scc = 1.0f / sqrtf(256.f * 128.f);
      for (size_t o = (size_t)F.bid * NTHR + F.tid; o < (size_t)8192 * 512; o += (size_t)F.G * NTHR) {
          const int r = (int)(o >> 9), t0 = (int)(o & 511) * 8, rr = r & 4095; float v[8];
#pragma unroll
          for (int j = 0; j < 8; ++j) { const int ph = (rr * (t0 + j)) & 4095; const float ang = (float)ph * (2.0f / 4096.0f); v[j] = (r < 4096 ? cospif(ang) : sinpif(ang)) * scl; }
          *(GAS v4u*)((bf16*)(F.ws + WS_CSL) + (size_t)r * 4096 + t0) = pack8(v); }
      for (int o = F.bid * NTHR + F.tid; o < 512 * 32; o += F.G * NTHR) {
          const int r = o >> 5, t0 = (o & 31) * 8, rr = r & 255; float v[8];
#pragma unroll
          for (int j = 0; j < 8; ++j) { const int ph = (rr * (t0 + j)) & 255; const float ang = (float)ph * (2.0f / 256.0f); v[j] = (r < 256 ? cospif(ang) : sinpif(ang)) * scc; }
          *(GAS v4u*)((bf16*)(F.ws + WS_CSC) + (size_t)r * 256 + t0) = pack8(v); } }
    for (int o = F.bid * NTHR + F.tid; o < 2 * 2 * 1024; o += F.G * NTHR) { const float lam = F.kin[14][o]; const float sp = (-lam > 20.f) ? -lam : log1pf(__expf(-lam));
        ((float*)(F.ws + WS_MODS + 512 * 1024))[o] = -8.0f * sp; }
    __syncthreads();
    { LAS float* sc = (LAS float*)(F.lds + 131072 - 9 * 1024 * 4);
      LAS float* red = (LAS float*)F.lds;
      for (int o = F.tid; o < 9 * 1024; o += NTHR) { const float cv = o < 8192 ? F.kin[1][o] : F.kin[3][o - 8192]; sc[o] = siluf_(cv); }
      __syncthreads();
      for (int it = F.bid; it < 2 * (NMOD * D / 64); it += F.G) {
          const int l = it / (NMOD * D / 64), n = (it % (NMOD * D / 64)) * 64 + F.lane; const float* w = F.kin[4] + (size_t)l * D * NMOD * D + n; float acc[9];
#pragma unroll
          for (int q = 0; q < 9; ++q) acc[q] = 0.f;
          for (int k = F.wave * 128; k < F.wave * 128 + 128; ++k) { const float wv = w[(size_t)k * NMOD * D];
#pragma unroll
              for (int q = 0; q < 9; ++q) acc[q] += sc[q * 1024 + k] * wv; }
#pragma unroll
          for (int q = 0; q < 9; ++q) red[(F.wave * 9 + q) * 64 + F.lane] = acc[q];
          __syncthreads();
          for (int o = F.tid; o < 9 * 64; o += NTHR) { const int q = o >> 6, ln = o & 63; float s = 0.f;
#pragma unroll
              for (int wv = 0; wv < 8; ++wv) s += red[(wv * 9 + q) * 64 + ln];
              const int nn = (it % (NMOD * D / 64)) * 64 + ln;
              ((float*)(F.ws + WS_MODS))[((size_t)(l * 9 + q)) * NMOD * D + nn] = s + F.kin[5][(size_t)l * NMOD * D + nn]; }
          __syncthreads();
      } }
}

__device__ __forceinline__ void p_norm1(Frame& F, int l) {
    const int gw = F.bid * NWAVES + F.wave, NGW = F.G * NWAVES;
    const float* gn = F.kin[6] + (size_t)l * D;
    bf16* hx = (bf16*)(F.ws + WS_RA); const bf16* c01 = (const bf16*)(F.ws + WS_C01);
    for (int r = gw; r < NT; r += NGW) {
        const int mb = mb_of(r);
        const float* src = l == 0 ? (r < NL ? F.kin[0] + (size_t)r * D : F.kin[2] + (size_t)(r - NL) * D)
                                  : (r < NL ? F.out + (size_t)r * D : (const float*)(F.ws + WS_HCTX) + (size_t)(r - NL) * D);
        f32x4 v[4]; float ss = 0.f;
#pragma unroll
        for (int j = 0; j < 4; ++j) v[j] = *(const GAS f32x4*)(src + F.lane * 4 + 256 * j);
        if (l == 1) { const float* g2 = modp(F, 0, mb, 5);
#pragma unroll
            for (int j = 0; j < 4; ++j) { const int k = F.lane * 4 + 256 * j; const v2u a = *(const GAS v2u*)(c01 + (size_t)r * D + k), b = *(const GAS v2u*)(c01 + ((size_t)NT + r) * D + k);
                const f32x4 gv = *(const GAS f32x4*)(g2 + k);
                v[j][0] += gv[0] * (bflo(a.x) + bflo(b.x)); v[j][1] += gv[1] * (bfhi(a.x) + bfhi(b.x)); v[j][2] += gv[2] * (bflo(a.y) + bflo(b.y)); v[j][3] += gv[3] * (bfhi(a.y) + bfhi(b.y));
                *(GAS f32x4*)((float*)src + k) = v[j]; } }
#pragma unroll
        for (int j = 0; j < 4; ++j) ss += (v[j][0] * v[j][0] + v[j][1] * v[j][1]) + (v[j][2] * v[j][2] + v[j][3] * v[j][3]);
        const float rstd = rsqrtf(wave_sum(ss) * (1.f / D) + RMS_EPS);
        const float *sh = modp(F, l, mb, 0), *sc = modp(F, l, mb, 1);
#pragma unroll
        for (int j = 0; j < 4; ++j) { const int k = F.lane * 4 + 256 * j; const f32x4 g = *(const GAS f32x4*)(gn + k), s1 = *(const GAS f32x4*)(sc + k), s0 = *(const GAS f32x4*)(sh + k);
            float o[4];
#pragma unroll
            for (int q = 0; q < 4; ++q) o[q] = v[j][q] * rstd * g[q] * (1.f + s1[q]) + s0[q];
            v2u w; w.x = pk2(o[0], o[1]); w.y = pk2(o[2], o[3]); *(GAS v2u*)(hx + (size_t)r * D + k) = w; }
    }
}
__device__ __forceinline__ void p_final(Frame& F) {
    const int gw = F.bid * NWAVES + F.wave, NGW = F.G * NWAVES;
    const bf16* c01 = (const bf16*)(F.ws + WS_C01);
    for (int r = gw; r < NL; r += NGW) {
        const int mb = r >> 12; float* src = F.out + (size_t)r * D; const float* g2 = modp(F, 1, mb, 5);
        f32x4 v[4]; float ss = 0.f;
#pragma unroll
        for (int j = 0; j < 4; ++j) { const int k = F.lane * 4 + 256 * j; v[j] = *(const GAS f32x4*)(src + k);
            const v2u a = *(const GAS v2u*)(c01 + (size_t)r * D + k), b = *(const GAS v2u*)(c01 + ((size_t)NT + r) * D + k); const f32x4 gv = *(const GAS f32x4*)(g2 + k);
            v[j][0] += gv[0] * (bflo(a.x) + bflo(b.x)); v[j][1] += gv[1] * (bfhi(a.x) + bfhi(b.x)); v[j][2] += gv[2] * (bflo(a.y) + bflo(b.y)); v[j][3] += gv[3] * (bfhi(a.y) + bfhi(b.y));
            ss += (v[j][0] * v[j][0] + v[j][1] * v[j][1]) + (v[j][2] * v[j][2] + v[j][3] * v[j][3]); }
        const float rstd = rsqrtf(wave_sum(ss) * (1.f / D) + RMS_EPS);
#pragma unroll
        for (int j = 0; j < 4; ++j) { const int k = F.lane * 4 + 256 * j; const f32x4 g = *(const GAS f32x4*)(F.kin[24] + k); f32x4 o;
#pragma unroll
            for (int q = 0; q < 4; ++q) o[q] = v[j][q] * rstd * g[q];
            *(GAS f32x4*)(src + k) = o; }
    }
}
__device__ __forceinline__ void p_transpose(Frame& F) {
    LAS bf16* tile = (LAS bf16*)F.lds;
    const bf16* uf = (const bf16*)(F.ws + WS_RF); bf16* ut = (bf16*)(F.ws + WS_RG);
    for (int it = F.bid; it < 4096 + 256; it += F.G) {
        int b, tb, cb, L; size_t rowbase; bf16* dst;
        if (it < 4096) { b = it >> 9; tb = (it >> 3) & 63; cb = it & 7; L = 4096; rowbase = (size_t)b * 4096 + tb * 64; dst = ut + (size_t)b * 512 * 4096; }
        else { const int j = it - 4096; b = j >> 5; tb = (j >> 3) & 3; cb = j & 7; L = 256; rowbase = (size_t)NL + b * 256 + tb * 64; dst = ut + (size_t)8 * 512 * 4096 + (size_t)b * 512 * 256; }
        { const int t = F.tid >> 3, c8 = (F.tid & 7) * 8; const v4u w = *(const GAS v4u*)(uf + (rowbase + t) * 512 + cb * 64 + c8);
          LAS unsigned* p = (LAS unsigned*)(tile + t * 72 + c8); p[0] = w.x; p[1] = w.y; p[2] = w.z; p[3] = w.w; }
        __syncthreads();
        { const int c = F.tid >> 3, t8 = (F.tid & 7) * 8; v4u o; unsigned h[8];
#pragma unroll
          for (int j = 0; j < 8; ++j) h[j] = tile[(t8 + j) * 72 + c];
          o.x = h[0] | (h[1] << 16); o.y = h[2] | (h[3] << 16); o.z = h[4] | (h[5] << 16); o.w = h[6] | (h[7] << 16);
          *(GAS v4u*)(dst + (size_t)(cb * 64 + c) * L + tb * 64 + t8) = o; }
        __syncthreads();
    }
}
__device__ __forceinline__ void p_scan_simple(Frame& F, int l) {
    if (F.bid >= 128) return;
    const int b = F.bid >> 4, h = (F.bid >> 1) & 7, d = F.bid & 1;
    LAS float* U = (LAS float*)F.lds;
    LAS float* RAg = U + 64 * 128;
    LAS float* XIg = RAg + 64 * 128;
    const bf16* urnn = (const bf16*)(F.ws + WS_RB);
    bf16* hout = (bf16*)(F.ws + (d ? WS_RF : WS_RA));
    const float* cw = F.kin[8] + (size_t)l * 4 * D + h * 128; const float* cb = F.kin[9] + (size_t)l * D + h * 128;
    const float* Wa = F.kin[10] + ((size_t)(l * 2 + d) * 8 + h) * 128 * 128; const float* Wx = F.kin[12] + ((size_t)(l * 2 + d) * 8 + h) * 128 * 128;
    const float* ba = F.kin[11] + ((size_t)(l * 2 + d) * 8 + h) * 128; const float* bx = F.kin[13] + ((size_t)(l * 2 + d) * 8 + h) * 128;
    const float* n8 = (const float*)(F.ws + WS_MODS + 512 * 1024) + (size_t)(l * 2 + d) * 1024 + h * 128;
    const int ch = F.tid & 127, tq = F.tid >> 7;
    float hstate = 0.f;
    for (int step = 0; step < 68; ++step) {
        const int j = d == 0 ? step : (step < 4 ? 3 - step : 71 - step);
        const bool isctx = j < 4; const size_t row0 = isctx ? (size_t)NL + b * 256 + j * 64 : (size_t)b * 4096 + (size_t)(j - 4) * 64;
        __syncthreads();
        for (int o = F.tid; o < 64 * 128; o += NTHR) { const int t = o >> 7, c = o & 127; float s = cb[c];
#pragma unroll
            for (int k = 0; k < 4; ++k) { const int tt = t + k - 2; bool ok; if (isctx) { const int g = j * 64 + tt; ok = g >= 0 && g < 256; } else ok = tt >= 0 && tt < 64;
                if (ok) s += cw[(size_t)k * D + c] * bf2f(urnn[(row0 + tt) * D + h * 128 + c]); }
            U[o] = s; }
        __syncthreads();
        { float ar[16], ax[16];
#pragma unroll
          for (int q = 0; q < 16; ++q) { ar[q] = 0.f; ax[q] = 0.f; }
          for (int k = 0; k < 128; ++k) { const float wa = Wa[(size_t)k * 128 + ch], wx = Wx[(size_t)k * 128 + ch];
#pragma unroll
              for (int q = 0; q < 16; ++q) { const float uv = U[(tq * 16 + q) * 128 + k]; ar[q] += uv * wa; ax[q] += uv * wx; } }
          const float bav = ba[ch], bxv = bx[ch], n8v = n8[ch];
#pragma unroll
          for (int q = 0; q < 16; ++q) { const int t = tq * 16 + q; const float r = sigmoidf_(ar[q] + bav), ig = sigmoidf_(ax[q] + bxv);
              const float la = n8v * r, a = __expf(la), y2 = 2.f * la;
              const float om = (y2 > -0.02f) ? -(y2 * (1.f + y2 * (0.5f + y2 * (1.f / 6.f)))) : 1.f - __expf(y2);
              RAg[t * 128 + ch] = a; XIg[t * 128 + ch] = sqrtf(om) * ig * U[t * 128 + ch]; } }
        __syncthreads();
        if (F.tid < 128) {
            for (int q = 0; q < 64; ++q) { const int t = d == 0 ? q : 63 - q; hstate = RAg[t * 128 + ch] * hstate + XIg[t * 128 + ch]; RAg[t * 128 + ch] = hstate; } }
        __syncthreads();
        for (int o = F.tid; o < 64 * 16; o += NTHR) { const int t = o >> 4, c8 = (o & 15) * 8; float v[8];
#pragma unroll
            for (int q = 0; q < 8; ++q) v[q] = RAg[t * 128 + c8 + q];
            *(GAS v4u*)(hout + (row0 + t) * D + h * 128 + c8) = pack8(v); }
    }
}
__device__ __forceinline__ void p_ycombine(Frame& F) {
    bf16* hf = (bf16*)(F.ws + WS_RA); const bf16* hb = (const bf16*)(F.ws + WS_RF); const bf16* gt = (const bf16*)(F.ws + WS_RC);
    for (size_t o = ((size_t)F.bid * NTHR + F.tid) * 8; o < (size_t)NT * D; o += (size_t)F.G * NTHR * 8) {
        float a[8], b[8], g[8]; unpack8(*(const GAS v4u*)(hf + o), a); unpack8(*(const GAS v4u*)(hb + o), b); unpack8(*(const GAS v4u*)(gt + o), g);
#pragma unroll
        for (int j = 0; j < 8; ++j) a[j] = (a[j] + b[j]) * g[j];
        *(GAS v4u*)(hf + o) = pack8(a); }
}
__device__ __forceinline__ void p_norm2_route(Frame& F, int l) {
    LAS float* RW = (LAS float*)F.lds;
    LAS int* lcnt = (LAS int*)(F.lds + 65536);
    LAS int* rinfo = lcnt + 64;
    const int rpb = (NT + F.G - 1) / F.G, r0 = F.bid * rpb, r1 = (r0 + rpb < NT) ? r0 + rpb : NT;
    for (int o = F.tid; o < 1024 * 16; o += NTHR) RW[o] = F.kin[19][o];
    if (F.tid < 32) lcnt[F.tid] = 0;
    __syncthreads();
    const float* gn = F.kin[18] + (size_t)l * D; bf16* hx2 = (bf16*)(F.ws + WS_RA);
    float rb[16];
#pragma unroll
    for (int e = 0; e < 16; ++e) rb[e] = F.kin[20][e];
    for (int r = r0 + F.wave; r < r1; r += NWAVES) {
        const int mb = mb_of(r);
        const float* src = r < NL ? F.out + (size_t)r * D : (const float*)(F.ws + WS_HCTX) + (size_t)(r - NL) * D;
        f32x4 v[4]; float ss = 0.f;
#pragma unroll
        for (int j = 0; j < 4; ++j) { v[j] = *(const GAS f32x4*)(src + F.lane * 4 + 256 * j); ss += (v[j][0] * v[j][0] + v[j][1] * v[j][1]) + (v[j][2] * v[j][2] + v[j][3] * v[j][3]); }
        const float rstd = rsqrtf(wave_sum(ss) * (1.f / D) + RMS_EPS);
        const float *sh = modp(F, l, mb, 3), *sc = modp(F, l, mb, 4);
        float lg[16];
#pragma unroll
        for (int e = 0; e < 16; ++e) lg[e] = 0.f;
#pragma unroll
        for (int j = 0; j < 4; ++j) { const int k = F.lane * 4 + 256 * j; const f32x4 g = *(const GAS f32x4*)(gn + k), s1 = *(const GAS f32x4*)(sc + k), s0 = *(const GAS f32x4*)(sh + k);
            float o[4];
#pragma unroll
            for (int q = 0; q < 4; ++q) { o[q] = v[j][q] * rstd * g[q] * (1.f + s1[q]) + s0[q];
                const LAS f32x4* rw = (const LAS f32x4*)(RW + (k + q) * 16);
#pragma unroll
                for (int e4 = 0; e4 < 4; ++e4) { const f32x4 w = rw[e4]; lg[4 * e4] += o[q] * w[0]; lg[4 * e4 + 1] += o[q] * w[1]; lg[4 * e4 + 2] += o[q] * w[2]; lg[4 * e4 + 3] += o[q] * w[3]; } }
            v2u w; w.x = pk2(o[0], o[1]); w.y = pk2(o[2], o[3]); *(GAS v2u*)(hx2 + (size_t)r * D + k) = w; }
        float aff[16], sel[16];
#pragma unroll
        for (int e = 0; e < 16; ++e) { lg[e] = wave_sum(lg[e]); aff[e] = sigmoidf_(lg[e]); sel[e] = aff[e] + rb[e]; }
        int grp = 0; float best = -1e30f;
#pragma unroll
        for (int g = 0; g < 4; ++g) { const float a = sel[4 * g], b = sel[4 * g + 1], c = sel[4 * g + 2], dd = sel[4 * g + 3];
            const float s = fmaxf(fmaxf(fmaxf(a + b, a + c), fmaxf(a + dd, b + c)), fmaxf(b + dd, c + dd));
            if (s > best) { best = s; grp = g; } }
        float s4[4], a4[4];
#pragma unroll
        for (int q = 0; q < 4; ++q) { s4[q] = grp == 0 ? sel[q] : grp == 1 ? sel[4 + q] : grp == 2 ? sel[8 + q] : sel[12 + q]; a4[q] = grp == 0 ? aff[q] : grp == 1 ? aff[4 + q] : grp == 2 ? aff[8 + q] : aff[12 + q]; }
        int i0 = 0; float m0 = s4[0], af0 = a4[0];
#pragma unroll
        for (int q = 1; q < 4; ++q) if (s4[q] > m0) { m0 = s4[q]; i0 = q; af0 = a4[q]; }
        int i1 = -1; float m1 = -1e30f, af1 = 0.f;
#pragma unroll
        for (int q = 0; q < 4; ++q) if (q != i0 && s4[q] > m1) { m1 = s4[q]; i1 = q; af1 = a4[q]; }
        const int e0 = grp * 4 + i0, e1 = grp * 4 + i1; const float inv = 1.f / (af0 + af1);
        if (F.lane == 0) { const int lr0 = __hip_atomic_fetch_add(lcnt + e0, 1, __ATOMIC_RELAXED, __HIP_MEMORY_SCOPE_WORKGROUP), lr1 = __hip_atomic_fetch_add(lcnt + e1, 1, __ATOMIC_RELAXED, __HIP_MEMORY_SCOPE_WORKGROUP);
            LAS int* ri = rinfo + (r - r0) * 5; ri[0] = e0 | (e1 << 8); ri[1] = lr0; ri[2] = lr1; ri[3] = __builtin_bit_cast(int, af0 * inv); ri[4] = __builtin_bit_cast(int, af1 * inv); }
    }
    __syncthreads();
    if (F.tid < 16) lcnt[16 + F.tid] = (int)__hip_atomic_fetch_add(F.ctl + CW_CNT + 64 * l + F.tid, (unsigned)lcnt[F.tid], __ATOMIC_RELAXED, __HIP_MEMORY_SCOPE_AGENT);
    __syncthreads();
    int2* list = (int2*)(F.ws + WS_LIST);
    for (int rl = F.tid; rl < r1 - r0; rl += NTHR) { const LAS int* ri = rinfo + rl * 5; const int e0 = ri[0] & 255, e1 = ri[0] >> 8, r = r0 + rl;
        list[(size_t)e0 * NT + lcnt[16 + e0] + ri[1]] = make_int2(r, ri[3]);
        list[(size_t)e1 * NT + lcnt[16 + e1] + ri[2]] = make_int2(r | (int)0x80000000, ri[4]); }
    __syncthreads();
    { const int gw = F.bid * NWAVES + F.wave, NGW = F.G * NWAVES; LAS float* scr = (LAS float*)(F.lds + F.wave * 16384);
      bf16* mw = (bf16*)(F.ws + WS_MOEW);
      for (int it = gw; it < 16 * 3 * 512; it += NGW) { const int e = it / 1536, rem = it % 1536, m = rem / 512, q = rem % 512, kb = q >> 5, nb = q & 31;
          const float* W = F.kin[m == 0 ? 21 : m == 1 ? 22 : 23] + ((size_t)l * 16 + e) * D * D; bf16* dst = mw + (size_t)e * 3 * D * D + (m == 2 ? (size_t)2 * D * D : 0);
          const int n0 = nb * 32; const int drow = m == 2 ? n0 : ((n0 >> 7) * 256 + (m == 1 ? 128 : 0) + (n0 & 127));
          transpose_item(W, D, D, dst, kb * 64, n0, drow, scr, F.lane); } }
}
__device__ __forceinline__ void moe_table(Frame& F, int l, LAS int* ts, LAS int* cn) {
    __syncthreads();
    if (F.tid == 0) { int acc = 0;
        for (int e = 0; e < 16; ++e) { const int c = (int)__hip_atomic_load(F.ctl + CW_CNT + 64 * l + e, __ATOMIC_RELAXED, __HIP_MEMORY_SCOPE_AGENT); cn[e] = c; ts[e] = acc; acc += (c + 255) >> 8; }
        ts[16] = acc; }
    __syncthreads();
}

constexpr int NPH = 24;
struct Args { const float* in[25]; float* out; unsigned char* ws; int ph_lo, ph_hi; };
__global__ void __launch_bounds__(NTHR, 2) fwd_kernel(Args args) {
    extern __shared__ __attribute__((aligned(16))) unsigned char lds[];
    Frame F;
    F.lds = (LAS unsigned char*)lds; F.tid = threadIdx.x; F.lane = F.tid & 63; F.wave = __builtin_amdgcn_readfirstlane(F.tid >> 6);
    F.G = gridDim.x; F.bid = blockIdx.x; F.ws = args.ws; F.out = args.out; F.ctl = (unsigned*)(args.ws + WS_CTL);
    F.kin = (const float* const __attribute__((address_space(4)))*)__builtin_amdgcn_kernarg_segment_ptr();
    volatile LAS unsigned* MISC = (volatile LAS unsigned*)(F.lds + MISC_OFF);
    if (F.tid < 32) MISC[F.tid] = 0u;
    __syncthreads();
    XcdBarrier bar; bar.bar = F.ctl + CW_BAR; bar.x = 0; bar.st = nullptr;
    if (MK_N_LAUNCHES == 1) bar = xcd_barrier_post(F.ctl + CW_BAR, MISC + 8);
    LAS int* ts = (LAS int*)(F.lds + MISC_OFF + 256); LAS int* cn = ts + 32;
    const int lo = args.ph_lo, hi = args.ph_hi;
#ifndef SITE_MASK
#define SITE_MASK 0xfffffu
#endif
#define SITE(j) (((SITE_MASK) >> (j)) & 1u)
#define IN(k) (lo <= (k) && (k) < hi)
#define LAUNDER() asm volatile("" : "+s"(F.ws), "+s"(F.out), "+s"(F.kin), "+s"(F.ctl), "+s"(F.lds), "+s"(F.wave), "+s"(F.bid), "+s"(F.G), "+v"(F.tid), "+v"(F.lane))
#define SEAM(k) do { if (MK_N_LAUNCHES == 1 && IN((k) + 1)) xcd_barrier(bar); } while (0)

    if (SITE(0) && IN(0)) { LAUNDER(); p_prologue(F); SEAM(0); }
    for (int l = 0; l < 2; ++l) {
        const int pb = 1 + 11 * l;
        if (SITE(1) && IN(pb + 0)) { LAUNDER(); p_norm1(F, l); SEAM(pb + 0); }
        if (SITE(2) && IN(pb + 1)) { LAUNDER();
            PInproj p; p.G = F.G; p.c = F.bid; p.l = l; p.hx = (const bf16*)(F.ws + WS_RA); p.wt = (const bf16*)(F.ws + WS_WIN) + (size_t)l * INW * D;
            p.urnn = (bf16*)(F.ws + WS_RB); p.gate = (bf16*)(F.ws + WS_RC); p.ufour = (bf16*)(F.ws + WS_RF); p.sgr = (bf16*)(F.ws + WS_RD); p.sgf = (bf16*)(F.ws + WS_RE);
            simple_gemm_phase(F, p); SEAM(pb + 1); }
        if (SITE(3) && IN(pb + 2)) { LAUNDER(); p_transpose(F); SEAM(pb + 2); }
        if (SITE(4) && IN(pb + 3)) { LAUNDER();
            PDft p; p.G = F.G; p.c = F.bid; p.csl = (const bf16*)(F.ws + WS_CSL); p.csc = (const bf16*)(F.ws + WS_CSC); p.ut = (const bf16*)(F.ws + WS_RG); p.g = (bf16*)(F.ws + WS_RH);
            simple_gemm_phase(F, p); SEAM(pb + 3); }
        if (SITE(5) && IN(pb + 4)) { LAUNDER(); p_scan_simple(F, l); SEAM(pb + 4); }
        if (SITE(6) && IN(pb + 5)) { LAUNDER(); p_ycombine(F); SEAM(pb + 5); }
        if (SITE(7) && IN(pb + 6)) { LAUNDER();
            PMerge p; p.G = F.G; p.c = F.bid; p.gm = (const bf16*)(F.ws + WS_RH); p.y = (const bf16*)(F.ws + WS_RA); p.wf = (const bf16*)(F.ws + WS_WF) + (size_t)l * D * D; p.wr = (const bf16*)(F.ws + WS_WR) + (size_t)l * D * D;
            p.sgr = (const bf16*)(F.ws + WS_RD); p.sgf = (const bf16*)(F.ws + WS_RE); p.t1 = (bf16*)(F.ws + WS_RB); p.mg = (bf16*)(F.ws + WS_RC);
            simple_gemm_phase(F, p); SEAM(pb + 6); }
        if (SITE(8) && IN(pb + 7)) { LAUNDER();
            PWout p; p.G = F.G; p.c = F.bid; p.mg = (const bf16*)(F.ws + WS_RC); p.wo = (const bf16*)(F.ws + WS_WO) + (size_t)l * D * D;
            p.xold_l = l == 0 ? F.kin[0] : F.out; p.xold_c = l == 0 ? F.kin[2] : (const float*)(F.ws + WS_HCTX); p.xnew_l = F.out; p.xnew_c = (float*)(F.ws + WS_HCTX); p.g1 = modp(F, l, 0, 2);
            simple_gemm_phase(F, p); SEAM(pb + 7); }
        if (SITE(9) && IN(pb + 8)) { LAUNDER(); p_norm2_route(F, l); SEAM(pb + 8); }
        if (SITE(10) && IN(pb + 9)) { LAUNDER();
            moe_table(F, l, ts, cn);
            PMoe1 p; p.G = F.G; p.c = F.bid; p.hx2 = (const bf16*)(F.ws + WS_RA); p.w = (const bf16*)(F.ws + WS_MOEW); p.list = (const int2*)(F.ws + WS_LIST); p.he = (bf16*)(F.ws + WS_HE); p.ts = ts; p.cn = cn;
            simple_gemm_phase(F, p); SEAM(pb + 9); }
        if (SITE(11) && IN(pb + 10)) { LAUNDER();
            moe_table(F, l, ts, cn);
            PMoe2 p; p.G = F.G; p.c = F.bid; p.he = (const bf16*)(F.ws + WS_HE); p.w = (const bf16*)(F.ws + WS_MOEW); p.list = (const int2*)(F.ws + WS_LIST); p.c01 = (bf16*)(F.ws + WS_C01); p.ts = ts; p.cn = cn;
            simple_gemm_phase(F, p); SEAM(pb + 10); }
    }
    if (SITE(12) && IN(23)) { LAUNDER(); p_final(F); }
#undef IN
#undef SEAM
}

extern "C" void kernel_launch(void* const* d_in, const int* in_sizes, int n_in, void* d_out, int out_size, void* d_ws, size_t ws_size, hipStream_t stream) {
    static int grid = 0;
    if (grid == 0) {
        if (n_in != 25 || out_size != NL * D || ws_size < WS_END) { fprintf(stderr, "kernel_launch: unexpected shapes (n_in %d, out %d, ws %zu)\n", n_in, out_size, ws_size); grid = -1; return; }
        int dev = 0, cus = 0, per_cu = 0;
        if (hipGetDevice(&dev) != hipSuccess || hipDeviceGetAttribute(&cus, hipDeviceAttributeMultiprocessorCount, dev) != hipSuccess) { grid = -1; return; }
        if (hipFuncSetAttribute((const void*)fwd_kernel, hipFuncAttributeMaxDynamicSharedMemorySize, LDS_BYTES) != hipSuccess) { fprintf(stderr, "kernel_launch: hipFuncSetAttribute failed\n"); grid = -1; return; }
        if (hipOccupancyMaxActiveBlocksPerMultiprocessor(&per_cu, (const void*)fwd_kernel, NTHR, LDS_BYTES) != hipSuccess || per_cu < 1) { fprintf(stderr, "kernel_launch: occupancy query says %d\n", per_cu); }
        (void)hipGetLastError();
        grid = cus;
    }
    if (grid < 0) return;
    (void)hipMemsetAsync((char*)d_ws + WS_CTL, 0, CTL_ZERO_BYTES, stream);
    Args a{};
    for (int i = 0; i < 25; ++i) a.in[i] = (const float*)d_in[i];
    a.out = (float*)d_out; a.ws = (unsigned char*)d_ws;
    if (MK_N_LAUNCHES == 1) { a.ph_lo = 0; a.ph_hi = NPH; hipLaunchKernelGGL(fwd_kernel, dim3(grid), dim3(NTHR), LDS_BYTES, stream, a); }
    else for (int p = 0; p < NPH; ++p) { a.ph_lo = p; a.ph_hi = p + 1; hipLaunchKernelGGL(fwd_kernel, dim3(grid), dim3(NTHR), LDS_BYTES, stream, a); }
}
```

```cpp
#include <hip/hip_runtime.h>
#include <cstdio>
#include <cstdint>

#ifndef MK_N_LAUNCHES
#define MK_N_LAUNCHES 1
#endif

#define GAS __attribute__((address_space(1)))
#define LAS __attribute__((address_space(3)))
typedef unsigned short bf16;
typedef unsigned v4u __attribute__((ext_vector_type(4)));
typedef unsigned v2u __attribute__((ext_vector_type(2)));
typedef float f32x4 __attribute__((ext_vector_type(4)));
typedef short bf16x8 __attribute__((ext_vector_type(8)));

constexpr int D = 1024, NB = 8, SEQ = 4096, CTX = 256, NL = NB * SEQ, NC = NB * CTX, NT = NL + NC;
constexpr int NPAN = NT / 256;
constexpr int INW = 4608, NE = 16, NMOD = 6;
constexpr float RMS_EPS = 1e-6f;
constexpr int NWAVES = 8, NTHR = 512;

constexpr size_t MiB = 1u << 20;
constexpr size_t WS_CTL = 0, CTL_ZERO_BYTES = 1 * MiB;
constexpr size_t WS_MODS = 1 * MiB;
constexpr size_t WS_WIN = 2 * MiB;
constexpr size_t WS_WR = 20 * MiB, WS_WF = 24 * MiB, WS_WO = 28 * MiB;
constexpr size_t WS_LRU = 32 * MiB;
constexpr size_t WS_CSC = 34 * MiB;
constexpr size_t WS_HCTX = 35 * MiB;
constexpr size_t WS_LIST = 43 * MiB;
constexpr size_t WS_CSL = 48 * MiB;
constexpr size_t WS_RA = 112 * MiB;
constexpr size_t WS_RB = 180 * MiB;
constexpr size_t WS_RC = 248 * MiB;
constexpr size_t WS_RD = 316 * MiB;
constexpr size_t WS_RE = 384 * MiB;
constexpr size_t WS_RF = 452 * MiB;
constexpr size_t WS_RG = 486 * MiB;
constexpr size_t WS_RH = 520 * MiB;
constexpr size_t WS_END = 588 * MiB;
constexpr size_t WS_MOEW = 180 * MiB;
constexpr size_t WS_HE = 276 * MiB;
constexpr size_t WS_C01 = 420 * MiB;
static_assert(WS_C01 + (size_t)2 * NT * D * 2 <= WS_END, "map");
static_assert(WS_RA + (size_t)NT * D * 2 <= WS_RB && WS_RH + (size_t)NT * D * 2 <= WS_END, "map");

constexpr int CW_TMO = 0;
constexpr int CW_CNT = 64;
constexpr int CW_BAR = 4096;

constexpr int LDS_BYTES = 147456;
constexpr int MISC_OFF = 131072 + 8192;

__device__ __forceinline__ unsigned f2bf(float f) { unsigned u = __builtin_bit_cast(unsigned, f); return (u + 0x7fffu + ((u >> 16) & 1u)) >> 16; }
__device__ __forceinline__ unsigned pk2(float lo, float hi) { return f2bf(lo) | (f2bf(hi) << 16); }
__device__ __forceinline__ float bflo(unsigned w) { return __builtin_bit_cast(float, w << 16); }
__device__ __forceinline__ float bfhi(unsigned w) { return __builtin_bit_cast(float, w & 0xffff0000u); }
__device__ __forceinline__ float bf2f(bf16 h) { return __builtin_bit_cast(float, ((unsigned)h) << 16); }
__device__ __forceinline__ v4u pack8(const float* v) { v4u o; o.x = pk2(v[0], v[1]); o.y = pk2(v[2], v[3]); o.z = pk2(v[4], v[5]); o.w = pk2(v[6], v[7]); return o; }
__device__ __forceinline__ void unpack8(v4u w, float* v) { v[0] = bflo(w.x); v[1] = bfhi(w.x); v[2] = bflo(w.y); v[3] = bfhi(w.y); v[4] = bflo(w.z); v[5] = bfhi(w.z); v[6] = bflo(w.w); v[7] = bfhi(w.w); }
__device__ __forceinline__ float sigmoidf_(float x) { return 1.f / (1.f + __expf(-x)); }
__device__ __forceinline__ float siluf_(float x) { return x / (1.f + __expf(-x)); }
__device__ __forceinline__ float gelu_tanh(float x) { const float u = 0.7978845608028654f * (x + 0.044715f * x * x * x); const float e = __expf(2.f * u); const float t = 1.f - 2.f / (e + 1.f); return 0.5f * x * (1.f + t); }
__device__ __forceinline__ float wave_sum(float v) {
#pragma unroll
    for (int o = 1; o < 64; o <<= 1) v += __shfl_xor(v, o);
    return v;
}
#define LDS_WAIT() asm volatile("s_waitcnt lgkmcnt(0)" ::: "memory")
#define VM_WAIT() asm volatile("s_waitcnt vmcnt(0)" ::: "memory")

#define XB_TMO      128
#define XB_XCNT(j)  (256  + 64 * (j))
#define XB_XSUB(j)  (1280 + 64 * (j))
#define XB_XGEN(j)  (2304 + 64 * (j))
#define XB_TOP      3328
#define XB_TOPGEN   3392
#define XCD_BAR_WORDS 3456
#define XB_SPIN_CAP (1u << 18)
__device__ __forceinline__ unsigned xb_ld(unsigned* p)              { return __hip_atomic_load(p, __ATOMIC_RELAXED, __HIP_MEMORY_SCOPE_AGENT); }
__device__ __forceinline__ unsigned xb_add(unsigned* p, unsigned v) { return __hip_atomic_fetch_add(p, v, __ATOMIC_RELAXED, __HIP_MEMORY_SCOPE_AGENT); }
__device__ __forceinline__ unsigned xb_xcc_id() { return (unsigned)__builtin_amdgcn_s_getreg((3 << 11) | 20) & 0xFu; }
#define XB_SPIN(cond, bar) do { unsigned _sp = 0; while (cond) { __builtin_amdgcn_s_sleep(1); \
    if ((++_sp & 255u) == 0u) { if (xb_ld(&(bar)[XB_TMO])) break; if (_sp > XB_SPIN_CAP) { atomicAdd(&(bar)[XB_TMO], 1u); break; } } } } while (0)
struct XcdBarrier { unsigned* bar; unsigned x; volatile LAS unsigned* st; };
__device__ __forceinline__ XcdBarrier xcd_barrier_post(unsigned* bar, volatile LAS unsigned* st) {
    XcdBarrier b; b.bar = bar; b.x = xb_xcc_id(); b.st = st;
    if (threadIdx.x == 0) (void)xb_add(&bar[XB_XCNT(b.x)], 1u);
    return b;
}
__device__ __forceinline__ void xcd_barrier_complete(unsigned* bar, unsigned x, unsigned& nloc, unsigned& nx) {
    const unsigned G = gridDim.x * gridDim.y * gridDim.z;
    unsigned sum, cnt, mine, sp = 0u;
    for (;;) {
        sum = 0u; cnt = 0u; mine = 0u;
#pragma unroll
        for (unsigned j = 0; j < 16; ++j) { const unsigned c = xb_ld(&bar[XB_XCNT(j)]); sum += c; cnt += (c > 0u) ? 1u : 0u; mine = (j == x) ? c : mine; }
        if (sum == G) break;
        __builtin_amdgcn_s_sleep(1);
        if ((++sp & 255u) == 0u) { if (xb_ld(&bar[XB_TMO])) break; if (sp > XB_SPIN_CAP) { atomicAdd(&bar[XB_TMO], 1u); break; } }
    }
    nloc = mine > 0u ? mine : 1u; nx = cnt > 0u ? cnt : 1u;
}
__device__ __forceinline__ void xcd_barrier(const XcdBarrier& b) {
    asm volatile("s_waitcnt vmcnt(0)" ::: "memory");
    __syncthreads();
    if (threadIdx.x == 0) {
        unsigned* bar = b.bar;
        __builtin_amdgcn_s_waitcnt(0);
        unsigned nloc = b.st[0], nx = b.st[1];
        if (nloc == 0u) { xcd_barrier_complete(bar, b.x, nloc, nx); b.st[0] = nloc; b.st[1] = nx; }
        const unsigned old = xb_add(&bar[XB_XSUB(b.x)], 1u);
        const unsigned gen = old / nloc;
        if (old + 1u == (gen + 1u) * nloc) {
            __builtin_amdgcn_fence(__ATOMIC_RELEASE, "agent");
            asm volatile("s_waitcnt vmcnt(0)" ::: "memory");
            const unsigned og = xb_add(&bar[XB_TOP], 1u);
            const unsigned tg = og / nx;
            if (og + 1u == (tg + 1u) * nx) xb_add(&bar[XB_TOPGEN], 1u);
            else XB_SPIN(xb_ld(&bar[XB_TOPGEN]) == tg, bar);
            __builtin_amdgcn_fence(__ATOMIC_ACQUIRE, "agent");
            xb_add(&bar[XB_XGEN(b.x)], 1u);
            asm volatile("s_waitcnt vmcnt(0)" ::: "memory");
        } else {
            XB_SPIN(xb_ld(&bar[XB_XGEN(b.x)]) == gen, bar);
            __builtin_amdgcn_fence(__ATOMIC_ACQUIRE, "agent");
            asm volatile("s_waitcnt vmcnt(0)" ::: "memory");
        }
    }
    __syncthreads();
}

struct Frame {
    LAS unsigned char* lds;
    int tid, lane, wave, G, bid;
    unsigned* ctl;
    const float* const __attribute__((address_space(4)))* kin;
    float* out;
    unsigned char* ws;
};
__device__ __forceinline__ const float* modp(const Frame& F, int l, int mb, int which) { return (const float*)(F.ws + WS_MODS) + ((size_t)(l * 9 + mb) * NMOD + which) * D; }
__device__ __forceinline__ int mb_of(int r) { return r < NL ? (r >> 12) : 8; }

struct Unit { const bf16* A; const bf16* B; int lda, ldb, K; int pm, pn, x0, x1, x2; };

template <class P> __device__ __forceinline__ void simple_gemm_phase(Frame& F, const P& p) {
    LAS float* As = (LAS float*)F.lds;
    LAS float* Bs = As + 32 * 128;
    const int tid = F.tid, rg = tid >> 4, cg = tid & 15;
    Unit u;
    for (int i = 0; p.next(i, u); ++i) {
        for (int half = 0; half < 2; ++half) {
            float acc[4][16];
#pragma unroll
            for (int a = 0; a < 4; ++a)
#pragma unroll
                for (int b = 0; b < 16; ++b) acc[a][b] = 0.f;
            const int arow_i = tid >> 2, ak = (tid & 3) * 8, brow_i = tid >> 1, bk = (tid & 1) * 16;
            const bf16* arow = p.a_row(u, half * 128 + arow_i);
            const bf16* brow = u.B + (size_t)brow_i * u.ldb;
            for (int k0 = 0; k0 < u.K; k0 += 32) {
                const v4u a0 = *(const GAS v4u*)(arow + k0 + ak);
                const v4u b0 = *(const GAS v4u*)(brow + k0 + bk), b1 = *(const GAS v4u*)(brow + k0 + bk + 8);
                __syncthreads();
                float t[8];
                unpack8(a0, t);
#pragma unroll
                for (int j = 0; j < 8; ++j) As[(ak + j) * 128 + arow_i] = t[j];
                unpack8(b0, t);
#pragma unroll
                for (int j = 0; j < 8; ++j) Bs[(bk + j) * 256 + brow_i] = t[j];
                unpack8(b1, t);
#pragma unroll
                for (int j = 0; j < 8; ++j) Bs[(bk + 8 + j) * 256 + brow_i] = t[j];
                __syncthreads();
#pragma unroll 2
                for (int k = 0; k < 32; ++k) {
                    const f32x4 x0 = *(const LAS f32x4*)(As + k * 128 + rg * 4);
                    const f32x4 y0 = *(const LAS f32x4*)(Bs + k * 256 + cg * 8), y1 = *(const LAS f32x4*)(Bs + k * 256 + cg * 8 + 4);
                    const f32x4 y2 = *(const LAS f32x4*)(Bs + k * 256 + 128 + cg * 8), y3 = *(const LAS f32x4*)(Bs + k * 256 + 128 + cg * 8 + 4);
                    const float xa[4] = {x0[0], x0[1], x0[2], x0[3]};
                    const float yb[16] = {y0[0], y0[1], y0[2], y0[3], y1[0], y1[1], y1[2], y1[3], y2[0], y2[1], y2[2], y2[3], y3[0], y3[1], y3[2], y3[3]};
#pragma unroll
                    for (int a = 0; a < 4; ++a)
#pragma unroll
                        for (int b = 0; b < 16; ++b) acc[a][b] = __builtin_fmaf(xa[a], yb[b], acc[a][b]);
                }
            }
#pragma unroll
            for (int a = 0; a < 4; ++a) p.epi(u, half * 128 + rg * 4 + a, cg * 8, &acc[a][0], &acc[a][8]);
        }
    }
    __syncthreads();
}

struct PInproj {
    int G, c, l; const bf16* hx; const bf16* wt; bf16 *urnn, *gate, *ufour, *sgr, *sgf;
    __device__ __forceinline__ bool next(int i, Unit& u) const {
        const int idx = i * G + c; if (idx >= NPAN * 18) return false;
        u.pm = idx / 18; u.pn = idx % 18; u.A = hx + (size_t)u.pm * 256 * D; u.lda = D; u.B = wt + (size_t)u.pn * 256 * D; u.ldb = D; u.K = D; return true; }
    __device__ __forceinline__ const bf16* a_row(const Unit& u, int row) const { return u.A + (size_t)row * D; }
    __device__ __forceinline__ void epi(const Unit& u, int row, int c8, const float* v0, const float* v1) const {
        const size_t r = (size_t)u.pm * 256 + row; const int col = u.pn * 256 + c8;
        float a[8], b[8];
        if (col < 1024) { *(GAS v4u*)(urnn + r * D + col) = pack8(v0); *(GAS v4u*)(urnn + r * D + col + 128) = pack8(v1); }
        else if (col < 2048) {
#pragma unroll
            for (int j = 0; j < 8; ++j) { a[j] = gelu_tanh(v0[j]); b[j] = gelu_tanh(v1[j]); }
            *(GAS v4u*)(gate + r * D + col - 1024) = pack8(a); *(GAS v4u*)(gate + r * D + col - 1024 + 128) = pack8(b); }
        else if (col < 2560) { *(GAS v4u*)(ufour + r * 512 + col - 2048) = pack8(v0); *(GAS v4u*)(ufour + r * 512 + col - 2048 + 128) = pack8(v1); }
        else {
#pragma unroll
            for (int j = 0; j < 8; ++j) { a[j] = sigmoidf_(v0[j]); b[j] = sigmoidf_(v1[j]); }
            bf16* dst = col < 3584 ? sgr + r * D + (col - 2560) : sgf + r * D + (col - 3584);
            *(GAS v4u*)dst = pack8(a); *(GAS v4u*)(dst + 128) = pack8(b); }
    }
};
struct PDft {
    int G, c; const bf16 *csl, *csc, *ut; bf16* g;
    __device__ __forceinline__ bool next(int i, Unit& u) const {
        const int idx = i * G + c; if (idx >= 544) return false;
        if (idx < 512) { const int b = idx >> 6, rem = idx & 63; u.pm = rem >> 1; u.pn = rem & 1; u.x0 = b; u.x1 = 0;
            u.A = csl + (size_t)u.pm * 256 * 4096; u.lda = 4096; u.B = ut + ((size_t)b * 512 + u.pn * 256) * 4096; u.ldb = 4096; u.K = 4096; }
        else { const int j = idx - 512, b = j >> 2, rem = j & 3; u.pm = rem >> 1; u.pn = rem & 1; u.x0 = b; u.x1 = 1;
            u.A = csc + (size_t)u.pm * 256 * 256; u.lda = 256; u.B = ut + (size_t)8 * 512 * 4096 + ((size_t)b * 512 + u.pn * 256) * 256; u.ldb = 256; u.K = 256; }
        return true; }
    __device__ __forceinline__ const bf16* a_row(const Unit& u, int row) const { return u.A + (size_t)row * u.lda; }
    __device__ __forceinline__ void epi(const Unit& u, int row, int c8, const float* v0, const float* v1) const {
        size_t r; int col;
        if (u.x1 == 0) { r = (size_t)u.x0 * 4096 + (u.pm & 15) * 256 + row; col = (u.pm >> 4) * 512 + u.pn * 256 + c8; }
        else { r = (size_t)NL + u.x0 * 256 + row; col = u.pm * 512 + u.pn * 256 + c8; }
        *(GAS v4u*)(g + r * D + col) = pack8(v0); *(GAS v4u*)(g + r * D + col + 128) = pack8(v1);
    }
};
struct PMerge {
    int G, c; const bf16 *gm, *y, *wf, *wr, *sgr, *sgf; bf16 *t1, *mg;
    __device__ __forceinline__ bool next(int i, Unit& u) const {
        const int tile = (i >> 1) * G + c; if (tile >= NPAN * 4) return false;
        u.pm = tile >> 2; u.pn = tile & 3; u.x0 = i & 1; u.lda = D; u.ldb = D; u.K = D;
        u.A = (u.x0 ? y : gm) + (size_t)u.pm * 256 * D; u.B = (u.x0 ? wr : wf) + (size_t)u.pn * 256 * D; return true; }
    __device__ __forceinline__ const bf16* a_row(const Unit& u, int row) const { return u.A + (size_t)row * D; }
    __device__ __forceinline__ void epi(const Unit& u, int row, int c8, const float* v0, const float* v1) const {
        const size_t o = ((size_t)u.pm * 256 + row) * D + u.pn * 256 + c8;
#pragma unroll
        for (int h = 0; h < 2; ++h) { const float* v = h ? v1 : v0; const size_t oo = o + h * 128; float s[8], r[8];
            if (u.x0 == 0) { unpack8(*(const GAS v4u*)(sgf + oo), s);
#pragma unroll
                for (int j = 0; j < 8; ++j) r[j] = s[j] * v[j];
                *(GAS v4u*)(t1 + oo) = pack8(r); }
            else { float t[8]; unpack8(*(const GAS v4u*)(sgr + oo), s); unpack8(*(const GAS v4u*)(t1 + oo), t);
#pragma unroll
                for (int j = 0; j < 8; ++j) r[j] = s[j] * v[j] + t[j];
                *(GAS v4u*)(mg + oo) = pack8(r); } }
    }
};
struct PWout {
    int G, c; const bf16 *mg, *wo; const float *xold_l, *xold_c; float *xnew_l, *xnew_c; const float* g1;
    __device__ __forceinline__ bool next(int i, Unit& u) const {
        const int idx = i * G + c; if (idx >= NPAN * 4) return false;
        u.pm = idx >> 2; u.pn = idx & 3; u.lda = D; u.ldb = D; u.K = D; u.A = mg + (size_t)u.pm * 256 * D; u.B = wo + (size_t)u.pn * 256 * D; return true; }
    __device__ __forceinline__ const bf16* a_row(const Unit& u, int row) const { return u.A + (size_t)row * D; }
    __device__ __forceinline__ void epi(const Unit& u, int row, int c8, const float* v0, const float* v1) const {
        const int r = u.pm * 256 + row; const int mb = mb_of(r);
        const float* xo = r < NL ? xold_l + (size_t)r * D : xold_c + (size_t)(r - NL) * D;
        float* xn = r < NL ? xnew_l + (size_t)r * D : xnew_c + (size_t)(r - NL) * D;
        const float* gg = g1 + (size_t)mb * NMOD * D;
#pragma unroll
        for (int h = 0; h < 2; ++h) { const float* v = h ? v1 : v0; const int col = u.pn * 256 + c8 + h * 128;
#pragma unroll
            for (int q = 0; q < 2; ++q) { const f32x4 xv = *(const GAS f32x4*)(xo + col + 4 * q), gv = *(const GAS f32x4*)(gg + col + 4 * q);
                f32x4 o; o[0] = xv[0] + gv[0] * v[4 * q]; o[1] = xv[1] + gv[1] * v[4 * q + 1]; o[2] = xv[2] + gv[2] * v[4 * q + 2]; o[3] = xv[3] + gv[3] * v[4 * q + 3];
                *(GAS f32x4*)(xn + col + 4 * q) = o; } }
    }
};
struct PMoe1 {
    int G, c; const bf16* hx2; const bf16* w; const int2* list; bf16* he; const LAS int* ts; const LAS int* cn;
    __device__ __forceinline__ bool next(int i, Unit& u) const {
        const int idx = i * G + c; if (idx >= ts[16] * 8) return false;
        const int tile = idx >> 3; u.pn = idx & 7; u.pm = tile; int e = 0;
#pragma unroll
        for (int j = 1; j < 16; ++j) e += (tile >= ts[j]) ? 1 : 0;
        u.x0 = e; u.x1 = (tile - ts[e]) * 256; u.x2 = cn[e];
        u.A = hx2; u.lda = D; u.B = w + (size_t)e * 3 * D * D + (size_t)u.pn * 256 * D; u.ldb = D; u.K = D; return true; }
    __device__ __forceinline__ const bf16* a_row(const Unit& u, int row) const {
        const int p = u.x1 + row; int r = 0; if (p < u.x2) r = list[(size_t)u.x0 * NT + p].x & 0x7fffffff; return hx2 + (size_t)r * D; }
    __device__ __forceinline__ void epi(const Unit& u, int row, int c8, const float* v0, const float* v1) const {
        float r[8];
#pragma unroll
        for (int j = 0; j < 8; ++j) r[j] = siluf_(v0[j]) * v1[j];
        *(GAS v4u*)(he + ((size_t)u.pm * 256 + row) * D + u.pn * 128 + c8) = pack8(r);
    }
};
struct PMoe2 {
    int G, c; const bf16* he; const bf16* w; const int2* list; bf16* c01; const LAS int* ts; const LAS int* cn;
    __device__ __forceinline__ bool next(int i, Unit& u) const {
        const int idx = i * G + c; if (idx >= ts[16] * 4) return false;
        const int tile = idx >> 2; u.pn = idx & 3; u.pm = tile; int e = 0;
#pragma unroll
        for (int j = 1; j < 16; ++j) e += (tile >= ts[j]) ? 1 : 0;
        u.x0 = e; u.x1 = (tile - ts[e]) * 256; u.x2 = cn[e];
        u.A = he + (size_t)tile * 256 * D; u.lda = D; u.B = w + (size_t)e * 3 * D * D + (size_t)2 * D * D + (size_t)u.pn * 256 * D; u.ldb = D; u.K = D; return true; }
    __device__ __forceinline__ const bf16* a_row(const Unit& u, int row) const { return u.A + (size_t)row * D; }
    __device__ __forceinline__ void epi(const Unit& u, int row, int c8, const float* v0, const float* v1) const {
        const int p = u.x1 + row; if (p >= u.x2) return;
        const int2 en = list[(size_t)u.x0 * NT + p]; const int r = en.x & 0x7fffffff, s = (en.x >> 31) & 1; const float w8 = __builtin_bit_cast(float, en.y);
        bf16* dst = c01 + ((size_t)s * NT + r) * D + u.pn * 256 + c8; float a[8], b[8];
#pragma unroll
        for (int j = 0; j < 8; ++j) { a[j] = w8 * v0[j]; b[j] = w8 * v1[j]; }
        *(GAS v4u*)dst = pack8(a); *(GAS v4u*)(dst + 128) = pack8(b);
    }
};

__device__ __forceinline__ void transpose_item(const float* W, int K, int N, bf16* WT, int k0, int n0, int drow0, LAS float* scr, int lane) {
#pragma unroll 8
    for (int i = 0; i < 32; ++i) { const int kk = 2 * i + (lane >> 5); scr[kk * 33 + (lane & 31)] = W[(size_t)(k0 + kk) * N + n0 + (lane & 31)]; }
    LDS_WAIT(); asm volatile("" ::: "memory");
    const int c = lane & 7;
#pragma unroll
    for (int j = 0; j < 4; ++j) { const int n = (lane >> 3) + 8 * j; const LAS float* s = scr + (8 * c) * 33 + n;
        v4u o; o.x = pk2(s[0 * 33], s[1 * 33]); o.y = pk2(s[2 * 33], s[3 * 33]); o.z = pk2(s[4 * 33], s[5 * 33]); o.w = pk2(s[6 * 33], s[7 * 33]);
        *(GAS v4u*)(WT + (size_t)(drow0 + n) * K + k0 + 8 * c) = o; }
    LDS_WAIT(); asm volatile("" ::: "memory");
}
__device__ __forceinline__ void p_prologue(Frame& F) {
    const int gw = F.bid * NWAVES + F.wave, NGW = F.G * NWAVES;
    LAS float* scr = (LAS float*)(F.lds + F.wave * 16384);
    constexpr int I_IN = 16 * 144, I_SQ = 16 * 32;
    constexpr int NIT = 2 * (I_IN + 2 * I_SQ);
    for (int it = gw; it < NIT; it += NGW) {
        int r = it; const int l = r / (I_IN + 2 * I_SQ); r -= l * (I_IN + 2 * I_SQ);
        if (r < I_IN) { const int kb = r / 144, nb = r % 144; transpose_item(F.kin[7] + (size_t)l * D * INW, D, INW, (bf16*)(F.ws + WS_WIN) + (size_t)l * INW * D, kb * 64, nb * 32, nb * 32, scr, F.lane); continue; }
        r -= I_IN;
        const int which = r / I_SQ; r -= which * I_SQ; const int kb = r / 32, nb = r % 32;
        transpose_item(F.kin[which ? 17 : 15] + (size_t)l * D * D, D, D, (bf16*)(F.ws + (which ? WS_WO : WS_WR)) + (size_t)l * D * D, kb * 64, nb * 32, nb * 32, scr, F.lane);
    }
    for (int o = F.bid * NTHR + F.tid; o < 2 * D * D; o += F.G * NTHR) {
        const int l = o >> 20, rem = o & (D * D - 1), kk = rem >> 10, n = rem & 1023;
        const int ch = kk & 511, g = ch >> 7, cc = ch & 127; const bool sn = kk >= 512;
        const float* wf = F.kin[16] + (size_t)l * 512 * D + (size_t)(g * 128) * D + n; float s = 0.f;
        for (int m = 0; m < 128; ++m) { const int ph = (cc * m) & 127; const float ang = (float)ph * (2.0f / 128.0f);
            const float co = sn ? -sinpif(ang) : cospif(ang); s += co * wf[(size_t)m * D]; }
        ((bf16*)(F.ws + WS_WF))[(size_t)l * D * D + (size_t)n * D + kk] = (bf16)f2bf(s);
    }
    { const float scl = 1.0f / sqrtf(4096.f * 128.f), scc = 1.0f / sqrtf(256.f * 128.f);
      for (size_t o = (size_t)F.bid * NTHR + F.tid; o < (size_t)8192 * 512; o += (size_t)F.G * NTHR) {
          const int r = (int)(o >> 9), t0 = (int)(o & 511) * 8, rr = r & 4095; float v[8];
#pragma unroll
          for (int j = 0; j < 8; ++j) { const int ph = (rr * (t0 + j)) & 4095; const float ang = (float)ph * (2.0f / 4096.0f); v[j] = (r < 4096 ? cospif(ang) : sinpif(ang)) * scl; }
          *(GAS v4u*)((bf16*)(F.ws + WS_CSL) + (size_t)r * 4096 + t0) = pack8(v); }
      for (int o = F.bid * NTHR + F.tid; o < 512 * 32; o += F.G * NTHR) {
          const int r = o >> 5, t0 = (o & 31) * 8, rr = r & 255; float v[8];
#pragma unroll
          for (int j = 0; j < 8; ++j) { const int ph = (rr * (t0 + j)) & 255; const float ang = (float)ph * (2.0f / 256.0f); v[j] = (r < 256 ? cospif(ang) : sinpif(ang)) * scc; }
          *(GAS v4u*)((bf16*)(F.ws + WS_CSC) + (size_t)r * 256 + t0) = pack8(v); } }
    for (int o = F.bid * NTHR + F.tid; o < 2 * 2 * 1024; o += F.G * NTHR) { const float lam = F.kin[14][o]; const float sp = (-lam > 20.f) ? -lam : log1pf(__expf(-lam));
        ((float*)(F.ws + WS_MODS + 512 * 1024))[o] = -8.0f * sp; }
    __syncthreads();
    { LAS float* sc = (LAS float*)(F.lds + 131072 - 9 * 1024 * 4);
      LAS float* red = (LAS float*)F.lds;
      for (int o = F.tid; o < 9 * 1024; o += NTHR) { const float cv = o < 8192 ? F.kin[1][o] : F.kin[3][o - 8192]; sc[o] = siluf_(cv); }
      __syncthreads();
      for (int it = F.bid; it < 2 * (NMOD * D / 64); it += F.G) {
          const int l = it / (NMOD * D / 64), n = (it % (NMOD * D / 64)) * 64 + F.lane; const float* w = F.kin[4] + (size_t)l * D * NMOD * D + n; float acc[9];
#pragma unroll
          for (int q = 0; q < 9; ++q) acc[q] = 0.f;
          for (int k = F.wave * 128; k < F.wave * 128 + 128; ++k) { const float wv = w[(size_t)k * NMOD * D];
#pragma unroll
              for (int q = 0; q < 9; ++q) acc[q] += sc[q * 1024 + k] * wv; }
#pragma unroll
          for (int q = 0; q < 9; ++q) red[(F.wave * 9 + q) * 64 + F.lane] = acc[q];
          __syncthreads();
          for (int o = F.tid; o < 9 * 64; o += NTHR) { const int q = o >> 6, ln = o & 63; float s = 0.f;
#pragma unroll
              for (int wv = 0; wv < 8; ++wv) s += red[(wv * 9 + q) * 64 + ln];
              const int nn = (it % (NMOD * D / 64)) * 64 + ln;
              ((float*)(F.ws + WS_MODS))[((size_t)(l * 9 + q)) * NMOD * D + nn] = s + F.kin[5][(size_t)l * NMOD * D + nn]; }
          __syncthreads();
      } }
}

__device__ __forceinline__ void p_norm1(Frame& F, int l) {
    const int gw = F.bid * NWAVES + F.wave, NGW = F.G * NWAVES;
    const float* gn = F.kin[6] + (size_t)l * D;
    bf16* hx = (bf16*)(F.ws + WS_RA); const bf16* c01 = (const bf16*)(F.ws + WS_C01);
    for (int r = gw; r < NT; r += NGW) {
        const int mb = mb_of(r);
        const float* src = l == 0 ? (r < NL ? F.kin[0] + (size_t)r * D : F.kin[2] + (size_t)(r - NL) * D)
                                  : (r < NL ? F.out + (size_t)r * D : (const float*)(F.ws + WS_HCTX) + (size_t)(r - NL) * D);
        f32x4 v[4]; float ss = 0.f;
#pragma unroll
        for (int j = 0; j < 4; ++j) v[j] = *(const GAS f32x4*)(src + F.lane * 4 + 256 * j);
        if (l == 1) { const float* g2 = modp(F, 0, mb, 5);
#pragma unroll
            for (int j = 0; j < 4; ++j) { const int k = F.lane * 4 + 256 * j; const v2u a = *(const GAS v2u*)(c01 + (size_t)r * D + k), b = *(const GAS v2u*)(c01 + ((size_t)NT + r) * D + k);
                const f32x4 gv = *(const GAS f32x4*)(g2 + k);
                v[j][0] += gv[0] * (bflo(a.x) + bflo(b.x)); v[j][1] += gv[1] * (bfhi(a.x) + bfhi(b.x)); v[j][2] += gv[2] * (bflo(a.y) + bflo(b.y)); v[j][3] += gv[3] * (bfhi(a.y) + bfhi(b.y));
                *(GAS f32x4*)((float*)src + k) = v[j]; } }
#pragma unroll
        for (int j = 0; j < 4; ++j) ss += (v[j][0] * v[j][0] + v[j][1] * v[j][1]) + (v[j][2] * v[j][2] + v[j][3] * v[j][3]);
        const float rstd = rsqrtf(wave_sum(ss) * (1.f / D) + RMS_EPS);
        const float *sh = modp(F, l, mb, 0), *sc = modp(F, l, mb, 1);
#pragma unroll
        for (int j = 0; j < 4; ++j) { const int k = F.lane * 4 + 256 * j; const f32x4 g = *(const GAS f32x4*)(gn + k), s1 = *(const GAS f32x4*)(sc + k), s0 = *(const GAS f32x4*)(sh + k);
            float o[4];
#pragma unroll
            for (int q = 0; q < 4; ++q) o[q] = v[j][q] * rstd * g[q] * (1.f + s1[q]) + s0[q];
            v2u w; w.x = pk2(o[0], o[1]); w.y = pk2(o[2], o[3]); *(GAS v2u*)(hx + (size_t)r * D + k) = w; }
    }
}
__device__ __forceinline__ void p_final(Frame& F) {
    const int gw = F.bid * NWAVES + F.wave, NGW = F.G * NWAVES;
    const bf16* c01 = (const bf16*)(F.ws + WS_C01);
    for (int r = gw; r < NL; r += NGW) {
        const int mb = r >> 12; float* src = F.out + (size_t)r * D; const float* g2 = modp(F, 1, mb, 5);
        f32x4 v[4]; float ss = 0.f;
#pragma unroll
        for (int j = 0; j < 4; ++j) { const int k = F.lane * 4 + 256 * j; v[j] = *(const GAS f32x4*)(src + k);
            const v2u a = *(const GAS v2u*)(c01 + (size_t)r * D + k), b = *(const GAS v2u*)(c01 + ((size_t)NT + r) * D + k); const f32x4 gv = *(const GAS f32x4*)(g2 + k);
            v[j][0] += gv[0] * (bflo(a.x) + bflo(b.x)); v[j][1] += gv[1] * (bfhi(a.x) + bfhi(b.x)); v[j][2] += gv[2] * (bflo(a.y) + bflo(b.y)); v[j][3] += gv[3] * (bfhi(a.y) + bfhi(b.y));
            ss += (v[j][0] * v[j][0] + v[j][1] * v[j][1]) + (v[j][2] * v[j][2] + v[j][3] * v[j][3]); }
        const float rstd = rsqrtf(wave_sum(ss) * (1.f / D) + RMS_EPS);
#pragma unroll
        for (int j = 0; j < 4; ++j) { const int k = F.lane * 4 + 256 * j; const f32x4 g = *(const GAS f32x4*)(F.kin[24] + k); f32x4 o;
#pragma unroll
            for (int q = 0; q < 4; ++q) o[q] = v[j][q] * rstd * g[q];
            *(GAS f32x4*)(src + k) = o; }
    }
}
__device__ __forceinline__ void p_transpose(Frame& F) {
    LAS bf16* tile = (LAS bf16*)F.lds;
    const bf16* uf = (const bf16*)(F.ws + WS_RF); bf16* ut = (bf16*)(F.ws + WS_RG);
    for (int it = F.bid; it < 4096 + 256; it += F.G) {
        int b, tb, cb, L; size_t rowbase; bf16* dst;
        if (it < 4096) { b = it >> 9; tb = (it >> 3) & 63; cb = it & 7; L = 4096; rowbase = (size_t)b * 4096 + tb * 64; dst = ut + (size_t)b * 512 * 4096; }
        else { const int j = it - 4096; b = j >> 5; tb = (j >> 3) & 3; cb = j & 7; L = 256; rowbase = (size_t)NL + b * 256 + tb * 64; dst = ut + (size_t)8 * 512 * 4096 + (size_t)b * 512 * 256; }
        { const int t = F.tid >> 3, c8 = (F.tid & 7) * 8; const v4u w = *(const GAS v4u*)(uf + (rowbase + t) * 512 + cb * 64 + c8);
          LAS unsigned* p = (LAS unsigned*)(tile + t * 72 + c8); p[0] = w.x; p[1] = w.y; p[2] = w.z; p[3] = w.w; }
        __syncthreads();
        { const int c = F.tid >> 3, t8 = (F.tid & 7) * 8; v4u o; unsigned h[8];
#pragma unroll
          for (int j = 0; j < 8; ++j) h[j] = tile[(t8 + j) * 72 + c];
          o.x = h[0] | (h[1] << 16); o.y = h[2] | (h[3] << 16); o.z = h[4] | (h[5] << 16); o.w = h[6] | (h[7] << 16);
          *(GAS v4u*)(dst + (size_t)(cb * 64 + c) * L + tb * 64 + t8) = o; }
        __syncthreads();
    }
}
__device__ __forceinline__ void p_scan_simple(Frame& F, int l) {
    if (F.bid >= 128) return;
    const int b = F.bid >> 4, h = (F.bid >> 1) & 7, d = F.bid & 1;
    LAS float* U = (LAS float*)F.lds;
    LAS float* RAg = U + 64 * 128;
    LAS float* XIg = RAg + 64 * 128;
    const bf16* urnn = (const bf16*)(F.ws + WS_RB);
    bf16* hout = (bf16*)(F.ws + (d ? WS_RF : WS_RA));
    const float* cw = F.kin[8] + (size_t)l * 4 * D + h * 128; const float* cb = F.kin[9] + (size_t)l * D + h * 128;
    const float* Wa = F.kin[10] + ((size_t)(l * 2 + d) * 8 + h) * 128 * 128; const float* Wx = F.kin[12] + ((size_t)(l * 2 + d) * 8 + h) * 128 * 128;
    const float* ba = F.kin[11] + ((size_t)(l * 2 + d) * 8 + h) * 128; const float* bx = F.kin[13] + ((size_t)(l * 2 + d) * 8 + h) * 128;
    const float* n8 = (const float*)(F.ws + WS_MODS + 512 * 1024) + (size_t)(l * 2 + d) * 1024 + h * 128;
    const int ch = F.tid & 127, tq = F.tid >> 7;
    float hstate = 0.f;
    for (int step = 0; step < 68; ++step) {
        const int j = d == 0 ? step : (step < 4 ? 3 - step : 71 - step);
        const bool isctx = j < 4; const size_t row0 = isctx ? (size_t)NL + b * 256 + j * 64 : (size_t)b * 4096 + (size_t)(j - 4) * 64;
        __syncthreads();
        for (int o = F.tid; o < 64 * 128; o += NTHR) { const int t = o >> 7, c = o & 127; float s = cb[c];
#pragma unroll
            for (int k = 0; k < 4; ++k) { const int tt = t + k - 2; bool ok; if (isctx) { const int g = j * 64 + tt; ok = g >= 0 && g < 256; } else ok = tt >= 0 && tt < 64;
                if (ok) s += cw[(size_t)k * D + c] * bf2f(urnn[(row0 + tt) * D + h * 128 + c]); }
            U[o] = s; }
        __syncthreads();
        { float ar[16], ax[16];
#pragma unroll
          for (int q = 0; q < 16; ++q) { ar[q] = 0.f; ax[q] = 0.f; }
          for (int k = 0; k < 128; ++k) { const float wa = Wa[(size_t)k * 128 + ch], wx = Wx[(size_t)k * 128 + ch];
#pragma unroll
              for (int q = 0; q < 16; ++q) { const float uv = U[(tq * 16 + q) * 128 + k]; ar[q] += uv * wa; ax[q] += uv * wx; } }
          const float bav = ba[ch], bxv = bx[ch], n8v = n8[ch];
#pragma unroll
          for (int q = 0; q < 16; ++q) { const int t = tq * 16 + q; const float r = sigmoidf_(ar[q] + bav), ig = sigmoidf_(ax[q] + bxv);
              const float la = n8v * r, a = __expf(la), y2 = 2.f * la;
              const float om = (y2 > -0.02f) ? -(y2 * (1.f + y2 * (0.5f + y2 * (1.f / 6.f)))) : 1.f - __expf(y2);
              RAg[t * 128 + ch] = a; XIg[t * 128 + ch] = sqrtf(om) * ig * U[t * 128 + ch]; } }
        __syncthreads();
        if (F.tid < 128) {
            for (int q = 0; q < 64; ++q) { const int t = d == 0 ? q : 63 - q; hstate = RAg[t * 128 + ch] * hstate + XIg[t * 128 + ch]; RAg[t * 128 + ch] = hstate; } }
        __syncthreads();
        for (int o = F.tid; o < 64 * 16; o += NTHR) { const int t = o >> 4, c8 = (o & 15) * 8; float v[8];
#pragma unroll
            for (int q = 0; q < 8; ++q) v[q] = RAg[t * 128 + c8 + q];
            *(GAS v4u*)(hout + (row0 + t) * D + h * 128 + c8) = pack8(v); }
    }
}
__device__ __forceinline__ void p_ycombine(Frame& F) {
    bf16* hf = (bf16*)(F.ws + WS_RA); const bf16* hb = (const bf16*)(F.ws + WS_RF); const bf16* gt = (const bf16*)(F.ws + WS_RC);
    for (size_t o = ((size_t)F.bid * NTHR + F.tid) * 8; o < (size_t)NT * D; o += (size_t)F.G * NTHR * 8) {
        float a[8], b[8], g[8]; unpack8(*(const GAS v4u*)(hf + o), a); unpack8(*(const GAS v4u*)(hb + o), b); unpack8(*(const GAS v4u*)(gt + o), g);
#pragma unroll
        for (int j = 0; j < 8; ++j) a[j] = (a[j] + b[j]) * g[j];
        *(GAS v4u*)(hf + o) = pack8(a); }
}
__device__ __forceinline__ void p_norm2_route(Frame& F, int l) {
    LAS float* RW = (LAS float*)F.lds;
    LAS int* lcnt = (LAS int*)(F.lds + 65536);
    LAS int* rinfo = lcnt + 64;
    const int rpb = (NT + F.G - 1) / F.G, r0 = F.bid * rpb, r1 = (r0 + rpb < NT) ? r0 + rpb : NT;
    for (int o = F.tid; o < 1024 * 16; o += NTHR) RW[o] = F.kin[19][o];
    if (F.tid < 32) lcnt[F.tid] = 0;
    __syncthreads();
    const float* gn = F.kin[18] + (size_t)l * D; bf16* hx2 = (bf16*)(F.ws + WS_RA);
    float rb[16];
#pragma unroll
    for (int e = 0; e < 16; ++e) rb[e] = F.kin[20][e];
    for (int r = r0 + F.wave; r < r1; r += NWAVES) {
        const int mb = mb_of(r);
        const float* src = r < NL ? F.out + (size_t)r * D : (const float*)(F.ws + WS_HCTX) + (size_t)(r - NL) * D;
        f32x4 v[4]; float ss = 0.f;
#pragma unroll
        for (int j = 0; j < 4; ++j) { v[j] = *(const GAS f32x4*)(src + F.lane * 4 + 256 * j); ss += (v[j][0] * v[j][0] + v[j][1] * v[j][1]) + (v[j][2] * v[j][2] + v[j][3] * v[j][3]); }
        const float rstd = rsqrtf(wave_sum(ss) * (1.f / D) + RMS_EPS);
        const float *sh = modp(F, l, mb, 3), *sc = modp(F, l, mb, 4);
        float lg[16];
#pragma unroll
        for (int e = 0; e < 16; ++e) lg[e] = 0.f;
#pragma unroll
        for (int j = 0; j < 4; ++j) { const int k = F.lane * 4 + 256 * j; const f32x4 g = *(const GAS f32x4*)(gn + k), s1 = *(const GAS f32x4*)(sc + k), s0 = *(const GAS f32x4*)(sh + k);
            float o[4];
#pragma unroll
            for (int q = 0; q < 4; ++q) { o[q] = v[j][q] * rstd * g[q] * (1.f + s1[q]) + s0[q];
                const LAS f32x4* rw = (const LAS f32x4*)(RW + (k + q) * 16);
#pragma unroll
                for (int e4 = 0; e4 < 4; ++e4) { const f32x4 w = rw[e4]; lg[4 * e4] += o[q] * w[0]; lg[4 * e4 + 1] += o[q] * w[1]; lg[4 * e4 + 2] += o[q] * w[2]; lg[4 * e4 + 3] += o[q] * w[3]; } }
            v2u w; w.x = pk2(o[0], o[1]); w.y = pk2(o[2], o[3]); *(GAS v2u*)(hx2 + (size_t)r * D + k) = w; }
        float aff[16], sel[16];
#pragma unroll
        for (int e = 0; e < 16; ++e) { lg[e] = wave_sum(lg[e]); aff[e] = sigmoidf_(lg[e]); sel[e] = aff[e] + rb[e]; }
        int grp = 0; float best = -1e30f;
#pragma unroll
        for (int g = 0; g < 4; ++g) { const float a = sel[4 * g], b = sel[4 * g + 1], c = sel[4 * g + 2], dd = sel[4 * g + 3];
            const float s = fmaxf(fmaxf(fmaxf(a + b, a + c), fmaxf(a + dd, b + c)), fmaxf(b + dd, c + dd));
            if (s > best) { best = s; grp = g; } }
        float s4[4], a4[4];
#pragma unroll
        for (int q = 0; q < 4; ++q) { s4[q] = grp == 0 ? sel[q] : grp == 1 ? sel[4 + q] : grp == 2 ? sel[8 + q] : sel[12 + q]; a4[q] = grp == 0 ? aff[q] : grp == 1 ? aff[4 + q] : grp == 2 ? aff[8 + q] : aff[12 + q]; }
        int i0 = 0; float m0 = s4[0], af0 = a4[0];
#pragma unroll
        for (int q = 1; q < 4; ++q) if (s4[q] > m0) { m0 = s4[q]; i0 = q; af0 = a4[q]; }
        int i1 = -1; float m1 = -1e30f, af1 = 0.f;
#pragma unroll
        for (int q = 0; q < 4; ++q) if (q != i0 && s4[q] > m1) { m1 = s4[q]; i1 = q; af1 = a4[q]; }
        const int e0 = grp * 4 + i0, e1 = grp * 4 + i1; const float inv = 1.f / (af0 + af1);
        if (F.lane == 0) { const int lr0 = __hip_atomic_fetch_add(lcnt + e0, 1, __ATOMIC_RELAXED, __HIP_MEMORY_SCOPE_WORKGROUP), lr1 = __hip_atomic_fetch_add(lcnt + e1, 1, __ATOMIC_RELAXED, __HIP_MEMORY_SCOPE_WORKGROUP);
            LAS int* ri = rinfo + (r - r0) * 5; ri[0] = e0 | (e1 << 8); ri[1] = lr0; ri[2] = lr1; ri[3] = __builtin_bit_cast(int, af0 * inv); ri[4] = __builtin_bit_cast(int, af1 * inv); }
    }
    __syncthreads();
    if (F.tid < 16) lcnt[16 + F.tid] = (int)__hip_atomic_fetch_add(F.ctl + CW_CNT + 64 * l + F.tid, (unsigned)lcnt[F.tid], __ATOMIC_RELAXED, __HIP_MEMORY_SCOPE_AGENT);
    __syncthreads();
    int2* list = (int2*)(F.ws + WS_LIST);
    for (int rl = F.tid; rl < r1 - r0; rl += NTHR) { const LAS int* ri = rinfo + rl * 5; const int e0 = ri[0] & 255, e1 = ri[0] >> 8, r = r0 + rl;
        list[(size_t)e0 * NT + lcnt[16 + e0] + ri[1]] = make_int2(r, ri[3]);
        list[(size_t)e1 * NT + lcnt[16 + e1] + ri[2]] = make_int2(r | (int)0x80000000, ri[4]); }
    __syncthreads();
    { const int gw = F.bid * NWAVES + F.wave, NGW = F.G * NWAVES; LAS float* scr = (LAS float*)(F.lds + F.wave * 16384);
      bf16* mw = (bf16*)(F.ws + WS_MOEW);
      for (int it = gw; it < 16 * 3 * 512; it += NGW) { const int e = it / 1536, rem = it % 1536, m = rem / 512, q = rem % 512, kb = q >> 5, nb = q & 31;
          const float* W = F.kin[m == 0 ? 21 : m == 1 ? 22 : 23] + ((size_t)l * 16 + e) * D * D; bf16* dst = mw + (size_t)e * 3 * D * D + (m == 2 ? (size_t)2 * D * D : 0);
          const int n0 = nb * 32; const int drow = m == 2 ? n0 : ((n0 >> 7) * 256 + (m == 1 ? 128 : 0) + (n0 & 127));
          transpose_item(W, D, D, dst, kb * 64, n0, drow, scr, F.lane); } }
}
__device__ __forceinline__ void moe_table(Frame& F, int l, LAS int* ts, LAS int* cn) {
    __syncthreads();
    if (F.tid == 0) { int acc = 0;
        for (int e = 0; e < 16; ++e) { const int c = (int)__hip_atomic_load(F.ctl + CW_CNT + 64 * l + e, __ATOMIC_RELAXED, __HIP_MEMORY_SCOPE_AGENT); cn[e] = c; ts[e] = acc; acc += (c + 255) >> 8; }
        ts[16] = acc; }
    __syncthreads();
}

constexpr int NPH = 24;
struct Args { const float* in[25]; float* out; unsigned char* ws; int ph_lo, ph_hi; };
__global__ void __launch_bounds__(NTHR, 2) fwd_kernel(Args args) {
    extern __shared__ __attribute__((aligned(16))) unsigned char lds[];
    Frame F;
    F.lds = (LAS unsigned char*)lds; F.tid = threadIdx.x; F.lane = F.tid & 63; F.wave = __builtin_amdgcn_readfirstlane(F.tid >> 6);
    F.G = gridDim.x; F.bid = blockIdx.x; F.ws = args.ws; F.out = args.out; F.ctl = (unsigned*)(args.ws + WS_CTL);
    F.kin = (const float* const __attribute__((address_space(4)))*)__builtin_amdgcn_kernarg_segment_ptr();
    volatile LAS unsigned* MISC = (volatile LAS unsigned*)(F.lds + MISC_OFF);
    if (F.tid < 32) MISC[F.tid] = 0u;
    __syncthreads();
    XcdBarrier bar; bar.bar = F.ctl + CW_BAR; bar.x = 0; bar.st = nullptr;
    if (MK_N_LAUNCHES == 1) bar = xcd_barrier_post(F.ctl + CW_BAR, MISC + 8);
    LAS int* ts = (LAS int*)(F.lds + MISC_OFF + 256); LAS int* cn = ts + 32;
    const int lo = args.ph_lo, hi = args.ph_hi;
#ifndef SITE_MASK
#define SITE_MASK 0xfffffu
#endif
#define SITE(j) (((SITE_MASK) >> (j)) & 1u)
#define IN(k) (lo <= (k) && (k) < hi)
#define LAUNDER() asm volatile("" : "+s"(F.ws), "+s"(F.out), "+s"(F.kin), "+s"(F.ctl), "+s"(F.lds), "+s"(F.wave), "+s"(F.bid), "+s"(F.G), "+v"(F.tid), "+v"(F.lane))
#define SEAM(k) do { if (MK_N_LAUNCHES == 1 && IN((k) + 1)) xcd_barrier(bar); } while (0)

    if (SITE(0) && IN(0)) { LAUNDER(); p_prologue(F); SEAM(0); }
    for (int l = 0; l < 2; ++l) {
        const int pb = 1 + 11 * l;
        if (SITE(1) && IN(pb + 0)) { LAUNDER(); p_norm1(F, l); SEAM(pb + 0); }
        if (SITE(2) && IN(pb + 1)) { LAUNDER();
            PInproj p; p.G = F.G; p.c = F.bid; p.l = l; p.hx = (const bf16*)(F.ws + WS_RA); p.wt = (const bf16*)(F.ws + WS_WIN) + (size_t)l * INW * D;
            p.urnn = (bf16*)(F.ws + WS_RB); p.gate = (bf16*)(F.ws + WS_RC); p.ufour = (bf16*)(F.ws + WS_RF); p.sgr = (bf16*)(F.ws + WS_RD); p.sgf = (bf16*)(F.ws + WS_RE);
            simple_gemm_phase(F, p); SEAM(pb + 1); }
        if (SITE(3) && IN(pb + 2)) { LAUNDER(); p_transpose(F); SEAM(pb + 2); }
        if (SITE(4) && IN(pb + 3)) { LAUNDER();
            PDft p; p.G = F.G; p.c = F.bid; p.csl = (const bf16*)(F.ws + WS_CSL); p.csc = (const bf16*)(F.ws + WS_CSC); p.ut = (const bf16*)(F.ws + WS_RG); p.g = (bf16*)(F.ws + WS_RH);
            simple_gemm_phase(F, p); SEAM(pb + 3); }
        if (SITE(5) && IN(pb + 4)) { LAUNDER(); p_scan_simple(F, l); SEAM(pb + 4); }
        if (SITE(6) && IN(pb + 5)) { LAUNDER(); p_ycombine(F); SEAM(pb + 5); }
        if (SITE(7) && IN(pb + 6)) { LAUNDER();
            PMerge p; p.G = F.G; p.c = F.bid; p.gm = (const bf16*)(F.ws + WS_RH); p.y = (const bf16*)(F.ws + WS_RA); p.wf = (const bf16*)(F.ws + WS_WF) + (size_t)l * D * D; p.wr = (const bf16*)(F.ws + WS_WR) + (size_t)l * D * D;
            p.sgr = (const bf16*)(F.ws + WS_RD); p.sgf = (const bf16*)(F.ws + WS_RE); p.t1 = (bf16*)(F.ws + WS_RB); p.mg = (bf16*)(F.ws + WS_RC);
            simple_gemm_phase(F, p); SEAM(pb + 6); }
        if (SITE(8) && IN(pb + 7)) { LAUNDER();
            PWout p; p.G = F.G; p.c = F.bid; p.mg = (const bf16*)(F.ws + WS_RC); p.wo = (const bf16*)(F.ws + WS_WO) + (size_t)l * D * D;
            p.xold_l = l == 0 ? F.kin[0] : F.out; p.xold_c = l == 0 ? F.kin[2] : (const float*)(F.ws + WS_HCTX); p.xnew_l = F.out; p.xnew_c = (float*)(F.ws + WS_HCTX); p.g1 = modp(F, l, 0, 2);
            simple_gemm_phase(F, p); SEAM(pb + 7); }
        if (SITE(9) && IN(pb + 8)) { LAUNDER(); p_norm2_route(F, l); SEAM(pb + 8); }
        if (SITE(10) && IN(pb + 9)) { LAUNDER();
            moe_table(F, l, ts, cn);
            PMoe1 p; p.G = F.G; p.c = F.bid; p.hx2 = (const bf16*)(F.ws + WS_RA); p.w = (const bf16*)(F.ws + WS_MOEW); p.list = (const int2*)(F.ws + WS_LIST); p.he = (bf16*)(F.ws + WS_HE); p.ts = ts; p.cn = cn;
            simple_gemm_phase(F, p); SEAM(pb + 9); }
        if (SITE(11) && IN(pb + 10)) { LAUNDER();
            moe_table(F, l, ts, cn);
            PMoe2 p; p.G = F.G; p.c = F.bid; p.he = (const bf16*)(F.ws + WS_HE); p.w = (const bf16*)(F.ws + WS_MOEW); p.list = (const int2*)(F.ws + WS_LIST); p.c01 = (bf16*)(F.ws + WS_C01); p.ts = ts; p.cn = cn;
            simple_gemm_phase(F, p); SEAM(pb + 10); }
    }
    if (SITE(12) && IN(23)) { LAUNDER(); p_final(F); }
#undef IN
#undef SEAM
}

extern "C" void kernel_launch(void* const* d_in, const int* in_sizes, int n_in, void* d_out, int out_size, void* d_ws, size_t ws_size, hipStream_t stream) {
    static int grid = 0;
    if (grid == 0) {
        if (n_in != 25 || out_size != NL * D || ws_size < WS_END) { fprintf(stderr, "kernel_launch: unexpected shapes (n_in %d, out %d, ws %zu)\n", n_in, out_size, ws_size); grid = -1; return; }
        int dev = 0, cus = 0, per_cu = 0;
        if (hipGetDevice(&dev) != hipSuccess || hipDeviceGetAttribute(&cus, hipDeviceAttributeMultiprocessorCount, dev) != hipSuccess) { grid = -1; return; }
        if (hipFuncSetAttribute((const void*)fwd_kernel, hipFuncAttributeMaxDynamicSharedMemorySize, LDS_BYTES) != hipSuccess) { fprintf(stderr, "kernel_launch: hipFuncSetAttribute failed\n"); grid = -1; return; }
        if (hipOccupancyMaxActiveBlocksPerMultiprocessor(&per_cu, (const void*)fwd_kernel, NTHR, LDS_BYTES) != hipSuccess || per_cu < 1) { fprintf(stderr, "kernel_launch: occupancy query says %d\n", per_cu); }
        (void)hipGetLastError();
        grid = cus;
    }
    if (grid < 0) return;
    (void)hipMemsetAsync((char*)d_ws + WS_CTL, 0, CTL_ZERO_BYTES, stream);
    Args a{};
    for (int i = 0; i < 25; ++i) a.in[i] = (const float*)d_in[i];
    a.out = (float*)d_out; a.ws = (unsigned char*)d_ws;
    if (MK_N_LAUNCHES == 1) { a.ph_lo = 0; a.ph_hi = NPH; hipLaunchKernelGGL(fwd_kernel, dim3(grid), dim3(NTHR), LDS_BYTES, stream, a); }
    else for (int p = 0; p < NPH; ++p) { a.ph_lo = p; a.ph_hi = p + 1; hipLaunchKernelGGL(fwd_kernel, dim3(grid), dim3(NTHR), LDS_BYTES, stream, a); }
}
```

```cpp
#include <hip/hip_runtime.h>
#include <cstdio>
#include <cstdint>

#ifndef MK_N_LAUNCHES
#define MK_N_LAUNCHES 1
#endif

#define GAS __attribute__((address_space(1)))
#define LAS __attribute__((address_space(3)))
typedef unsigned short bf16;
typedef unsigned v4u __attribute__((ext_vector_type(4)));
typedef unsigned v2u __attribute__((ext_vector_type(2)));
typedef float f32x4 __attribute__((ext_vector_type(4)));
typedef short bf16x8 __attribute__((ext_vector_type(8)));

constexpr int D = 1024, NB = 8, SEQ = 4096, CTX = 256, NL = NB * SEQ, NC = NB * CTX, NT = NL + NC;
constexpr int NPAN = NT / 256;
constexpr int INW = 4608, NE = 16, NMOD = 6;
constexpr float RMS_EPS = 1e-6f;
constexpr int NWAVES = 8, NTHR = 512;

constexpr size_t MiB = 1u << 20;
constexpr size_t WS_CTL = 0, CTL_ZERO_BYTES = 1 * MiB;
constexpr size_t WS_MODS = 1 * MiB;
constexpr size_t WS_WIN = 2 * MiB;
constexpr size_t WS_WR = 20 * MiB, WS_WF = 24 * MiB, WS_WO = 28 * MiB;
constexpr size_t WS_LRU = 32 * MiB;
constexpr size_t WS_CSC = 34 * MiB;
constexpr size_t WS_HCTX = 35 * MiB;
constexpr size_t WS_LIST = 43 * MiB;
constexpr size_t WS_CSL = 48 * MiB;
constexpr size_t WS_RA = 112 * MiB;
constexpr size_t WS_RB = 180 * MiB;
constexpr size_t WS_RC = 248 * MiB;
constexpr size_t WS_RD = 316 * MiB;
constexpr size_t WS_RE = 384 * MiB;
constexpr size_t WS_RF = 452 * MiB;
constexpr size_t WS_RG = 486 * MiB;
constexpr size_t WS_RH = 520 * MiB;
constexpr size_t WS_END = 588 * MiB;
constexpr size_t WS_MOEW = 180 * MiB;
constexpr size_t WS_HE = 276 * MiB;
constexpr size_t WS_C01 = 420 * MiB;
static_assert(WS_C01 + (size_t)2 * NT * D * 2 <= WS_END, "map");
static_assert(WS_RA + (size_t)NT * D * 2 <= WS_RB && WS_RH + (size_t)NT * D * 2 <= WS_END, "map");

constexpr int CW_TMO = 0;
constexpr int CW_CNT = 64;
constexpr int CW_BAR = 4096;

constexpr int LDS_BYTES = 147456;
constexpr int MISC_OFF = 131072 + 8192;

__device__ __forceinline__ unsigned f2bf(float f) { unsigned u = __builtin_bit_cast(unsigned, f); return (u + 0x7fffu + ((u >> 16) & 1u)) >> 16; }
__device__ __forceinline__ unsigned pk2(float lo, float hi) { return f2bf(lo) | (f2bf(hi) << 16); }
__device__ __forceinline__ float bflo(unsigned w) { return __builtin_bit_cast(float, w << 16); }
__device__ __forceinline__ float bfhi(unsigned w) { return __builtin_bit_cast(float, w & 0xffff0000u); }
__device__ __forceinline__ float bf2f(bf16 h) { return __builtin_bit_cast(float, ((unsigned)h) << 16); }
__device__ __forceinline__ v4u pack8(const float* v) { v4u o; o.x = pk2(v[0], v[1]); o.y = pk2(v[2], v[3]); o.z = pk2(v[4], v[5]); o.w = pk2(v[6], v[7]); return o; }
__device__ __forceinline__ void unpack8(v4u w, float* v) { v[0] = bflo(w.x); v[1] = bfhi(w.x); v[2] = bflo(w.y); v[3] = bfhi(w.y); v[4] = bflo(w.z); v[5] = bfhi(w.z); v[6] = bflo(w.w); v[7] = bfhi(w.w); }
__device__ __forceinline__ float sigmoidf_(float x) { return 1.f / (1.f + __expf(-x)); }
__device__ __forceinline__ float siluf_(float x) { return x / (1.f + __expf(-x)); }
__device__ __forceinline__ float gelu_tanh(float x) { const float u = 0.7978845608028654f * (x + 0.044715f * x * x * x); const float e = __expf(2.f * u); const float t = 1.f - 2.f / (e + 1.f); return 0.5f * x * (1.f + t); }
__device__ __forceinline__ float wave_sum(float v, int lane) {
#pragma unroll
    for (int o = 1; o < 64; o <<= 1) v += __builtin_bit_cast(float, __builtin_amdgcn_ds_bpermute((lane ^ o) << 2, __builtin_bit_cast(int, v)));
    return v;
}
#define LDS_WAIT() asm volatile("s_waitcnt lgkmcnt(0)" ::: "memory")
#define VM_WAIT() asm volatile("s_waitcnt vmcnt(0)" ::: "memory")

#define XB_TMO      128
#define XB_XCNT(j)  (256  + 64 * (j))
#define XB_XSUB(j)  (1280 + 64 * (j))
#define XB_XGEN(j)  (2304 + 64 * (j))
#define XB_TOP      3328
#define XB_TOPGEN   3392
#define XCD_BAR_WORDS 3456
#define XB_SPIN_CAP (1u << 18)
__device__ __forceinline__ unsigned xb_ld(unsigned* p)              { return __hip_atomic_load(p, __ATOMIC_RELAXED, __HIP_MEMORY_SCOPE_AGENT); }
__device__ __forceinline__ unsigned xb_add(unsigned* p, unsigned v) { return __hip_atomic_fetch_add(p, v, __ATOMIC_RELAXED, __HIP_MEMORY_SCOPE_AGENT); }
__device__ __forceinline__ unsigned xb_xcc_id() { return (unsigned)__builtin_amdgcn_s_getreg((3 << 11) | 20) & 0xFu; }
#define XB_SPIN(cond, bar) do { unsigned _sp = 0; while (cond) { __builtin_amdgcn_s_sleep(1); \
    if ((++_sp & 255u) == 0u) { if (xb_ld(&(bar)[XB_TMO])) break; if (_sp > XB_SPIN_CAP) { atomicAdd(&(bar)[XB_TMO], 1u); break; } } } } while (0)
struct XcdBarrier { unsigned* bar; unsigned x; volatile LAS unsigned* st; };
__device__ __forceinline__ XcdBarrier xcd_barrier_post(unsigned* bar, volatile LAS unsigned* st) {
    XcdBarrier b; b.bar = bar; b.x = xb_xcc_id(); b.st = st;
    if (threadIdx.x == 0) (void)xb_add(&bar[XB_XCNT(b.x)], 1u);
    return b;
}
__device__ __forceinline__ void xcd_barrier_complete(unsigned* bar, unsigned x, unsigned& nloc, unsigned& nx) {
    const unsigned G = gridDim.x * gridDim.y * gridDim.z;
    unsigned sum, cnt, mine, sp = 0u;
    for (;;) {
        sum = 0u; cnt = 0u; mine = 0u;
#pragma unroll
        for (unsigned j = 0; j < 16; ++j) { const unsigned c = xb_ld(&bar[XB_XCNT(j)]); sum += c; cnt += (c > 0u) ? 1u : 0u; mine = (j == x) ? c : mine; }
        if (sum == G) break;
        __builtin_amdgcn_s_sleep(1);
        if ((++sp & 255u) == 0u) { if (xb_ld(&bar[XB_TMO])) break; if (sp > XB_SPIN_CAP) { atomicAdd(&bar[XB_TMO], 1u); break; } }
    }
    nloc = mine > 0u ? mine : 1u; nx = cnt > 0u ? cnt : 1u;
}
__device__ __forceinline__ void xcd_barrier(const XcdBarrier& b) {
    asm volatile("s_waitcnt vmcnt(0)" ::: "memory");
    __syncthreads();
    if (threadIdx.x == 0) {
        unsigned* bar = b.bar;
        __builtin_amdgcn_s_waitcnt(0);
        unsigned nloc = b.st[0], nx = b.st[1];
        if (nloc == 0u) { xcd_barrier_complete(bar, b.x, nloc, nx); b.st[0] = nloc; b.st[1] = nx; }
        const unsigned old = xb_add(&bar[XB_XSUB(b.x)], 1u);
        const unsigned gen = old / nloc;
        if (old + 1u == (gen + 1u) * nloc) {
            __builtin_amdgcn_fence(__ATOMIC_RELEASE, "agent");
            asm volatile("s_waitcnt vmcnt(0)" ::: "memory");
            const unsigned og = xb_add(&bar[XB_TOP], 1u);
            const unsigned tg = og / nx;
            if (og + 1u == (tg + 1u) * nx) xb_add(&bar[XB_TOPGEN], 1u);
            else XB_SPIN(xb_ld(&bar[XB_TOPGEN]) == tg, bar);
            __builtin_amdgcn_fence(__ATOMIC_ACQUIRE, "agent");
            xb_add(&bar[XB_XGEN(b.x)], 1u);
            asm volatile("s_waitcnt vmcnt(0)" ::: "memory");
        } else {
            XB_SPIN(xb_ld(&bar[XB_XGEN(b.x)]) == gen, bar);
            __builtin_amdgcn_fence(__ATOMIC_ACQUIRE, "agent");
            asm volatile("s_waitcnt vmcnt(0)" ::: "memory");
        }
    }
    __syncthreads();
}

struct Frame {
    LAS unsigned char* lds;
    int tid, lane, wave, G, bid;
    unsigned* ctl;
    const float* const __attribute__((address_space(4)))* kin;
    float* out;
    unsigned char* ws;
};
__device__ __forceinline__ const float* modp(const Frame& F, int l, int mb, int which) { return (const float*)(F.ws + WS_MODS) + ((size_t)(l * 9 + mb) * NMOD + which) * D; }
__device__ __forceinline__ int mb_of(int r) { return r < NL ? (r >> 12) : 8; }

struct Unit { const bf16* A; const bf16* B; int lda, ldb, K; int pm, pn, x0, x1, x2; };

template <class P> __device__ __forceinline__ void simple_gemm_phase(Frame& F, const P& p) {
    LAS float* As = (LAS float*)F.lds;
    LAS float* Bs = As + 32 * 128;
    const int tid = F.tid, rg = tid >> 4, cg = tid & 15;
    Unit u;
    for (int i = 0; p.next(i, u); ++i) {
        for (int half = 0; half < 2; ++half) {
            float acc[4][16];
#pragma unroll
            for (int a = 0; a < 4; ++a)
#pragma unroll
                for (int b = 0; b < 16; ++b) acc[a][b] = 0.f;
            const int arow_i = tid >> 2, ak = (tid & 3) * 8, brow_i = tid >> 1, bk = (tid & 1) * 16;
            const bf16* arow = p.a_row(u, half * 128 + arow_i);
            const bf16* brow = u.B + (size_t)brow_i * u.ldb;
            for (int k0 = 0; k0 < u.K; k0 += 32) {
                const v4u a0 = *(const GAS v4u*)(arow + k0 + ak);
                const v4u b0 = *(const GAS v4u*)(brow + k0 + bk), b1 = *(const GAS v4u*)(brow + k0 + bk + 8);
                __syncthreads();
                float t[8];
                unpack8(a0, t);
#pragma unroll
                for (int j = 0; j < 8; ++j) As[(ak + j) * 128 + arow_i] = t[j];
                unpack8(b0, t);
#pragma unroll
                for (int j = 0; j < 8; ++j) Bs[(bk + j) * 256 + brow_i] = t[j];
                unpack8(b1, t);
#pragma unroll
                for (int j = 0; j < 8; ++j) Bs[(bk + 8 + j) * 256 + brow_i] = t[j];
                __syncthreads();
#pragma unroll 2
                for (int k = 0; k < 32; ++k) {
                    const f32x4 x0 = *(const LAS f32x4*)(As + k * 128 + rg * 4);
                    const f32x4 y0 = *(const LAS f32x4*)(Bs + k * 256 + cg * 8), y1 = *(const LAS f32x4*)(Bs + k * 256 + cg * 8 + 4);
                    const f32x4 y2 = *(const LAS f32x4*)(Bs + k * 256 + 128 + cg * 8), y3 = *(const LAS f32x4*)(Bs + k * 256 + 128 + cg * 8 + 4);
                    const float xa[4] = {x0[0], x0[1], x0[2], x0[3]};
                    const float yb[16] = {y0[0], y0[1], y0[2], y0[3], y1[0], y1[1], y1[2], y1[3], y2[0], y2[1], y2[2], y2[3], y3[0], y3[1], y3[2], y3[3]};
#pragma unroll
                    for (int a = 0; a < 4; ++a)
#pragma unroll
                        for (int b = 0; b < 16; ++b) acc[a][b] = __builtin_fmaf(xa[a], yb[b], acc[a][b]);
                }
            }
#pragma unroll
            for (int a = 0; a < 4; ++a) p.epi(u, half * 128 + rg * 4 + a, cg * 8, &acc[a][0], &acc[a][8]);
        }
    }
    __syncthreads();
}

constexpr int HTB = 128 * 64 * 2;
__device__ __forceinline__ int lds_byte(int r, int c) { const int st = (r >> 4) * 2 + (c >> 5), rr = r & 15, cc = c & 31, ob = rr * 64 + cc * 2; return st * 1024 + (ob ^ (((ob >> 9) & 1) << 5)); }
__device__ __forceinline__ void stage_rc(int b, int& R, int& C) { const int st = b / 1024, sb = b % 1024, swz = sb ^ (((sb >> 9) & 1) << 5); R = (st >> 1) * 16 + swz / 64; C = (st & 1) * 32 + (swz % 64) / 2; }
__device__ __forceinline__ int perm32(int rho) { const int n = rho >> 4, i = rho & 15; return 8 * (i >> 2) + 4 * n + (i & 3); }
template <class P> __device__ __forceinline__ void fast_gemm_phase(Frame& F, const P& p) {
    LAS unsigned char* lds = F.lds;
    const int tid = F.tid, wid = F.wave, lane = F.lane, wr = wid >> 2, wc = wid & 3, fr = lane & 15, fq = lane >> 4;
    int R0, C0, R1, C1; stage_rc(tid * 16, R0, C0); stage_rc(tid * 16 + 8192, R1, C1);
    const int Rb0 = (R0 & ~31) + perm32(R0 & 31), Rb1 = (R1 & ~31) + perm32(R1 & 31);
    const unsigned ldsw = (unsigned)wid * 1024u;
    const int aoffL = lds_byte(wr * 64 + fr, fq * 8), boffL = lds_byte(wc * 32 + fr, fq * 8);
    Unit cur, nxt; int ui = 0;
    if (!p.next(0, cur)) return;
    const char* sA; const char* sB; unsigned sa00, sa01, sa10, sa11, sb0, sb1; size_t shB;
#define FG_SET(u) do { sA = (const char*)(u).A; sB = (const char*)(u).B; shB = (size_t)128 * (u).ldb * 2; \
        sa00 = p.a_off((u), R0) + C0 * 2; sa01 = p.a_off((u), R1) + C1 * 2; sa10 = p.a_off((u), 128 + R0) + C0 * 2; sa11 = p.a_off((u), 128 + R1) + C1 * 2; \
        sb0 = (unsigned)(Rb0 * (u).ldb + C0) * 2u; sb1 = (unsigned)(Rb1 * (u).ldb + C1) * 2u; } while (0)
#define FG_SA(b, h) (((b) * 2 + (h)) * HTB)
#define FG_SB(b, h) ((4 + (b) * 2 + (h)) * HTB)
#define FG_GLDS(src, bufoff, i) __builtin_amdgcn_global_load_lds((const unsigned*)(src), (LAS unsigned*)(lds + (bufoff) + ldsw + (i) * 8192), 16, 0, 0)
#define FG_STAGE_A0(bufoff, kt) do { const char* _pa = sA + (size_t)(kt) * 128; FG_GLDS(_pa + sa00, bufoff, 0); FG_GLDS(_pa + sa01, bufoff, 1); } while (0)
#define FG_STAGE_A1(bufoff, kt) do { const char* _pa = sA + (size_t)(kt) * 128; FG_GLDS(_pa + sa10, bufoff, 0); FG_GLDS(_pa + sa11, bufoff, 1); } while (0)
#define FG_STAGE_B(bufoff, h, kt) do { const char* _pb = sB + ((size_t)(h) * shB + (size_t)(kt) * 128); FG_GLDS(_pb + sb0, bufoff, 0); FG_GLDS(_pb + sb1, bufoff, 1); } while (0)
#define FG_LDA(dst, b, h) do { _Pragma("unroll") for (int m = 0; m < 4; ++m) _Pragma("unroll") for (int k = 0; k < 2; ++k) dst[m][k] = *(const LAS bf16x8*)(lds + FG_SA(b, h) + aoffL + m * 2048 + k * 1024); } while (0)
#define FG_LDB(dst, b, h) do { _Pragma("unroll") for (int n = 0; n < 2; ++n) _Pragma("unroll") for (int k = 0; k < 2; ++k) dst[n][k] = *(const LAS bf16x8*)(lds + FG_SB(b, h) + boffL + n * 2048 + k * 1024); } while (0)
#define FG_MMA(ai, bj, At, Bt) do { __builtin_amdgcn_s_setprio(1); _Pragma("unroll") for (int m = 0; m < 4; ++m) _Pragma("unroll") for (int n = 0; n < 2; ++n) _Pragma("unroll") for (int k = 0; k < 2; ++k) \
        acc[ai][bj][m][n] = __builtin_amdgcn_mfma_f32_16x16x32_bf16(Bt[n][k], At[m][k], acc[ai][bj][m][n], 0, 0, 0); __builtin_amdgcn_s_setprio(0); } while (0)
#define FG_WAIT_V(n) asm volatile("s_waitcnt vmcnt(" #n ")" ::: "memory")
#define FG_WAIT_L(n) asm volatile("s_waitcnt lgkmcnt(" #n ")" ::: "memory")
#define FG_BAR __builtin_amdgcn_s_barrier()
#define FG_SCHED __builtin_amdgcn_sched_barrier(0)
    f32x4 acc[2][2][4][2];
#pragma unroll
    for (int a = 0; a < 2; ++a)
#pragma unroll
        for (int b = 0; b < 2; ++b)
#pragma unroll
            for (int m = 0; m < 4; ++m)
#pragma unroll
                for (int n = 0; n < 2; ++n) acc[a][b][m][n] = (f32x4){0.f, 0.f, 0.f, 0.f};
    bf16x8 At[4][2], B0[2][2], B1[2][2];
    FG_SET(cur);
    FG_STAGE_B(FG_SB(0, 0), 0, 0); FG_STAGE_B(FG_SB(0, 1), 1, 0); FG_STAGE_A0(FG_SA(0, 0), 0); FG_STAGE_A1(FG_SA(0, 1), 0);
    if (wr == 1) FG_BAR;
    FG_WAIT_V(2); FG_BAR;
    FG_STAGE_B(FG_SB(1, 0), 0, 1); FG_STAGE_A0(FG_SA(1, 0), 1); FG_STAGE_B(FG_SB(1, 1), 1, 1);
    FG_WAIT_V(6); FG_BAR;
    for (;;) {
        const bool has_next = p.next(ui + 1, nxt);
        const int nt = cur.K >> 6;
        for (int t = 0; t < nt; t += 2) {
            const bool last = (t == nt - 2);
            const int k2 = last ? 0 : t + 2, k3 = k2 + 1;
            FG_LDB(B0, 0, 0); FG_LDB(B1, 0, 1); FG_SCHED; FG_LDA(At, 0, 0); FG_STAGE_A1(FG_SA(1, 1), t + 1);
            if (last && has_next) FG_SET(nxt);
            FG_WAIT_V(8); FG_WAIT_L(0); FG_BAR; FG_MMA(0, 0, At, B0); FG_MMA(0, 1, At, B1); FG_BAR; FG_SCHED;
            FG_LDA(At, 0, 1); FG_STAGE_B(FG_SB(0, 0), 0, k2); FG_STAGE_B(FG_SB(0, 1), 1, k2); FG_STAGE_A0(FG_SA(0, 0), k2);
            FG_WAIT_V(8); FG_WAIT_L(0); FG_BAR; FG_MMA(1, 0, At, B0); FG_MMA(1, 1, At, B1); FG_BAR; FG_SCHED;
            FG_LDB(B0, 1, 0); FG_LDB(B1, 1, 1); FG_SCHED; FG_LDA(At, 1, 0); FG_STAGE_A1(FG_SA(0, 1), k2);
            FG_WAIT_V(8); FG_WAIT_L(0); FG_BAR; FG_MMA(0, 0, At, B0); FG_MMA(0, 1, At, B1); FG_BAR; FG_SCHED;
            FG_LDA(At, 1, 1); FG_STAGE_B(FG_SB(1, 0), 0, k3); FG_STAGE_B(FG_SB(1, 1), 1, k3); FG_STAGE_A0(FG_SA(1, 0), k3);
            FG_WAIT_V(8); FG_WAIT_L(0); FG_BAR; FG_MMA(1, 0, At, B0); FG_MMA(1, 1, At, B1); FG_BAR; FG_SCHED;
        }
        if (wr == 0) FG_BAR;
#pragma unroll
        for (int ai = 0; ai < 2; ++ai)
#pragma unroll
            for (int m = 0; m < 4; ++m) {
                const float v0[8] = {acc[ai][0][m][0][0], acc[ai][0][m][0][1], acc[ai][0][m][0][2], acc[ai][0][m][0][3], acc[ai][0][m][1][0], acc[ai][0][m][1][1], acc[ai][0][m][1][2], acc[ai][0][m][1][3]};
                const float v1[8] = {acc[ai][1][m][0][0], acc[ai][1][m][0][1], acc[ai][1][m][0][2], acc[ai][1][m][0][3], acc[ai][1][m][1][0], acc[ai][1][m][1][1], acc[ai][1][m][1][2], acc[ai][1][m][1][3]};
                p.epi(cur, ai * 128 + wr * 64 + m * 16 + fr, wc * 32 + fq * 8, v0, v1);
            }
        if (!has_next) break;
#pragma unroll
        for (int a = 0; a < 2; ++a)
#pragma unroll
            for (int b = 0; b < 2; ++b)
#pragma unroll
                for (int m = 0; m < 4; ++m)
#pragma unroll
                    for (int n = 0; n < 2; ++n) acc[a][b][m][n] = (f32x4){0.f, 0.f, 0.f, 0.f};
        cur = nxt; ++ui;
        if (wr == 1) FG_BAR;
    }
    FG_WAIT_V(0);
    FG_BAR;
#undef FG_SET
#undef FG_SA
#undef FG_SB
#undef FG_GLDS
#undef FG_STAGE_A0
#undef FG_STAGE_A1
#undef FG_STAGE_B
#undef FG_LDA
#undef FG_LDB
#undef FG_MMA
#undef FG_WAIT_V
#undef FG_WAIT_L
#undef FG_BAR
#undef FG_SCHED
}

struct PInproj {
    int G, c, l; const bf16* hx; const bf16* wt; bf16 *urnn, *gate, *ufour, *sgr, *sgf;
    __device__ __forceinline__ bool next(int i, Unit& u) const {
        const int idx = i * G + c; if (idx >= NPAN * 18) return false;
        u.pm = idx / 18; u.pn = idx % 18; u.A = hx + (size_t)u.pm * 256 * D; u.lda = D; u.B = wt + (size_t)u.pn * 256 * D; u.ldb = D; u.K = D; return true; }
    __device__ __forceinline__ const bf16* a_row(const Unit& u, int row) const { return u.A + (size_t)row * D; }
    __device__ __forceinline__ unsigned a_off(const Unit& u, int row) const { return (unsigned)row * (D * 2); }
    __device__ __forceinline__ void epi(const Unit& u, int row, int c8, const float* v0, const float* v1) const {
        const size_t r = (size_t)u.pm * 256 + row; const int col = u.pn * 256 + c8;
        float a[8], b[8];
        if (col < 1024) { *(GAS v4u*)(urnn + r * D + col) = pack8(v0); *(GAS v4u*)(urnn + r * D + col + 128) = pack8(v1); }
        else if (col < 2048) {
#pragma unroll
            for (int j = 0; j < 8; ++j) { a[j] = gelu_tanh(v0[j]); b[j] = gelu_tanh(v1[j]); }
            *(GAS v4u*)(gate + r * D + col - 1024) = pack8(a); *(GAS v4u*)(gate + r * D + col - 1024 + 128) = pack8(b); }
        else if (col < 2560) { *(GAS v4u*)(ufour + r * 512 + col - 2048) = pack8(v0); *(GAS v4u*)(ufour + r * 512 + col - 2048 + 128) = pack8(v1); }
        else {
#pragma unroll
            for (int j = 0; j < 8; ++j) { a[j] = sigmoidf_(v0[j]); b[j] = sigmoidf_(v1[j]); }
            bf16* dst = col < 3584 ? sgr + r * D + (col - 2560) : sgf + r * D + (col - 3584);
            *(GAS v4u*)dst = pack8(a); *(GAS v4u*)(dst + 128) = pack8(b); }
    }
};
struct PDft {
    int G, c; const bf16 *csl, *csc, *ut; bf16* g;
    __device__ __forceinline__ bool next(int i, Unit& u) const {
        const int idx = i * G + c; if (idx >= 544) return false;
        if (idx < 512) { const int b = idx >> 6, rem = idx & 63; u.pm = rem >> 1; u.pn = rem & 1; u.x0 = b; u.x1 = 0;
            u.A = csl + (size_t)u.pm * 256 * 4096; u.lda = 4096; u.B = ut + ((size_t)b * 512 + u.pn * 256) * 4096; u.ldb = 4096; u.K = 4096; }
        else { const int j = idx - 512, b = j >> 2, rem = j & 3; u.pm = rem >> 1; u.pn = rem & 1; u.x0 = b; u.x1 = 1;
            u.A = csc + (size_t)u.pm * 256 * 256; u.lda = 256; u.B = ut + (size_t)8 * 512 * 4096 + ((size_t)b * 512 + u.pn * 256) * 256; u.ldb = 256; u.K = 256; }
        return true; }
    __device__ __forceinline__ const bf16* a_row(const Unit& u, int row) const { return u.A + (size_t)row * u.lda; }
    __device__ __forceinline__ unsigned a_off(const Unit& u, int row) const { return (unsigned)(row * u.lda) * 2u; }
    __device__ __forceinline__ void epi(const Unit& u, int row, int c8, const float* v0, const float* v1) const {
        size_t r; int col;
        if (u.x1 == 0) { r = (size_t)u.x0 * 4096 + (u.pm & 15) * 256 + row; col = (u.pm >> 4) * 512 + u.pn * 256 + c8; }
        else { r = (size_t)NL + u.x0 * 256 + row; col = u.pm * 512 + u.pn * 256 + c8; }
        *(GAS v4u*)(g + r * D + col) = pack8(v0); *(GAS v4u*)(g + r * D + col + 128) = pack8(v1);
    }
};
struct PMerge {
    int G, c; const bf16 *gm, *y, *wf, *wr, *sgr, *sgf; bf16 *t1, *mg;
    __device__ __forceinline__ bool next(int i, Unit& u) const {
        const int tile = (i >> 1) * G + c; if (tile >= NPAN * 4) return false;
        u.pm = tile >> 2; u.pn = tile & 3; u.x0 = i & 1; u.lda = D; u.ldb = D; u.K = D;
        u.A = (u.x0 ? y : gm) + (size_t)u.pm * 256 * D; u.B = (u.x0 ? wr : wf) + (size_t)u.pn * 256 * D; return true; }
    __device__ __forceinline__ const bf16* a_row(const Unit& u, int row) const { return u.A + (size_t)row * D; }
    __device__ __forceinline__ unsigned a_off(const Unit& u, int row) const { return (unsigned)row * (D * 2); }
    __device__ __forceinline__ void epi(const Unit& u, int row, int c8, const float* v0, const float* v1) const {
        const size_t o = ((size_t)u.pm * 256 + row) * D + u.pn * 256 + c8;
#pragma unroll
        for (int h = 0; h < 2; ++h) { const float* v = h ? v1 : v0; const size_t oo = o + h * 128; float s[8], r[8];
            if (u.x0 == 0) { unpack8(*(const GAS v4u*)(sgf + oo), s);
#pragma unroll
                for (int j = 0; j < 8; ++j) r[j] = s[j] * v[j];
                *(GAS v4u*)(t1 + oo) = pack8(r); }
            else { float t[8]; unpack8(*(const GAS v4u*)(sgr + oo), s); unpack8(*(const GAS v4u*)(t1 + oo), t);
#pragma unroll
                for (int j = 0; j < 8; ++j) r[j] = s[j] * v[j] + t[j];
                *(GAS v4u*)(mg + oo) = pack8(r); } }
    }
};
struct PWout {
    int G, c; const bf16 *mg, *wo; const float *xold_l, *xold_c; float *xnew_l, *xnew_c; const float* g1;
    __device__ __forceinline__ bool next(int i, Unit& u) const {
        const int idx = i * G + c; if (idx >= NPAN * 4) return false;
        u.pm = idx >> 2; u.pn = idx & 3; u.lda = D; u.ldb = D; u.K = D; u.A = mg + (size_t)u.pm * 256 * D; u.B = wo + (size_t)u.pn * 256 * D; return true; }
    __device__ __forceinline__ const bf16* a_row(const Unit& u, int row) const { return u.A + (size_t)row * D; }
    __device__ __forceinline__ unsigned a_off(const Unit& u, int row) const { return (unsigned)row * (D * 2); }
    __device__ __forceinline__ void epi(const Unit& u, int row, int c8, const float* v0, const float* v1) const {
        const int r = u.pm * 256 + row; const int mb = mb_of(r);
        const float* xo = r < NL ? xold_l + (size_t)r * D : xold_c + (size_t)(r - NL) * D;
        float* xn = r < NL ? xnew_l + (size_t)r * D : xnew_c + (size_t)(r - NL) * D;
        const float* gg = g1 + (size_t)mb * NMOD * D;
#pragma unroll
        for (int h = 0; h < 2; ++h) { const float* v = h ? v1 : v0; const int col = u.pn * 256 + c8 + h * 128;
#pragma unroll
            for (int q = 0; q < 2; ++q) { const f32x4 xv = *(const GAS f32x4*)(xo + col + 4 * q), gv = *(const GAS f32x4*)(gg + col + 4 * q);
                f32x4 o; o[0] = xv[0] + gv[0] * v[4 * q]; o[1] = xv[1] + gv[1] * v[4 * q + 1]; o[2] = xv[2] + gv[2] * v[4 * q + 2]; o[3] = xv[3] + gv[3] * v[4 * q + 3];
                *(GAS f32x4*)(xn + col + 4 * q) = o; } }
    }
};
struct PMoe1 {
    int G, c; const bf16* hx2; const bf16* w; const int2* list; bf16* he; const LAS int* ts; const LAS int* cn;
    __device__ __forceinline__ bool next(int i, Unit& u) const {
        const int idx = i * G + c; if (idx >= __builtin_amdgcn_readfirstlane(ts[16]) * 8) return false;
        const int tile = idx >> 3; u.pn = idx & 7; u.pm = tile; int e = 0;
#pragma unroll
        for (int j = 1; j < 16; ++j) e += (tile >= ts[j]) ? 1 : 0;
        e = __builtin_amdgcn_readfirstlane(e);
        u.x0 = e; u.x1 = (tile - __builtin_amdgcn_readfirstlane(ts[e])) * 256; u.x2 = __builtin_amdgcn_readfirstlane(cn[e]);
        u.A = hx2; u.lda = D; u.B = w + (size_t)e * 3 * D * D + (size_t)u.pn * 256 * D; u.ldb = D; u.K = D; return true; }
    __device__ __forceinline__ const bf16* a_row(const Unit& u, int row) const {
        const int p = u.x1 + row; int r = 0; if (p < u.x2) r = list[(size_t)u.x0 * NT + p].x & 0x7fffffff; return hx2 + (size_t)r * D; }
    __device__ __forceinline__ unsigned a_off(const Unit& u, int row) const {
        int p = u.x1 + row; p = p < u.x2 ? p : u.x2 - 1; const int r = ((const int*)list)[2 * ((size_t)u.x0 * NT + p)] & 0x7fffffff; return (unsigned)r * (D * 2); }
    __device__ __forceinline__ void epi(const Unit& u, int row, int c8, const float* v0, const float* v1) const {
        float r[8];
#pragma unroll
        for (int j = 0; j < 8; ++j) r[j] = siluf_(v0[j]) * v1[j];
        *(GAS v4u*)(he + ((size_t)u.pm * 256 + row) * D + u.pn * 128 + c8) = pack8(r);
    }
};
struct PMoe2 {
    int G, c; const bf16* he; const bf16* w; const int2* list; bf16* c01; const LAS int* ts; const LAS int* cn;
    __device__ __forceinline__ bool next(int i, Unit& u) const {
        const int idx = i * G + c; if (idx >= __builtin_amdgcn_readfirstlane(ts[16]) * 4) return false;
        const int tile = idx >> 2; u.pn = idx & 3; u.pm = tile; int e = 0;
#pragma unroll
        for (int j = 1; j < 16; ++j) e += (tile >= ts[j]) ? 1 : 0;
        e = __builtin_amdgcn_readfirstlane(e);
        u.x0 = e; u.x1 = (tile - __builtin_amdgcn_readfirstlane(ts[e])) * 256; u.x2 = __builtin_amdgcn_readfirstlane(cn[e]);
        u.A = he + (size_t)tile * 256 * D; u.lda = D; u.B = w + (size_t)e * 3 * D * D + (size_t)2 * D * D + (size_t)u.pn * 256 * D; u.ldb = D; u.K = D; return true; }
    __device__ __forceinline__ const bf16* a_row(const Unit& u, int row) const { return u.A + (size_t)row * D; }
    __device__ __forceinline__ unsigned a_off(const Unit& u, int row) const { return (unsigned)row * (D * 2); }
    __device__ __forceinline__ void epi(const Unit& u, int row, int c8, const float* v0, const float* v1) const {
        const int p = u.x1 + row; if (p >= u.x2) return;
        const int2 en = list[(size_t)u.x0 * NT + p]; const int r = en.x & 0x7fffffff, s = (en.x >> 31) & 1; const float w8 = __builtin_bit_cast(float, en.y);
        bf16* dst = c01 + ((size_t)s * NT + r) * D + u.pn * 256 + c8; float a[8], b[8];
#pragma unroll
        for (int j = 0; j < 8; ++j) { a[j] = w8 * v0[j]; b[j] = w8 * v1[j]; }
        *(GAS v4u*)dst = pack8(a); *(GAS v4u*)(dst + 128) = pack8(b);
    }
};

__device__ __forceinline__ void transpose_item(const float* W, int K, int N, bf16* WT, int k0, int n0, int drow0, LAS float* scr, int lane) {
#pragma unroll 8
    for (int i = 0; i < 32; ++i) { const int kk = 2 * i + (lane >> 5); scr[kk * 33 + (lane & 31)] = W[(size_t)(k0 + kk) * N + n0 + (lane & 31)]; }
    LDS_WAIT(); asm volatile("" ::: "memory");
    const int c = lane & 7;
#pragma unroll
    for (int j = 0; j < 4; ++j) { const int n = (lane >> 3) + 8 * j; const LAS float* s = scr + (8 * c) * 33 + n;
        v4u o; o.x = pk2(s[0 * 33], s[1 * 33]); o.y = pk2(s[2 * 33], s[3 * 33]); o.z = pk2(s[4 * 33], s[5 * 33]); o.w = pk2(s[6 * 33], s[7 * 33]);
        *(GAS v4u*)(WT + (size_t)(drow0 + n) * K + k0 + 8 * c) = o; }
    LDS_WAIT(); asm volatile("" ::: "memory");
}
__device__ __forceinline__ void p_prologue(Frame& F) {
    const int gw = F.bid * NWAVES + F.wave, NGW = F.G * NWAVES;
    LAS float* scr = (LAS float*)(F.lds + F.wave * 16384);
    constexpr int I_IN = 16 * 144, I_SQ = 16 * 32;
    constexpr int NIT = 2 * (I_IN + 2 * I_SQ);
    for (int it = gw; it < NIT; it += NGW) {
        int r = it; const int l = r / (I_IN + 2 * I_SQ); r -= l * (I_IN + 2 * I_SQ);
        if (r < I_IN) { const int kb = r / 144, nb = r % 144; transpose_item(F.kin[7] + (size_t)l * D * INW, D, INW, (bf16*)(F.ws + WS_WIN) + (size_t)l * INW * D, kb * 64, nb * 32, nb * 32, scr, F.lane); continue; }
        r -= I_IN;
        const int which = r / I_SQ; r -= which * I_SQ; const int kb = r / 32, nb = r % 32;
        transpose_item(F.kin[which ? 17 : 15] + (size_t)l * D * D, D, D, (bf16*)(F.ws + (which ? WS_WO : WS_WR)) + (size_t)l * D * D, kb * 64, nb * 32, nb * 32, scr, F.lane);
    }
    for (int o = F.bid * NTHR + F.tid; o < 2 * D * D; o += F.G * NTHR) {
        const int l = o >> 20, rem = o & (D * D - 1), kk = rem >> 10, n = rem & 1023;
        const int ch = kk & 511, g = ch >> 7, cc = ch & 127; const bool sn = kk >= 512;
        const float* wf = F.kin[16] + (size_t)l * 512 * D + (size_t)(g * 128) * D + n; float s = 0.f;
        for (int m = 0; m < 128; ++m) { const int ph = (cc * m) & 127; const float ang = (float)ph * (2.0f / 128.0f);
            const float co = sn ? -sinpif(ang) : cospif(ang); s += co * wf[(size_t)m * D]; }
        ((bf16*)(F.ws + WS_WF))[(size_t)l * D * D + (size_t)n * D + kk] = (bf16)f2bf(s);
    }
    { const float scl = 1.0f / sqrtf(4096.f * 128.f), scc = 1.0f / sqrtf(256.f * 128.f);
      for (size_t o = (size_t)F.bid * NTHR + F.tid; o < (size_t)8192 * 512; o += (size_t)F.G * NTHR) {
          const int r = (int)(o >> 9), t0 = (int)(o & 511) * 8, rr = r & 4095; float v[8];
#pragma unroll
          for (int j = 0; j < 8; ++j) { const int ph = (rr * (t0 + j)) & 4095; const float ang = (float)ph * (2.0f / 4096.0f); v[j] = (r < 4096 ? cospif(ang) : sinpif(ang)) * scl; }
          *(GAS v4u*)((bf16*)(F.ws + WS_CSL) + (size_t)r * 4096 + t0) = pack8(v); }
      for (int o = F.bid * NTHR + F.tid; o < 512 * 32; o += F.G * NTHR) {
          const int r = o >> 5, t0 = (o & 31) * 8, rr = r & 255; float v[8];
#pragma unroll
          for (int j = 0; j < 8; ++j) { const int ph = (rr * (t0 + j)) & 255; const float ang = (float)ph * (2.0f / 256.0f); v[j] = (r < 256 ? cospif(ang) : sinpif(ang)) * scc; }
          *(GAS v4u*)((bf16*)(F.ws + WS_CSC) + (size_t)r * 256 + t0) = pack8(v); } }
    for (int o = F.bid * NTHR + F.tid; o < 2 * 2 * 1024; o += F.G * NTHR) { const float lam = F.kin[14][o]; const float sp = (-lam > 20.f) ? -lam : log1pf(__expf(-lam));
        ((float*)(F.ws + WS_MODS + 512 * 1024))[o] = -8.0f * sp; }
    __syncthreads();
    { LAS float* sc = (LAS float*)(F.lds + 131072 - 9 * 1024 * 4);
      LAS float* red = (LAS float*)F.lds;
      for (int o = F.tid; o < 9 * 1024; o += NTHR) { const float cv = o < 8192 ? F.kin[1][o] : F.kin[3][o - 8192]; sc[o] = siluf_(cv); }
      __syncthreads();
      for (int it = F.bid; it < 2 * (NMOD * D / 64); it += F.G) {
          const int l = it / (NMOD * D / 64), n = (it % (NMOD * D / 64)) * 64 + F.lane; const float* w = F.kin[4] + (size_t)l * D * NMOD * D + n; float acc[9];
#pragma unroll
          for (int q = 0; q < 9; ++q) acc[q] = 0.f;
          for (int k = F.wave * 128; k < F.wave * 128 + 128; ++k) { const float wv = w[(size_t)k * NMOD * D];
#pragma unroll
              for (int q = 0; q < 9; ++q) acc[q] += sc[q * 1024 + k] * wv; }
#pragma unroll
          for (int q = 0; q < 9; ++q) red[(F.wave * 9 + q) * 64 + F.lane] = acc[q];
          __syncthreads();
          for (int o = F.tid; o < 9 * 64; o += NTHR) { const int q = o >> 6, ln = o & 63; float s = 0.f;
#pragma unroll
              for (int wv = 0; wv < 8; ++wv) s += red[(wv * 9 + q) * 64 + ln];
              const int nn = (it % (NMOD * D / 64)) * 64 + ln;
              ((float*)(F.ws + WS_MODS))[((size_t)(l * 9 + q)) * NMOD * D + nn] = s + F.kin[5][(size_t)l * NMOD * D + nn]; }
          __syncthreads();
      } }
}

__device__ __forceinline__ void p_norm1(Frame& F, int l) {
    const int gw = F.bid * NWAVES + F.wave, NGW = F.G * NWAVES;
    const float* gn = F.kin[6] + (size_t)l * D;
    bf16* hx = (bf16*)(F.ws + WS_RA); const bf16* c01 = (const bf16*)(F.ws + WS_C01);
    for (int r = gw; r < NT; r += NGW) {
        const int mb = mb_of(r);
        const float* src = l == 0 ? (r < NL ? F.kin[0] + (size_t)r * D : F.kin[2] + (size_t)(r - NL) * D)
                                  : (r < NL ? F.out + (size_t)r * D : (const float*)(F.ws + WS_HCTX) + (size_t)(r - NL) * D);
        f32x4 v[4]; float ss = 0.f;
#pragma unroll
        for (int j = 0; j < 4; ++j) v[j] = *(const GAS f32x4*)(src + F.lane * 4 + 256 * j);
        if (l == 1) { const float* g2 = modp(F, 0, mb, 5);
#pragma unroll
            for (int j = 0; j < 4; ++j) { const int k = F.lane * 4 + 256 * j; const v2u a = *(const GAS v2u*)(c01 + (size_t)r * D + k), b = *(const GAS v2u*)(c01 + ((size_t)NT + r) * D + k);
                const f32x4 gv = *(const GAS f32x4*)(g2 + k);
                v[j][0] += gv[0] * (bflo(a.x) + bflo(b.x)); v[j][1] += gv[1] * (bfhi(a.x) + bfhi(b.x)); v[j][2] += gv[2] * (bflo(a.y) + bflo(b.y)); v[j][3] += gv[3] * (bfhi(a.y) + bfhi(b.y));
                *(GAS f32x4*)((float*)src + k) = v[j]; } }
#pragma unroll
        for (int j = 0; j < 4; ++j) ss += (v[j][0] * v[j][0] + v[j][1] * v[j][1]) + (v[j][2] * v[j][2] + v[j][3] * v[j][3]);
        const float rstd = rsqrtf(wave_sum(ss, F.lane) * (1.f / D) + RMS_EPS);
        const float *sh = modp(F, l, mb, 0), *sc = modp(F, l, mb, 1);
#pragma unroll
        for (int j = 0; j < 4; ++j) { const int k = F.lane * 4 + 256 * j; const f32x4 g = *(const GAS f32x4*)(gn + k), s1 = *(const GAS f32x4*)(sc + k), s0 = *(const GAS f32x4*)(sh + k);
            float o[4];
#pragma unroll
            for (int q = 0; q < 4; ++q) o[q] = v[j][q] * rstd * g[q] * (1.f + s1[q]) + s0[q];
            v2u w; w.x = pk2(o[0], o[1]); w.y = pk2(o[2], o[3]); *(GAS v2u*)(hx + (size_t)r * D + k) = w; }
    }
}
__device__ __forceinline__ void p_final(Frame& F) {
    const int gw = F.bid * NWAVES + F.wave, NGW = F.G * NWAVES;
    const bf16* c01 = (const bf16*)(F.ws + WS_C01);
    for (int r = gw; r < NL; r += NGW) {
        const int mb = r >> 12; float* src = F.out + (size_t)r * D; const float* g2 = modp(F, 1, mb, 5);
        f32x4 v[4]; float ss = 0.f;
#pragma unroll
        for (int j = 0; j < 4; ++j) { const int k = F.lane * 4 + 256 * j; v[j] = *(const GAS f32x4*)(src + k);
            const v2u a = *(const GAS v2u*)(c01 + (size_t)r * D + k), b = *(const GAS v2u*)(c01 + ((size_t)NT + r) * D + k); const f32x4 gv = *(const GAS f32x4*)(g2 + k);
            v[j][0] += gv[0] * (bflo(a.x) + bflo(b.x)); v[j][1] += gv[1] * (bfhi(a.x) + bfhi(b.x)); v[j][2] += gv[2] * (bflo(a.y) + bflo(b.y)); v[j][3] += gv[3] * (bfhi(a.y) + bfhi(b.y));
            ss += (v[j][0] * v[j][0] + v[j][1] * v[j][1]) + (v[j][2] * v[j][2] + v[j][3] * v[j][3]); }
        const float rstd = rsqrtf(wave_sum(ss, F.lane) * (1.f / D) + RMS_EPS);
#pragma unroll
        for (int j = 0; j < 4; ++j) { const int k = F.lane * 4 + 256 * j; const f32x4 g = *(const GAS f32x4*)(F.kin[24] + k); f32x4 o;
#pragma unroll
            for (int q = 0; q < 4; ++q) o[q] = v[j][q] * rstd * g[q];
            *(GAS f32x4*)(src + k) = o; }
    }
}
__device__ __forceinline__ void p_transpose(Frame& F) {
    LAS bf16* tile = (LAS bf16*)F.lds;
    const bf16* uf = (const bf16*)(F.ws + WS_RF); bf16* ut = (bf16*)(F.ws + WS_RG);
    for (int it = F.bid; it < 4096 + 256; it += F.G) {
        int b, tb, cb, L; size_t rowbase; bf16* dst;
        if (it < 4096) { b = it >> 9; tb = (it >> 3) & 63; cb = it & 7; L = 4096; rowbase = (size_t)b * 4096 + tb * 64; dst = ut + (size_t)b * 512 * 4096; }
        else { const int j = it - 4096; b = j >> 5; tb = (j >> 3) & 3; cb = j & 7; L = 256; rowbase = (size_t)NL + b * 256 + tb * 64; dst = ut + (size_t)8 * 512 * 4096 + (size_t)b * 512 * 256; }
        { const int t = F.tid >> 3, c8 = (F.tid & 7) * 8; const v4u w = *(const GAS v4u*)(uf + (rowbase + t) * 512 + cb * 64 + c8);
          LAS unsigned* p = (LAS unsigned*)(tile + t * 72 + c8); p[0] = w.x; p[1] = w.y; p[2] = w.z; p[3] = w.w; }
        __syncthreads();
        { const int c = F.tid >> 3, t8 = (F.tid & 7) * 8; v4u o; unsigned h[8];
#pragma unroll
          for (int j = 0; j < 8; ++j) h[j] = tile[(t8 + j) * 72 + c];
          o.x = h[0] | (h[1] << 16); o.y = h[2] | (h[3] << 16); o.z = h[4] | (h[5] << 16); o.w = h[6] | (h[7] << 16);
          *(GAS v4u*)(dst + (size_t)(cb * 64 + c) * L + tb * 64 + t8) = o; }
        __syncthreads();
    }
}
__device__ __forceinline__ void p_scan_simple(Frame& F, int l) {
    if (F.bid >= 128) return;
    const int b = F.bid >> 4, h = (F.bid >> 1) & 7, d = F.bid & 1;
    LAS float* U = (LAS float*)F.lds;
    LAS float* RAg = U + 64 * 128;
    LAS float* XIg = RAg + 64 * 128;
    const bf16* urnn = (const bf16*)(F.ws + WS_RB);
    bf16* hout = (bf16*)(F.ws + (d ? WS_RF : WS_RA));
    const float* cw = F.kin[8] + (size_t)l * 4 * D + h * 128; const float* cb = F.kin[9] + (size_t)l * D + h * 128;
    const float* Wa = F.kin[10] + ((size_t)(l * 2 + d) * 8 + h) * 128 * 128; const float* Wx = F.kin[12] + ((size_t)(l * 2 + d) * 8 + h) * 128 * 128;
    const float* ba = F.kin[11] + ((size_t)(l * 2 + d) * 8 + h) * 128; const float* bx = F.kin[13] + ((size_t)(l * 2 + d) * 8 + h) * 128;
    const float* n8 = (const float*)(F.ws + WS_MODS + 512 * 1024) + (size_t)(l * 2 + d) * 1024 + h * 128;
    const int ch = F.tid & 127, tq = F.tid >> 7;
    float hstate = 0.f;
    for (int step = 0; step < 68; ++step) {
        const int j = d == 0 ? step : (step < 4 ? 3 - step : 71 - step);
        const bool isctx = j < 4; const size_t row0 = isctx ? (size_t)NL + b * 256 + j * 64 : (size_t)b * 4096 + (size_t)(j - 4) * 64;
        __syncthreads();
        for (int o = F.tid; o < 64 * 128; o += NTHR) { const int t = o >> 7, c = o & 127; float s = cb[c];
#pragma unroll
            for (int k = 0; k < 4; ++k) { const int tt = t + k - 2; bool ok; if (isctx) { const int g = j * 64 + tt; ok = g >= 0 && g < 256; } else ok = tt >= 0 && tt < 64;
                if (ok) s += cw[(size_t)k * D + c] * bf2f(urnn[(row0 + tt) * D + h * 128 + c]); }
            U[o] = s; }
        __syncthreads();
        { float ar[16], ax[16];
#pragma unroll
          for (int q = 0; q < 16; ++q) { ar[q] = 0.f; ax[q] = 0.f; }
          for (int k = 0; k < 128; ++k) { const float wa = Wa[(size_t)k * 128 + ch], wx = Wx[(size_t)k * 128 + ch];
#pragma unroll
              for (int q = 0; q < 16; ++q) { const float uv = U[(tq * 16 + q) * 128 + k]; ar[q] += uv * wa; ax[q] += uv * wx; } }
          const float bav = ba[ch], bxv = bx[ch], n8v = n8[ch];
#pragma unroll
          for (int q = 0; q < 16; ++q) { const int t = tq * 16 + q; const float r = sigmoidf_(ar[q] + bav), ig = sigmoidf_(ax[q] + bxv);
              const float la = n8v * r, a = __expf(la), y2 = 2.f * la;
              const float om = (y2 > -0.02f) ? -(y2 * (1.f + y2 * (0.5f + y2 * (1.f / 6.f)))) : 1.f - __expf(y2);
              RAg[t * 128 + ch] = a; XIg[t * 128 + ch] = sqrtf(om) * ig * U[t * 128 + ch]; } }
        __syncthreads();
        if (F.tid < 128) {
            for (int q = 0; q < 64; ++q) { const int t = d == 0 ? q : 63 - q; hstate = RAg[t * 128 + ch] * hstate + XIg[t * 128 + ch]; RAg[t * 128 + ch] = hstate; } }
        __syncthreads();
        for (int o = F.tid; o < 64 * 16; o += NTHR) { const int t = o >> 4, c8 = (o & 15) * 8; float v[8];
#pragma unroll
            for (int q = 0; q < 8; ++q) v[q] = RAg[t * 128 + c8 + q];
            *(GAS v4u*)(hout + (row0 + t) * D + h * 128 + c8) = pack8(v); }
    }
}
constexpr size_t WS_SUM = 588 * MiB;
constexpr size_t WS_CIN = 597 * MiB;
constexpr size_t WS_END2 = 602 * MiB;
constexpr int SC_XRAW = 0, SC_U32 = 17408, SC_UBF = SC_U32 + 32768, SC_YT = SC_UBF + 16384, SC_CW = SC_YT + 16384;
__device__ __forceinline__ float fast_sigmoid(float x) { return __builtin_amdgcn_rcpf(1.f + __expf(-x)); }
template <int PASS> __device__ __forceinline__ void p_scan_fast(Frame& F, int l) {
    LAS unsigned char* lds = F.lds;
    const int tid = F.tid, lane = F.lane, w = F.wave, fr = lane & 15, fq = lane >> 4;
    const bf16* urnn = (const bf16*)(F.ws + WS_RB); const bf16* gate = (const bf16*)(F.ws + WS_RC); bf16* yout = (bf16*)(F.ws + WS_RA);
    float* SUM = (float*)(F.ws + WS_SUM); const float* CIN = (const float*)(F.ws + WS_CIN);
    const int h = F.bid & 7, qi = F.bid >> 3, nq = (F.G - h + 7) >> 3;
    bf16x8 bw[4][4];
    float bia[4];
#pragma unroll
    for (int ty = 0; ty < 4; ++ty) { const int d = ty >> 1; const float* W = F.kin[(ty & 1) ? 12 : 10] + ((size_t)(l * 2 + d) * 8 + h) * 128 * 128 + 16 * w + fr;
#pragma unroll
        for (int ks = 0; ks < 4; ++ks) { float t8[8];
#pragma unroll
            for (int q = 0; q < 8; ++q) t8[q] = W[(size_t)(32 * ks + 8 * fq + q) * 128];
            const v4u pk = pack8(t8); bw[ty][ks] = __builtin_bit_cast(bf16x8, pk); }
        bia[ty] = F.kin[(ty & 1) ? 13 : 11][((size_t)(l * 2 + d) * 8 + h) * 128 + 16 * w + fr]; }
    const float n8f = ((const float*)(F.ws + WS_MODS + 512 * 1024))[(size_t)(l * 2 + 0) * 1024 + h * 128 + 16 * w + fr];
    const float n8b = ((const float*)(F.ws + WS_MODS + 512 * 1024))[(size_t)(l * 2 + 1) * 1024 + h * 128 + 16 * w + fr];
    { LAS float* CW = (LAS float*)(lds + SC_CW);
      for (int o = tid; o < 5 * 128; o += NTHR) CW[o] = o < 512 ? F.kin[8][(size_t)l * 4 * D + (size_t)(o >> 7) * D + h * 128 + (o & 127)] : F.kin[9][(size_t)l * D + h * 128 + (o & 127)]; }
    for (int pi = qi; pi < 544; pi += nq) {
        const int b = pi / 68, j = pi % 68;
        const bool isctx = j < 4; const size_t row0 = isctx ? (size_t)NL + b * 256 + j * 64 : (size_t)b * 4096 + (size_t)(j - 4) * 64;
        __syncthreads();
        for (int p = tid; p < 68 * 16; p += NTHR) { const int rr = p >> 4, c16 = p & 15, tt = rr - 2; bool ok; if (isctx) { const int g = j * 64 + tt; ok = g >= 0 && g < 256; } else ok = tt >= 0 && tt < 64;
            v4u v = (v4u){0u, 0u, 0u, 0u}; if (ok) v = *(const GAS v4u*)(urnn + (row0 + tt) * D + h * 128 + c16 * 8);
            *(LAS v4u*)(lds + SC_XRAW + rr * 256 + c16 * 16) = v; }
        __syncthreads();
        { const int t = tid >> 3, cg = tid & 7; const LAS float* CW = (const LAS float*)(lds + SC_CW); float u[16];
#pragma unroll
          for (int q = 0; q < 16; ++q) u[q] = CW[512 + cg * 16 + q];
#pragma unroll
          for (int k = 0; k < 4; ++k) { float x[16]; unpack8(*(const LAS v4u*)(lds + SC_XRAW + (t + k) * 256 + cg * 32), x); unpack8(*(const LAS v4u*)(lds + SC_XRAW + (t + k) * 256 + cg * 32 + 16), x + 8);
#pragma unroll
              for (int q = 0; q < 16; ++q) u[q] += CW[k * 128 + cg * 16 + q] * x[q]; }
#pragma unroll
          for (int q = 0; q < 4; ++q) *(LAS f32x4*)(lds + SC_U32 + t * 512 + cg * 64 + q * 16) = (f32x4){u[4 * q], u[4 * q + 1], u[4 * q + 2], u[4 * q + 3]};
          const int ft = (t & 3) | (((t >> 4) & 3) << 2);
          *(LAS v4u*)(lds + SC_UBF + t * 256 + (((cg * 2) ^ ft) << 4)) = pack8(u); *(LAS v4u*)(lds + SC_UBF + t * 256 + (((cg * 2 + 1) ^ ft) << 4)) = pack8(u + 8); }
        __syncthreads();
        const int c = 16 * w + fr;
        float hs[16];
#pragma unroll
        for (int d = 0; d < 2; ++d) {
            f32x4 acc[2][4];
#pragma unroll
            for (int ty = 0; ty < 2; ++ty)
#pragma unroll
                for (int m = 0; m < 4; ++m) acc[ty][m] = (f32x4){0.f, 0.f, 0.f, 0.f};
#pragma unroll
            for (int m = 0; m < 4; ++m) { const int tau = 16 * (fr >> 2) + 4 * m + (fr & 3);
#pragma unroll
                for (int ks = 0; ks < 4; ++ks) { const bf16x8 af = *(const LAS bf16x8*)(lds + SC_UBF + tau * 256 + (((4 * ks + fq) ^ fr) << 4));
                    acc[0][m] = __builtin_amdgcn_mfma_f32_16x16x32_bf16(af, bw[2 * d][ks], acc[0][m], 0, 0, 0); acc[1][m] = __builtin_amdgcn_mfma_f32_16x16x32_bf16(af, bw[2 * d + 1][ks], acc[1][m], 0, 0, 0); } }
            float av[16], bv[16]; const float n8 = d ? n8b : n8f, b_a = bia[2 * d], b_x = bia[2 * d + 1];
#pragma unroll
            for (int q = 0; q < 16; ++q) { const float r = fast_sigmoid(acc[0][q >> 2][q & 3] + b_a), ig = fast_sigmoid(acc[1][q >> 2][q & 3] + b_x);
                const float la = n8 * r, a = __expf(la), y2 = 2.f * la;
                const float om = (y2 > -0.02f) ? -(y2 * (1.f + y2 * (0.5f + y2 * (1.f / 6.f)))) : 1.f - __expf(y2);
                av[q] = a; bv[q] = __builtin_sqrtf(om) * ig * *(const LAS float*)(lds + SC_U32 + (16 * fq + q) * 512 + c * 4);
                if ((q & 3) == 3) __builtin_amdgcn_sched_barrier(0); }
            float P = 1.f, H = 0.f;
#pragma unroll
            for (int q = 0; q < 16; ++q) { const int t = d ? 15 - q : q; H = av[t] * H + bv[t]; P *= av[t]; }
            float Ps[4], Hs[4];
#pragma unroll
            for (int sgi = 0; sgi < 4; ++sgi) { Ps[sgi] = __builtin_bit_cast(float, __builtin_amdgcn_ds_bpermute(((sgi << 4) | fr) << 2, __builtin_bit_cast(int, P)));
                                              Hs[sgi] = __builtin_bit_cast(float, __builtin_amdgcn_ds_bpermute(((sgi << 4) | fr) << 2, __builtin_bit_cast(int, H))); }
            if (PASS == 1) {
                float Pt = 1.f, Ht = 0.f;
#pragma unroll
                for (int q = 0; q < 4; ++q) { const int sgi = d ? 3 - q : q; Ht = Ps[sgi] * Ht + Hs[sgi]; Pt *= Ps[sgi]; }
                if (fq == 0) { float* dst = SUM + ((((size_t)b * 2 + d) * 68 + j) * 2) * 1024 + h * 128 + c; dst[0] = Pt; dst[1024] = Ht; }
            } else {
                float cin = CIN[(((size_t)b * 2 + d) * 68 + j) * 1024 + h * 128 + c];
#pragma unroll
                for (int q = 0; q < 3; ++q) { const int sgi = d ? 3 - q : q; const bool before = d ? (sgi > fq) : (sgi < fq); if (before) cin = Ps[sgi] * cin + Hs[sgi]; }
                float hh = cin;
#pragma unroll
                for (int q = 0; q < 16; ++q) { const int t = d ? 15 - q : q; hh = av[t] * hh + bv[t]; if (d == 0) hs[t] = hh; else hs[t] += hh; }
            }
        }
        if (PASS == 2) {
#pragma unroll
            for (int q = 0; q < 16; ++q) *(LAS bf16*)(lds + SC_YT + (16 * fq + q) * 256 + c * 2) = (bf16)f2bf(hs[q]);
            __syncthreads();
            { const int t = tid >> 3, cg = tid & 7; float yv[16], gv[16];
              unpack8(*(const LAS v4u*)(lds + SC_YT + t * 256 + cg * 32), yv); unpack8(*(const LAS v4u*)(lds + SC_YT + t * 256 + cg * 32 + 16), yv + 8);
              const bf16* gp = gate + (row0 + t) * D + h * 128 + cg * 16; unpack8(*(const GAS v4u*)gp, gv); unpack8(*(const GAS v4u*)(gp + 8), gv + 8);
#pragma unroll
              for (int q = 0; q < 16; ++q) yv[q] *= gv[q];
              bf16* yp = yout + (row0 + t) * D + h * 128 + cg * 16; *(GAS v4u*)yp = pack8(yv); *(GAS v4u*)(yp + 8) = pack8(yv + 8); }
        }
    }
    __syncthreads();
}
__device__ __forceinline__ void p_scan_carry(Frame& F) {
    const float* SUM = (const float*)(F.ws + WS_SUM); float* CIN = (float*)(F.ws + WS_CIN);
    for (int g = F.bid * NTHR + F.tid; g < 8 * 2 * 1024; g += F.G * NTHR) {
        const int b = g >> 11, d = (g >> 10) & 1, ch = g & 1023; float cst = 0.f;
        const float* sp = SUM + (((size_t)b * 2 + d) * 68) * 2 * 1024 + ch; float* cp = CIN + (((size_t)b * 2 + d) * 68) * 1024 + ch;
#pragma unroll 4
        for (int step = 0; step < 68; ++step) { const int j = d == 0 ? step : (step < 4 ? 3 - step : 71 - step);
            const float P = sp[(size_t)j * 2048], H = sp[(size_t)j * 2048 + 1024]; cp[(size_t)j * 1024] = cst; cst = P * cst + H; }
    }
}

__device__ __forceinline__ void p_ycombine(Frame& F) {
    bf16* hf = (bf16*)(F.ws + WS_RA); const bf16* hb = (const bf16*)(F.ws + WS_RF); const bf16* gt = (const bf16*)(F.ws + WS_RC);
    for (size_t o = ((size_t)F.bid * NTHR + F.tid) * 8; o < (size_t)NT * D; o += (size_t)F.G * NTHR * 8) {
        float a[8], b[8], g[8]; unpack8(*(const GAS v4u*)(hf + o), a); unpack8(*(const GAS v4u*)(hb + o), b); unpack8(*(const GAS v4u*)(gt + o), g);
#pragma unroll
        for (int j = 0; j < 8; ++j) a[j] = (a[j] + b[j]) * g[j];
        *(GAS v4u*)(hf + o) = pack8(a); }
}
__device__ __forceinline__ void p_norm2_route(Frame& F, int l) {
    LAS float* RW = (LAS float*)F.lds;
    LAS int* lcnt = (LAS int*)(F.lds + 65536);
    LAS int* rinfo = lcnt + 64;
    const int rpb = (NT + F.G - 1) / F.G, r0 = F.bid * rpb, r1 = (r0 + rpb < NT) ? r0 + rpb : NT;
    for (int o = F.tid; o < 1024 * 16; o += NTHR) RW[o] = F.kin[19][o];
    if (F.tid < 32) lcnt[F.tid] = 0;
    __syncthreads();
    const float* gn = F.kin[18] + (size_t)l * D; bf16* hx2 = (bf16*)(F.ws + WS_RA);
    float rb[16];
#pragma unroll
    for (int e = 0; e < 16; ++e) rb[e] = F.kin[20][e];
    for (int r = r0 + F.wave; r < r1; r += NWAVES) {
        const int mb = mb_of(r);
        const float* src = r < NL ? F.out + (size_t)r * D : (const float*)(F.ws + WS_HCTX) + (size_t)(r - NL) * D;
        f32x4 v[4]; float ss = 0.f;
#pragma unroll
        for (int j = 0; j < 4; ++j) { v[j] = *(const GAS f32x4*)(src + F.lane * 4 + 256 * j); ss += (v[j][0] * v[j][0] + v[j][1] * v[j][1]) + (v[j][2] * v[j][2] + v[j][3] * v[j][3]); }
        const float rstd = rsqrtf(wave_sum(ss, F.lane) * (1.f / D) + RMS_EPS);
        const float *sh = modp(F, l, mb, 3), *sc = modp(F, l, mb, 4);
        float lg[16];
#pragma unroll
        for (int e = 0; e < 16; ++e) lg[e] = 0.f;
#pragma unroll
        for (int j = 0; j < 4; ++j) { const int k = F.lane * 4 + 256 * j; const f32x4 g = *(const GAS f32x4*)(gn + k), s1 = *(const GAS f32x4*)(sc + k), s0 = *(const GAS f32x4*)(sh + k);
            float o[4];
#pragma unroll
            for (int q = 0; q < 4; ++q) { o[q] = v[j][q] * rstd * g[q] * (1.f + s1[q]) + s0[q];
                const LAS f32x4* rw = (const LAS f32x4*)(RW + (k + q) * 16);
#pragma unroll
                for (int e4 = 0; e4 < 4; ++e4) { const f32x4 w = rw[e4]; lg[4 * e4] += o[q] * w[0]; lg[4 * e4 + 1] += o[q] * w[1]; lg[4 * e4 + 2] += o[q] * w[2]; lg[4 * e4 + 3] += o[q] * w[3]; } }
            v2u w; w.x = pk2(o[0], o[1]); w.y = pk2(o[2], o[3]); *(GAS v2u*)(hx2 + (size_t)r * D + k) = w; }
        float aff[16], sel[16];
#pragma unroll
        for (int e = 0; e < 16; ++e) { lg[e] = wave_sum(lg[e], F.lane); aff[e] = sigmoidf_(lg[e]); sel[e] = aff[e] + rb[e]; }
        int grp = 0; float best = -1e30f;
#pragma unroll
        for (int g = 0; g < 4; ++g) { const float a = sel[4 * g], b = sel[4 * g + 1], c = sel[4 * g + 2], dd = sel[4 * g + 3];
            const float s = fmaxf(fmaxf(fmaxf(a + b, a + c), fmaxf(a + dd, b + c)), fmaxf(b + dd, c + dd));
            if (s > best) { best = s; grp = g; } }
        float s4[4], a4[4];
#pragma unroll
        for (int q = 0; q < 4; ++q) { s4[q] = grp == 0 ? sel[q] : grp == 1 ? sel[4 + q] : grp == 2 ? sel[8 + q] : sel[12 + q]; a4[q] = grp == 0 ? aff[q] : grp == 1 ? aff[4 + q] : grp == 2 ? aff[8 + q] : aff[12 + q]; }
        int i0 = 0; float m0 = s4[0], af0 = a4[0];
#pragma unroll
        for (int q = 1; q < 4; ++q) if (s4[q] > m0) { m0 = s4[q]; i0 = q; af0 = a4[q]; }
        int i1 = -1; float m1 = -1e30f, af1 = 0.f;
#pragma unroll
        for (int q = 0; q < 4; ++q) if (q != i0 && s4[q] > m1) { m1 = s4[q]; i1 = q; af1 = a4[q]; }
        const int e0 = grp * 4 + i0, e1 = grp * 4 + i1; const float inv = 1.f / (af0 + af1);
        if (F.lane == 0) { const int lr0 = __hip_atomic_fetch_add(lcnt + e0, 1, __ATOMIC_RELAXED, __HIP_MEMORY_SCOPE_WORKGROUP), lr1 = __hip_atomic_fetch_add(lcnt + e1, 1, __ATOMIC_RELAXED, __HIP_MEMORY_SCOPE_WORKGROUP);
            LAS int* ri = rinfo + (r - r0) * 5; ri[0] = e0 | (e1 << 8); ri[1] = lr0; ri[2] = lr1; ri[3] = __builtin_bit_cast(int, af0 * inv); ri[4] = __builtin_bit_cast(int, af1 * inv); }
    }
    __syncthreads();
    if (F.tid < 16) lcnt[16 + F.tid] = (int)__hip_atomic_fetch_add(F.ctl + CW_CNT + 64 * l + F.tid, (unsigned)lcnt[F.tid], __ATOMIC_RELAXED, __HIP_MEMORY_SCOPE_AGENT);
    __syncthreads();
    int2* list = (int2*)(F.ws + WS_LIST);
    for (int rl = F.tid; rl < r1 - r0; rl += NTHR) { const LAS int* ri = rinfo + rl * 5; const int e0 = ri[0] & 255, e1 = ri[0] >> 8, r = r0 + rl;
        list[(size_t)e0 * NT + lcnt[16 + e0] + ri[1]] = make_int2(r, ri[3]);
        list[(size_t)e1 * NT + lcnt[16 + e1] + ri[2]] = make_int2(r | (int)0x80000000, ri[4]); }
    __syncthreads();
    { const int gw = F.bid * NWAVES + F.wave, NGW = F.G * NWAVES; LAS float* scr = (LAS float*)(F.lds + F.wave * 16384);
      bf16* mw = (bf16*)(F.ws + WS_MOEW);
      for (int it = gw; it < 16 * 3 * 512; it += NGW) { const int e = it / 1536, rem = it % 1536, m = rem / 512, q = rem % 512, kb = q >> 5, nb = q & 31;
          const float* W = F.kin[m == 0 ? 21 : m == 1 ? 22 : 23] + ((size_t)l * 16 + e) * D * D; bf16* dst = mw + (size_t)e * 3 * D * D + (m == 2 ? (size_t)2 * D * D : 0);
          const int n0 = nb * 32; const int drow = m == 2 ? n0 : ((n0 >> 7) * 256 + (m == 1 ? 128 : 0) + (n0 & 127));
          transpose_item(W, D, D, dst, kb * 64, n0, drow, scr, F.lane); } }
}
__device__ __forceinline__ void moe_table(Frame& F, int l, LAS int* ts, LAS int* cn) {
    __syncthreads();
    if (F.tid == 0) { int acc = 0;
        for (int e = 0; e < 16; ++e) { const int c = (int)__hip_atomic_load(F.ctl + CW_CNT + 64 * l + e, __ATOMIC_RELAXED, __HIP_MEMORY_SCOPE_AGENT); cn[e] = c; ts[e] = acc; acc += (c + 255) >> 8; }
        ts[16] = acc; }
    __syncthreads();
}

constexpr int NPH = 24;
struct Args { const float* in[25]; float* out; unsigned char* ws; int ph_lo, ph_hi; };
__global__ void __launch_bounds__(NTHR, 2) fwd_kernel(Args args) {
    extern __shared__ __attribute__((aligned(16))) unsigned char lds[];
    Frame F;
    F.lds = (LAS unsigned char*)lds; F.tid = threadIdx.x; F.lane = F.tid & 63; F.wave = __builtin_amdgcn_readfirstlane(F.tid >> 6);
    F.G = gridDim.x; F.bid = blockIdx.x; F.ws = args.ws; F.out = args.out; F.ctl = (unsigned*)(args.ws + WS_CTL);
    F.kin = (const float* const __attribute__((address_space(4)))*)__builtin_amdgcn_kernarg_segment_ptr();
    volatile LAS unsigned* MISC = (volatile LAS unsigned*)(F.lds + MISC_OFF);
    if (F.tid < 32) MISC[F.tid] = 0u;
    __syncthreads();
    XcdBarrier bar; bar.bar = F.ctl + CW_BAR; bar.x = 0; bar.st = nullptr;
    if (MK_N_LAUNCHES == 1) bar = xcd_barrier_post(F.ctl + CW_BAR, MISC + 8);
    LAS int* ts = (LAS int*)(F.lds + MISC_OFF + 256); LAS int* cn = ts + 32;
    const int lo = args.ph_lo, hi = args.ph_hi;
#ifndef SITE_MASK
#define SITE_MASK 0xfffffu
#endif
#define SITE(j) (((SITE_MASK) >> (j)) & 1u)
#define IN(k) (lo <= (k) && (k) < hi)
#define LAUNDER() asm volatile("" : "+s"(F.ws), "+s"(F.out), "+s"(F.kin), "+s"(F.ctl), "+s"(F.lds), "+s"(F.wave), "+s"(F.bid), "+s"(F.G), "+v"(F.tid), "+v"(F.lane))
#define SEAM(k) do { if (MK_N_LAUNCHES == 1 && IN((k) + 1)) xcd_barrier(bar); } while (0)

    if (SITE(0) && IN(0)) { LAUNDER(); p_prologue(F); SEAM(0); }
    for (int l = 0; l < 2; ++l) {
        const int pb = 1 + 11 * l;
        if (SITE(1) && IN(pb + 0)) { LAUNDER(); p_norm1(F, l); SEAM(pb + 0); }
        if (SITE(2) && IN(pb + 1)) { LAUNDER();
            PInproj p; p.G = F.G; p.c = F.bid; p.l = l; p.hx = (const bf16*)(F.ws + WS_RA); p.wt = (const bf16*)(F.ws + WS_WIN) + (size_t)l * INW * D;
            p.urnn = (bf16*)(F.ws + WS_RB); p.gate = (bf16*)(F.ws + WS_RC); p.ufour = (bf16*)(F.ws + WS_RF); p.sgr = (bf16*)(F.ws + WS_RD); p.sgf = (bf16*)(F.ws + WS_RE);
            fast_gemm_phase(F, p); SEAM(pb + 1); }
        if (SITE(3) && IN(pb + 2)) { LAUNDER(); p_scan_fast<1>(F, l); p_transpose(F); SEAM(pb + 2); }
        if (SITE(4) && IN(pb + 3)) { LAUNDER(); p_scan_carry(F); SEAM(pb + 3); }
        if (SITE(5) && IN(pb + 4)) { LAUNDER();
            PDft p; p.G = F.G; p.c = F.bid; p.csl = (const bf16*)(F.ws + WS_CSL); p.csc = (const bf16*)(F.ws + WS_CSC); p.ut = (const bf16*)(F.ws + WS_RG); p.g = (bf16*)(F.ws + WS_RH);
            fast_gemm_phase(F, p); SEAM(pb + 4); }
        if (SITE(6) && IN(pb + 5)) { LAUNDER(); p_scan_fast<2>(F, l); SEAM(pb + 5); }
        if (SITE(7) && IN(pb + 6)) { LAUNDER();
            PMerge p; p.G = F.G; p.c = F.bid; p.gm = (const bf16*)(F.ws + WS_RH); p.y = (const bf16*)(F.ws + WS_RA); p.wf = (const bf16*)(F.ws + WS_WF) + (size_t)l * D * D; p.wr = (const bf16*)(F.ws + WS_WR) + (size_t)l * D * D;
            p.sgr = (const bf16*)(F.ws + WS_RD); p.sgf = (const bf16*)(F.ws + WS_RE); p.t1 = (bf16*)(F.ws + WS_RB); p.mg = (bf16*)(F.ws + WS_RC);
            fast_gemm_phase(F, p); SEAM(pb + 6); }
        if (SITE(8) && IN(pb + 7)) { LAUNDER();
            PWout p; p.G = F.G; p.c = F.bid; p.mg = (const bf16*)(F.ws + WS_RC); p.wo = (const bf16*)(F.ws + WS_WO) + (size_t)l * D * D;
            p.xold_l = l == 0 ? F.kin[0] : F.out; p.xold_c = l == 0 ? F.kin[2] : (const float*)(F.ws + WS_HCTX); p.xnew_l = F.out; p.xnew_c = (float*)(F.ws + WS_HCTX); p.g1 = modp(F, l, 0, 2);
            fast_gemm_phase(F, p); SEAM(pb + 7); }
        if (SITE(9) && IN(pb + 8)) { LAUNDER(); p_norm2_route(F, l); SEAM(pb + 8); }
        if (SITE(10) && IN(pb + 9)) { LAUNDER();
            moe_table(F, l, ts, cn);
            PMoe1 p; p.G = F.G; p.c = F.bid; p.hx2 = (const bf16*)(F.ws + WS_RA); p.w = (const bf16*)(F.ws + WS_MOEW); p.list = (const int2*)(F.ws + WS_LIST); p.he = (bf16*)(F.ws + WS_HE); p.ts = ts; p.cn = cn;
            fast_gemm_phase(F, p); SEAM(pb + 9); }
        if (SITE(11) && IN(pb + 10)) { LAUNDER();
            moe_table(F, l, ts, cn);
            PMoe2 p; p.G = F.G; p.c = F.bid; p.he = (const bf16*)(F.ws + WS_HE); p.w = (const bf16*)(F.ws + WS_MOEW); p.list = (const int2*)(F.ws + WS_LIST); p.c01 = (bf16*)(F.ws + WS_C01); p.ts = ts; p.cn = cn;
            fast_gemm_phase(F, p); SEAM(pb + 10); }
    }
    if (SITE(12) && IN(23)) { LAUNDER(); p_final(F); }
#undef IN
#undef SEAM
}

extern "C" void kernel_launch(void* const* d_in, const int* in_sizes, int n_in, void* d_out, int out_size, void* d_ws, size_t ws_size, hipStream_t stream) {
    static int grid = 0;
    if (grid == 0) {
        if (n_in != 25 || out_size != NL * D || ws_size < WS_END2) { fprintf(stderr, "kernel_launch: unexpected shapes (n_in %d, out %d, ws %zu)\n", n_in, out_size, ws_size); grid = -1; return; }
        int dev = 0, cus = 0, per_cu = 0;
        if (hipGetDevice(&dev) != hipSuccess || hipDeviceGetAttribute(&cus, hipDeviceAttributeMultiprocessorCount, dev) != hipSuccess) { grid = -1; return; }
        if (hipFuncSetAttribute((const void*)fwd_kernel, hipFuncAttributeMaxDynamicSharedMemorySize, LDS_BYTES) != hipSuccess) { fprintf(stderr, "kernel_launch: hipFuncSetAttribute failed\n"); grid = -1; return; }
        if (hipOccupancyMaxActiveBlocksPerMultiprocessor(&per_cu, (const void*)fwd_kernel, NTHR, LDS_BYTES) != hipSuccess || per_cu < 1) { fprintf(stderr, "kernel_launch: occupancy query says %d\n", per_cu); }
        (void)hipGetLastError();
        grid = cus;
    }
    if (grid < 0) return;
    (void)hipMemsetAsync((char*)d_ws + WS_CTL, 0, CTL_ZERO_BYTES, stream);
    Args a{};
    for (int i = 0; i < 25; ++i) a.in[i] = (const float*)d_in[i];
    a.out = (float*)d_out; a.ws = (unsigned char*)d_ws;
    if (MK_N_LAUNCHES == 1) { a.ph_lo = 0; a.ph_hi = NPH; hipLaunchKernelGGL(fwd_kernel, dim3(grid), dim3(NTHR), LDS_BYTES, stream, a); }
    else for (int p = 0; p < NPH; ++p) { a.ph_lo = p; a.ph_hi = p + 1; hipLaunchKernelGGL(fwd_kernel, dim3(grid), dim3(NTHR), LDS_BYTES, stream, a); }
}
```

```cpp
#include <hip/hip_runtime.h>
#include <cstdio>
#include <cstdint>

#ifndef MK_N_LAUNCHES
#define MK_N_LAUNCHES 1
#endif

#define GAS __attribute__((address_space(1)))
#define LAS __attribute__((address_space(3)))
typedef unsigned short bf16;
typedef unsigned v4u __attribute__((ext_vector_type(4)));
typedef unsigned v2u __attribute__((ext_vector_type(2)));
typedef float f32x4 __attribute__((ext_vector_type(4)));
typedef short bf16x8 __attribute__((ext_vector_type(8)));

constexpr int D = 1024, NB = 8, SEQ = 4096, CTX = 256, NL = NB * SEQ, NC = NB * CTX, NT = NL + NC;
constexpr int NPAN = NT / 256;
constexpr int INW = 4608, NE = 16, NMOD = 6;
constexpr float RMS_EPS = 1e-6f;
constexpr int NWAVES = 8, NTHR = 512;

constexpr size_t MiB = 1u << 20;
constexpr size_t WS_CTL = 0, CTL_ZERO_BYTES = 1 * MiB;
constexpr size_t WS_MODS = 1 * MiB;
constexpr size_t WS_WIN = 2 * MiB;
constexpr size_t WS_WR = 20 * MiB, WS_WF = 24 * MiB, WS_WO = 28 * MiB;
constexpr size_t WS_LRU = 32 * MiB;
constexpr size_t WS_CSC = 34 * MiB;
constexpr size_t WS_HCTX = 35 * MiB;
constexpr size_t WS_LIST = 43 * MiB;
constexpr size_t WS_CSL = 48 * MiB;
constexpr size_t WS_RA = 112 * MiB;
constexpr size_t WS_RB = 180 * MiB;
constexpr size_t WS_RC = 248 * MiB;
constexpr size_t WS_RD = 316 * MiB;
constexpr size_t WS_RE = 384 * MiB;
constexpr size_t WS_RF = 452 * MiB;
constexpr size_t WS_RG = 486 * MiB;
constexpr size_t WS_RH = 520 * MiB;
constexpr size_t WS_END = 588 * MiB;
constexpr size_t WS_MOEW = 180 * MiB;
constexpr size_t WS_HE = 276 * MiB;
constexpr size_t WS_C01 = 420 * MiB;
static_assert(WS_C01 + (size_t)2 * NT * D * 2 <= WS_END, "map");
static_assert(WS_RA + (size_t)NT * D * 2 <= WS_RB && WS_RH + (size_t)NT * D * 2 <= WS_END, "map");

constexpr int CW_TMO = 0;
constexpr int CW_CNT = 64;
constexpr int CW_BAR = 4096;

constexpr int LDS_BYTES = 147456;
constexpr int MISC_OFF = 131072 + 8192;

__device__ __forceinline__ unsigned f2bf(float f) { unsigned u = __builtin_bit_cast(unsigned, f); return (u + 0x7fffu + ((u >> 16) & 1u)) >> 16; }
__device__ __forceinline__ unsigned pk2(float lo, float hi) { return f2bf(lo) | (f2bf(hi) << 16); }
__device__ __forceinline__ float bflo(unsigned w) { return __builtin_bit_cast(float, w << 16); }
__device__ __forceinline__ float bfhi(unsigned w) { return __builtin_bit_cast(float, w & 0xffff0000u); }
__device__ __forceinline__ float bf2f(bf16 h) { return __builtin_bit_cast(float, ((unsigned)h) << 16); }
__device__ __forceinline__ v4u pack8(const float* v) { v4u o; o.x = pk2(v[0], v[1]); o.y = pk2(v[2], v[3]); o.z = pk2(v[4], v[5]); o.w = pk2(v[6], v[7]); return o; }
__device__ __forceinline__ void unpack8(v4u w, float* v) { v[0] = bflo(w.x); v[1] = bfhi(w.x); v[2] = bflo(w.y); v[3] = bfhi(w.y); v[4] = bflo(w.z); v[5] = bfhi(w.z); v[6] = bflo(w.w); v[7] = bfhi(w.w); }
__device__ __forceinline__ float sigmoidf_(float x) { return __builtin_amdgcn_rcpf(1.f + __expf(-x)); }
__device__ __forceinline__ float siluf_(float x) { return x * __builtin_amdgcn_rcpf(1.f + __expf(-x)); }
__device__ __forceinline__ float gelu_tanh(float x) { const float u = 0.7978845608028654f * (x + 0.044715f * x * x * x); const float e = __expf(2.f * u); const float t = 1.f - 2.f * __builtin_amdgcn_rcpf(e + 1.f); return 0.5f * x * (1.f + t); }
__device__ __forceinline__ float wave_sum(float v, int lane) {
#pragma unroll
    for (int o = 1; o < 64; o <<= 1) v += __builtin_bit_cast(float, __builtin_amdgcn_ds_bpermute((lane ^ o) << 2, __builtin_bit_cast(int, v)));
    return v;
}
#define LDS_WAIT() asm volatile("s_waitcnt lgkmcnt(0)" ::: "memory")
#define VM_WAIT() asm volatile("s_waitcnt vmcnt(0)" ::: "memory")

#define XB_TMO      128
#define XB_XCNT(j)  (256  + 64 * (j))
#define XB_XSUB(j)  (1280 + 64 * (j))
#define XB_XGEN(j)  (2304 + 64 * (j))
#define XB_TOP      3328
#define XB_TOPGEN   3392
#define XCD_BAR_WORDS 3456
#define XB_SPIN_CAP (1u << 18)
__device__ __forceinline__ unsigned xb_ld(unsigned* p)              { return __hip_atomic_load(p, __ATOMIC_RELAXED, __HIP_MEMORY_SCOPE_AGENT); }
__device__ __forceinline__ unsigned xb_add(unsigned* p, unsigned v) { return __hip_atomic_fetch_add(p, v, __ATOMIC_RELAXED, __HIP_MEMORY_SCOPE_AGENT); }
__device__ __forceinline__ unsigned xb_xcc_id() { return (unsigned)__builtin_amdgcn_s_getreg((3 << 11) | 20) & 0xFu; }
#define XB_SPIN(cond, bar) do { unsigned _sp = 0; while (cond) { __builtin_amdgcn_s_sleep(1); \
    if ((++_sp & 255u) == 0u) { if (xb_ld(&(bar)[XB_TMO])) break; if (_sp > XB_SPIN_CAP) { atomicAdd(&(bar)[XB_TMO], 1u); break; } } } } while (0)
struct XcdBarrier { unsigned* bar; unsigned x; volatile LAS unsigned* st; };
__device__ __forceinline__ XcdBarrier xcd_barrier_post(unsigned* bar, volatile LAS unsigned* st) {
    XcdBarrier b; b.bar = bar; b.x = xb_xcc_id(); b.st = st;
    if (threadIdx.x == 0) (void)xb_add(&bar[XB_XCNT(b.x)], 1u);
    return b;
}
__device__ __forceinline__ void xcd_barrier_complete(unsigned* bar, unsigned x, unsigned& nloc, unsigned& nx) {
    const unsigned G = gridDim.x * gridDim.y * gridDim.z;
    unsigned sum, cnt, mine, sp = 0u;
    for (;;) {
        sum = 0u; cnt = 0u; mine = 0u;
#pragma unroll
        for (unsigned j = 0; j < 16; ++j) { const unsigned c = xb_ld(&bar[XB_XCNT(j)]); sum += c; cnt += (c > 0u) ? 1u : 0u; mine = (j == x) ? c : mine; }
        if (sum == G) break;
        __builtin_amdgcn_s_sleep(1);
        if ((++sp & 255u) == 0u) { if (xb_ld(&bar[XB_TMO])) break; if (sp > XB_SPIN_CAP) { atomicAdd(&bar[XB_TMO], 1u); break; } }
    }
    nloc = mine > 0u ? mine : 1u; nx = cnt > 0u ? cnt : 1u;
}
__device__ __forceinline__ void xcd_barrier(const XcdBarrier& b) {
    asm volatile("s_waitcnt vmcnt(0)" ::: "memory");
    __syncthreads();
    if (threadIdx.x == 0) {
        unsigned* bar = b.bar;
        __builtin_amdgcn_s_waitcnt(0);
        unsigned nloc = b.st[0], nx = b.st[1];
        if (nloc == 0u) { xcd_barrier_complete(bar, b.x, nloc, nx); b.st[0] = nloc; b.st[1] = nx; }
        const unsigned old = xb_add(&bar[XB_XSUB(b.x)], 1u);
        const unsigned gen = old / nloc;
        if (old + 1u == (gen + 1u) * nloc) {
            __builtin_amdgcn_fence(__ATOMIC_RELEASE, "agent");
            asm volatile("s_waitcnt vmcnt(0)" ::: "memory");
            const unsigned og = xb_add(&bar[XB_TOP], 1u);
            const unsigned tg = og / nx;
            if (og + 1u == (tg + 1u) * nx) xb_add(&bar[XB_TOPGEN], 1u);
            else XB_SPIN(xb_ld(&bar[XB_TOPGEN]) == tg, bar);
            __builtin_amdgcn_fence(__ATOMIC_ACQUIRE, "agent");
            xb_add(&bar[XB_XGEN(b.x)], 1u);
            asm volatile("s_waitcnt vmcnt(0)" ::: "memory");
        } else {
            XB_SPIN(xb_ld(&bar[XB_XGEN(b.x)]) == gen, bar);
            __builtin_amdgcn_fence(__ATOMIC_ACQUIRE, "agent");
            asm volatile("s_waitcnt vmcnt(0)" ::: "memory");
        }
    }
    __syncthreads();
}

struct Frame {
    LAS unsigned char* lds;
    int tid, lane, wave, G, bid;
    unsigned* ctl;
    const float* const __attribute__((address_space(4)))* kin;
    float* out;
    unsigned char* ws;
};
__device__ __forceinline__ const float* modp(const Frame& F, int l, int mb, int which) { return (const float*)(F.ws + WS_MODS) + ((size_t)(l * 9 + mb) * NMOD + which) * D; }
__device__ __forceinline__ int mb_of(int r) { return r < NL ? (r >> 12) : 8; }

struct Unit { const bf16* A; const bf16* B; int lda, ldb, K; int pm, pn, x0, x1, x2; };

template <class P> __device__ __forceinline__ void simple_gemm_phase(Frame& F, const P& p) {
    LAS float* As = (LAS float*)F.lds;
    LAS float* Bs = As + 32 * 128;
    const int tid = F.tid, rg = tid >> 4, cg = tid & 15;
    Unit u;
    for (int i = 0; p.next(i, u); ++i) {
        for (int half = 0; half < 2; ++half) {
            float acc[4][16];
#pragma unroll
            for (int a = 0; a < 4; ++a)
#pragma unroll
                for (int b = 0; b < 16; ++b) acc[a][b] = 0.f;
            const int arow_i = tid >> 2, ak = (tid & 3) * 8, brow_i = tid >> 1, bk = (tid & 1) * 16;
            const bf16* arow = p.a_row(u, half * 128 + arow_i);
            const bf16* brow = u.B + (size_t)brow_i * u.ldb;
            for (int k0 = 0; k0 < u.K; k0 += 32) {
                const v4u a0 = *(const GAS v4u*)(arow + k0 + ak);
                const v4u b0 = *(const GAS v4u*)(brow + k0 + bk), b1 = *(const GAS v4u*)(brow + k0 + bk + 8);
                __syncthreads();
                float t[8];
                unpack8(a0, t);
#pragma unroll
                for (int j = 0; j < 8; ++j) As[(ak + j) * 128 + arow_i] = t[j];
                unpack8(b0, t);
#pragma unroll
                for (int j = 0; j < 8; ++j) Bs[(bk + j) * 256 + brow_i] = t[j];
                unpack8(b1, t);
#pragma unroll
                for (int j = 0; j < 8; ++j) Bs[(bk + 8 + j) * 256 + brow_i] = t[j];
                __syncthreads();
#pragma unroll 2
                for (int k = 0; k < 32; ++k) {
                    const f32x4 x0 = *(const LAS f32x4*)(As + k * 128 + rg * 4);
                    const f32x4 y0 = *(const LAS f32x4*)(Bs + k * 256 + cg * 8), y1 = *(const LAS f32x4*)(Bs + k * 256 + cg * 8 + 4);
                    const f32x4 y2 = *(const LAS f32x4*)(Bs + k * 256 + 128 + cg * 8), y3 = *(const LAS f32x4*)(Bs + k * 256 + 128 + cg * 8 + 4);
                    const float xa[4] = {x0[0], x0[1], x0[2], x0[3]};
                    const float yb[16] = {y0[0], y0[1], y0[2], y0[3], y1[0], y1[1], y1[2], y1[3], y2[0], y2[1], y2[2], y2[3], y3[0], y3[1], y3[2], y3[3]};
#pragma unroll
                    for (int a = 0; a < 4; ++a)
#pragma unroll
                        for (int b = 0; b < 16; ++b) acc[a][b] = __builtin_fmaf(xa[a], yb[b], acc[a][b]);
                }
            }
#pragma unroll
            for (int a = 0; a < 4; ++a) p.epi(u, half * 128 + rg * 4 + a, cg * 8, &acc[a][0], &acc[a][8]);
        }
    }
    __syncthreads();
}

constexpr int HTB = 128 * 64 * 2;
__device__ __forceinline__ int lds_byte(int r, int c) { const int st = (r >> 4) * 2 + (c >> 5), rr = r & 15, cc = c & 31, ob = rr * 64 + cc * 2; return st * 1024 + (ob ^ (((ob >> 9) & 1) << 5)); }
__device__ __forceinline__ void stage_rc(int b, int& R, int& C) { const int st = b / 1024, sb = b % 1024, swz = sb ^ (((sb >> 9) & 1) << 5); R = (st >> 1) * 16 + swz / 64; C = (st & 1) * 32 + (swz % 64) / 2; }
__device__ __forceinline__ int perm32(int rho) { const int n = rho >> 4, i = rho & 15; return 8 * (i >> 2) + 4 * n + (i & 3); }
template <class P> __device__ __forceinline__ void fast_gemm_phase(Frame& F, const P& p) {
    LAS unsigned char* lds = F.lds;
    const int tid = F.tid, wid = F.wave, lane = F.lane, wr = wid >> 2, wc = wid & 3, fr = lane & 15, fq = lane >> 4;
    int R0, C0, R1, C1; stage_rc(tid * 16, R0, C0); stage_rc(tid * 16 + 8192, R1, C1);
    const int Rb0 = (R0 & ~31) + perm32(R0 & 31), Rb1 = (R1 & ~31) + perm32(R1 & 31);
    const unsigned ldsw = (unsigned)wid * 1024u;
    const int aoffL = lds_byte(wr * 64 + fr, fq * 8), boffL = lds_byte(wc * 32 + fr, fq * 8);
    Unit cur, nxt; int ui = 0;
    if (!p.next(0, cur)) return;
    const char* sA; const char* sB; unsigned sa00, sa01, sa10, sa11, sb0, sb1; size_t shB;
#define FG_SET(u) do { sA = (const char*)(u).A; sB = (const char*)(u).B; shB = (size_t)128 * (u).ldb * 2; \
        sa00 = p.a_off((u), R0) + C0 * 2; sa01 = p.a_off((u), R1) + C1 * 2; sa10 = p.a_off((u), 128 + R0) + C0 * 2; sa11 = p.a_off((u), 128 + R1) + C1 * 2; \
        sb0 = (unsigned)(Rb0 * (u).ldb + C0) * 2u; sb1 = (unsigned)(Rb1 * (u).ldb + C1) * 2u; } while (0)
#define FG_SA(b, h) (((b) * 2 + (h)) * HTB)
#define FG_SB(b, h) ((4 + (b) * 2 + (h)) * HTB)
#define FG_GLDS(src, bufoff, i) __builtin_amdgcn_global_load_lds((const unsigned*)(src), (LAS unsigned*)(lds + (bufoff) + ldsw + (i) * 8192), 16, 0, 0)
#define FG_STAGE_A0(bufoff, kt) do { const char* _pa = sA + (size_t)(kt) * 128; FG_GLDS(_pa + sa00, bufoff, 0); FG_GLDS(_pa + sa01, bufoff, 1); } while (0)
#define FG_STAGE_A1(bufoff, kt) do { const char* _pa = sA + (size_t)(kt) * 128; FG_GLDS(_pa + sa10, bufoff, 0); FG_GLDS(_pa + sa11, bufoff, 1); } while (0)
#define FG_STAGE_B(bufoff, h, kt) do { const char* _pb = sB + ((size_t)(h) * shB + (size_t)(kt) * 128); FG_GLDS(_pb + sb0, bufoff, 0); FG_GLDS(_pb + sb1, bufoff, 1); } while (0)
#define FG_LDA(dst, b, h) do { _Pragma("unroll") for (int m = 0; m < 4; ++m) _Pragma("unroll") for (int k = 0; k < 2; ++k) dst[m][k] = *(const LAS bf16x8*)(lds + FG_SA(b, h) + aoffL + m * 2048 + k * 1024); } while (0)
#define FG_LDB(dst, b, h) do { _Pragma("unroll") for (int n = 0; n < 2; ++n) _Pragma("unroll") for (int k = 0; k < 2; ++k) dst[n][k] = *(const LAS bf16x8*)(lds + FG_SB(b, h) + boffL + n * 2048 + k * 1024); } while (0)
#define FG_MMA(ai, bj, At, Bt) do { __builtin_amdgcn_s_setprio(1); _Pragma("unroll") for (int m = 0; m < 4; ++m) _Pragma("unroll") for (int n = 0; n < 2; ++n) _Pragma("unroll") for (int k = 0; k < 2; ++k) \
        acc[ai][bj][m][n] = __builtin_amdgcn_mfma_f32_16x16x32_bf16(Bt[n][k], At[m][k], acc[ai][bj][m][n], 0, 0, 0); __builtin_amdgcn_s_setprio(0); } while (0)
#define FG_WAIT_V(n) asm volatile("s_waitcnt vmcnt(" #n ")" ::: "memory")
#define FG_WAIT_L(n) asm volatile("s_waitcnt lgkmcnt(" #n ")" ::: "memory")
#define FG_BAR __builtin_amdgcn_s_barrier()
#define FG_SCHED __builtin_amdgcn_sched_barrier(0)
    f32x4 acc[2][2][4][2];
#pragma unroll
    for (int a = 0; a < 2; ++a)
#pragma unroll
        for (int b = 0; b < 2; ++b)
#pragma unroll
            for (int m = 0; m < 4; ++m)
#pragma unroll
                for (int n = 0; n < 2; ++n) acc[a][b][m][n] = (f32x4){0.f, 0.f, 0.f, 0.f};
    bf16x8 At[4][2], B0[2][2], B1[2][2];
    FG_SET(cur);
    FG_STAGE_B(FG_SB(0, 0), 0, 0); FG_STAGE_B(FG_SB(0, 1), 1, 0); FG_STAGE_A0(FG_SA(0, 0), 0); FG_STAGE_A1(FG_SA(0, 1), 0);
    if (wr == 1) FG_BAR;
    FG_WAIT_V(2); FG_BAR;
    FG_STAGE_B(FG_SB(1, 0), 0, 1); FG_STAGE_A0(FG_SA(1, 0), 1); FG_STAGE_B(FG_SB(1, 1), 1, 1);
    FG_WAIT_V(6); FG_BAR;
    for (;;) {
        const bool has_next = p.next(ui + 1, nxt);
        const int nt = cur.K >> 6;
        for (int t = 0; t < nt; t += 2) {
            const bool last = (t == nt - 2);
            const int k2 = last ? 0 : t + 2, k3 = k2 + 1;
            FG_LDB(B0, 0, 0); FG_LDB(B1, 0, 1); FG_SCHED; FG_LDA(At, 0, 0); FG_STAGE_A1(FG_SA(1, 1), t + 1);
            if (last && has_next) FG_SET(nxt);
            FG_WAIT_V(8); FG_WAIT_L(0); FG_BAR; FG_MMA(0, 0, At, B0); FG_MMA(0, 1, At, B1); FG_BAR; FG_SCHED;
            FG_LDA(At, 0, 1); FG_STAGE_B(FG_SB(0, 0), 0, k2); FG_STAGE_B(FG_SB(0, 1), 1, k2); FG_STAGE_A0(FG_SA(0, 0), k2);
            FG_WAIT_V(8); FG_WAIT_L(0); FG_BAR; FG_MMA(1, 0, At, B0); FG_MMA(1, 1, At, B1); FG_BAR; FG_SCHED;
            FG_LDB(B0, 1, 0); FG_LDB(B1, 1, 1); FG_SCHED; FG_LDA(At, 1, 0); FG_STAGE_A1(FG_SA(0, 1), k2);
            FG_WAIT_V(8); FG_WAIT_L(0); FG_BAR; FG_MMA(0, 0, At, B0); FG_MMA(0, 1, At, B1); FG_BAR; FG_SCHED;
            FG_LDA(At, 1, 1); FG_STAGE_B(FG_SB(1, 0), 0, k3); FG_STAGE_B(FG_SB(1, 1), 1, k3); FG_STAGE_A0(FG_SA(1, 0), k3);
            FG_WAIT_V(8); FG_WAIT_L(0); FG_BAR; FG_MMA(1, 0, At, B0); FG_MMA(1, 1, At, B1); FG_BAR; FG_SCHED;
        }
        if (wr == 0) FG_BAR;
#pragma unroll
        for (int ai = 0; ai < 2; ++ai)
#pragma unroll
            for (int m = 0; m < 4; ++m) {
                const float v0[8] = {acc[ai][0][m][0][0], acc[ai][0][m][0][1], acc[ai][0][m][0][2], acc[ai][0][m][0][3], acc[ai][0][m][1][0], acc[ai][0][m][1][1], acc[ai][0][m][1][2], acc[ai][0][m][1][3]};
                const float v1[8] = {acc[ai][1][m][0][0], acc[ai][1][m][0][1], acc[ai][1][m][0][2], acc[ai][1][m][0][3], acc[ai][1][m][1][0], acc[ai][1][m][1][1], acc[ai][1][m][1][2], acc[ai][1][m][1][3]};
                p.epi(cur, ai * 128 + wr * 64 + m * 16 + fr, wc * 32 + fq * 8, v0, v1);
            }
        if (!has_next) break;
#pragma unroll
        for (int a = 0; a < 2; ++a)
#pragma unroll
            for (int b = 0; b < 2; ++b)
#pragma unroll
                for (int m = 0; m < 4; ++m)
#pragma unroll
                    for (int n = 0; n < 2; ++n) acc[a][b][m][n] = (f32x4){0.f, 0.f, 0.f, 0.f};
        cur = nxt; ++ui;
        if (wr == 1) FG_BAR;
    }
    FG_WAIT_V(0);
    FG_BAR;
#undef FG_SET
#undef FG_SA
#undef FG_SB
#undef FG_GLDS
#undef FG_STAGE_A0
#undef FG_STAGE_A1
#undef FG_STAGE_B
#undef FG_LDA
#undef FG_LDB
#undef FG_MMA
#undef FG_WAIT_V
#undef FG_WAIT_L
#undef FG_BAR
#undef FG_SCHED
}

struct PInproj {
    int G, c, l; const bf16* hx; const bf16* wt; bf16 *urnn, *gate, *ufour, *sgr, *sgf;
    __device__ __forceinline__ bool next(int i, Unit& u) const {
        const int idx = i * G + c; if (idx >= NPAN * 18) return false;
        u.pm = idx / 18; u.pn = idx % 18; u.A = hx + (size_t)u.pm * 256 * D; u.lda = D; u.B = wt + (size_t)u.pn * 256 * D; u.ldb = D; u.K = D; return true; }
    __device__ __forceinline__ const bf16* a_row(const Unit& u, int row) const { return u.A + (size_t)row * D; }
    __device__ __forceinline__ unsigned a_off(const Unit& u, int row) const { return (unsigned)row * (D * 2); }
    __device__ __forceinline__ void epi(const Unit& u, int row, int c8, const float* v0, const float* v1) const {
        const size_t r = (size_t)u.pm * 256 + row; const int col = u.pn * 256 + c8;
        float a[8], b[8];
        if (col < 1024) { *(GAS v4u*)(urnn + r * D + col) = pack8(v0); *(GAS v4u*)(urnn + r * D + col + 128) = pack8(v1); }
        else if (col < 2048) {
#pragma unroll
            for (int j = 0; j < 8; ++j) { a[j] = gelu_tanh(v0[j]); b[j] = gelu_tanh(v1[j]); }
            *(GAS v4u*)(gate + r * D + col - 1024) = pack8(a); *(GAS v4u*)(gate + r * D + col - 1024 + 128) = pack8(b); }
        else if (col < 2560) { *(GAS v4u*)(ufour + r * 512 + col - 2048) = pack8(v0); *(GAS v4u*)(ufour + r * 512 + col - 2048 + 128) = pack8(v1); }
        else {
#pragma unroll
            for (int j = 0; j < 8; ++j) { a[j] = sigmoidf_(v0[j]); b[j] = sigmoidf_(v1[j]); }
            bf16* dst = col < 3584 ? sgr + r * D + (col - 2560) : sgf + r * D + (col - 3584);
            *(GAS v4u*)dst = pack8(a); *(GAS v4u*)(dst + 128) = pack8(b); }
    }
};
struct PDft {
    int G, c; const bf16 *csl, *csc, *ut; bf16* g;
    __device__ __forceinline__ bool next(int i, Unit& u) const {
        const int idx = i * G + c; if (idx >= 544) return false;
        if (idx < 512) { const int b = idx >> 6, rem = idx & 63; u.pm = rem >> 1; u.pn = rem & 1; u.x0 = b; u.x1 = 0;
            u.A = csl + (size_t)u.pm * 256 * 4096; u.lda = 4096; u.B = ut + ((size_t)b * 512 + u.pn * 256) * 4096; u.ldb = 4096; u.K = 4096; }
        else { const int j = idx - 512, b = j >> 2, rem = j & 3; u.pm = rem >> 1; u.pn = rem & 1; u.x0 = b; u.x1 = 1;
            u.A = csc + (size_t)u.pm * 256 * 256; u.lda = 256; u.B = ut + (size_t)8 * 512 * 4096 + ((size_t)b * 512 + u.pn * 256) * 256; u.ldb = 256; u.K = 256; }
        return true; }
    __device__ __forceinline__ const bf16* a_row(const Unit& u, int row) const { return u.A + (size_t)row * u.lda; }
    __device__ __forceinline__ unsigned a_off(const Unit& u, int row) const { return (unsigned)(row * u.lda) * 2u; }
    __device__ __forceinline__ void epi(const Unit& u, int row, int c8, const float* v0, const float* v1) const {
        size_t r; int col;
        if (u.x1 == 0) { r = (size_t)u.x0 * 4096 + (u.pm & 15) * 256 + row; col = (u.pm >> 4) * 512 + u.pn * 256 + c8; }
        else { r = (size_t)NL + u.x0 * 256 + row; col = u.pm * 512 + u.pn * 256 + c8; }
        *(GAS v4u*)(g + r * D + col) = pack8(v0); *(GAS v4u*)(g + r * D + col + 128) = pack8(v1);
    }
};
struct PMerge {
    int G, c; const bf16 *gm, *y, *wf, *wr, *sgr, *sgf; bf16 *t1, *mg;
    __device__ __forceinline__ bool next(int i, Unit& u) const {
        const int tile = (i >> 1) * G + c; if (tile >= NPAN * 4) return false;
        u.pm = tile >> 2; u.pn = tile & 3; u.x0 = i & 1; u.lda = D; u.ldb = D; u.K = D;
        u.A = (u.x0 ? y : gm) + (size_t)u.pm * 256 * D; u.B = (u.x0 ? wr : wf) + (size_t)u.pn * 256 * D; return true; }
    __device__ __forceinline__ const bf16* a_row(const Unit& u, int row) const { return u.A + (size_t)row * D; }
    __device__ __forceinline__ unsigned a_off(const Unit& u, int row) const { return (unsigned)row * (D * 2); }
    __device__ __forceinline__ void epi(const Unit& u, int row, int c8, const float* v0, const float* v1) const {
        const size_t o = ((size_t)u.pm * 256 + row) * D + u.pn * 256 + c8;
#pragma unroll
        for (int h = 0; h < 2; ++h) { const float* v = h ? v1 : v0; const size_t oo = o + h * 128; float s[8], r[8];
            if (u.x0 == 0) { unpack8(*(const GAS v4u*)(sgf + oo), s);
#pragma unroll
                for (int j = 0; j < 8; ++j) r[j] = s[j] * v[j];
                *(GAS v4u*)(t1 + oo) = pack8(r); }
            else { float t[8]; unpack8(*(const GAS v4u*)(sgr + oo), s); unpack8(*(const GAS v4u*)(t1 + oo), t);
#pragma unroll
                for (int j = 0; j < 8; ++j) r[j] = s[j] * v[j] + t[j];
                *(GAS v4u*)(mg + oo) = pack8(r); } }
    }
};
struct PWout {
    int G, c; const bf16 *mg, *wo; const float *xold_l, *xold_c; float *xnew_l, *xnew_c; const float* g1;
    __device__ __forceinline__ bool next(int i, Unit& u) const {
        const int idx = i * G + c; if (idx >= NPAN * 4) return false;
        u.pm = idx >> 2; u.pn = idx & 3; u.lda = D; u.ldb = D; u.K = D; u.A = mg + (size_t)u.pm * 256 * D; u.B = wo + (size_t)u.pn * 256 * D; return true; }
    __device__ __forceinline__ const bf16* a_row(const Unit& u, int row) const { return u.A + (size_t)row * D; }
    __device__ __forceinline__ unsigned a_off(const Unit& u, int row) const { return (unsigned)row * (D * 2); }
    __device__ __forceinline__ void epi(const Unit& u, int row, int c8, const float* v0, const float* v1) const {
        const int r = u.pm * 256 + row; const int mb = mb_of(r);
        const float* xo = r < NL ? xold_l + (size_t)r * D : xold_c + (size_t)(r - NL) * D;
        float* xn = r < NL ? xnew_l + (size_t)r * D : xnew_c + (size_t)(r - NL) * D;
        const float* gg = g1 + (size_t)mb * NMOD * D;
#pragma unroll
        for (int h = 0; h < 2; ++h) { const float* v = h ? v1 : v0; const int col = u.pn * 256 + c8 + h * 128;
#pragma unroll
            for (int q = 0; q < 2; ++q) { const f32x4 xv = *(const GAS f32x4*)(xo + col + 4 * q), gv = *(const GAS f32x4*)(gg + col + 4 * q);
                f32x4 o; o[0] = xv[0] + gv[0] * v[4 * q]; o[1] = xv[1] + gv[1] * v[4 * q + 1]; o[2] = xv[2] + gv[2] * v[4 * q + 2]; o[3] = xv[3] + gv[3] * v[4 * q + 3];
                *(GAS f32x4*)(xn + col + 4 * q) = o; } }
    }
};
struct PMoe1 {
    int G, c; const bf16* hx2; const bf16* w; const int2* list; bf16* he; const LAS int* ts; const LAS int* cn;
    __device__ __forceinline__ bool next(int i, Unit& u) const {
        const int idx = i * G + c; if (idx >= __builtin_amdgcn_readfirstlane(ts[16]) * 8) return false;
        const int tile = idx >> 3; u.pn = idx & 7; u.pm = tile; int e = 0;
#pragma unroll
        for (int j = 1; j < 16; ++j) e += (tile >= ts[j]) ? 1 : 0;
        e = __builtin_amdgcn_readfirstlane(e);
        u.x0 = e; u.x1 = (tile - __builtin_amdgcn_readfirstlane(ts[e])) * 256; u.x2 = __builtin_amdgcn_readfirstlane(cn[e]);
        u.A = hx2; u.lda = D; u.B = w + (size_t)e * 3 * D * D + (size_t)u.pn * 256 * D; u.ldb = D; u.K = D; return true; }
    __device__ __forceinline__ const bf16* a_row(const Unit& u, int row) const {
        const int p = u.x1 + row; int r = 0; if (p < u.x2) r = list[(size_t)u.x0 * NT + p].x & 0x7fffffff; return hx2 + (size_t)r * D; }
    __device__ __forceinline__ unsigned a_off(const Unit& u, int row) const {
        int p = u.x1 + row; p = p < u.x2 ? p : u.x2 - 1; const int r = ((const GAS int*)list)[2 * ((size_t)u.x0 * NT + p)] & 0x7fffffff; return (unsigned)r * (D * 2); }
    __device__ __forceinline__ void epi(const Unit& u, int row, int c8, const float* v0, const float* v1) const {
        float r[8];
#pragma unroll
        for (int j = 0; j < 8; ++j) r[j] = siluf_(v0[j]) * v1[j];
        *(GAS v4u*)(he + ((size_t)u.pm * 256 + row) * D + u.pn * 128 + c8) = pack8(r);
    }
};
struct PMoe2 {
    int G, c; const bf16* he; const bf16* w; const int2* list; bf16* c01; const LAS int* ts; const LAS int* cn;
    __device__ __forceinline__ bool next(int i, Unit& u) const {
        const int idx = i * G + c; if (idx >= __builtin_amdgcn_readfirstlane(ts[16]) * 4) return false;
        const int tile = idx >> 2; u.pn = idx & 3; u.pm = tile; int e = 0;
#pragma unroll
        for (int j = 1; j < 16; ++j) e += (tile >= ts[j]) ? 1 : 0;
        e = __builtin_amdgcn_readfirstlane(e);
        u.x0 = e; u.x1 = (tile - __builtin_amdgcn_readfirstlane(ts[e])) * 256; u.x2 = __builtin_amdgcn_readfirstlane(cn[e]);
        u.A = he + (size_t)tile * 256 * D; u.lda = D; u.B = w + (size_t)e * 3 * D * D + (size_t)2 * D * D + (size_t)u.pn * 256 * D; u.ldb = D; u.K = D; return true; }
    __device__ __forceinline__ const bf16* a_row(const Unit& u, int row) const { return u.A + (size_t)row * D; }
    __device__ __forceinline__ unsigned a_off(const Unit& u, int row) const { return (unsigned)row * (D * 2); }
    __device__ __forceinline__ void epi(const Unit& u, int row, int c8, const float* v0, const float* v1) const {
        const int p = u.x1 + row; if (p >= u.x2) return;
        const int2 en = list[(size_t)u.x0 * NT + p]; const int r = en.x & 0x7fffffff, s = (en.x >> 31) & 1; const float w8 = __builtin_bit_cast(float, en.y);
        bf16* dst = c01 + ((size_t)s * NT + r) * D + u.pn * 256 + c8; float a[8], b[8];
#pragma unroll
        for (int j = 0; j < 8; ++j) { a[j] = w8 * v0[j]; b[j] = w8 * v1[j]; }
        *(GAS v4u*)dst = pack8(a); *(GAS v4u*)(dst + 128) = pack8(b);
    }
};

__device__ __forceinline__ void transpose_item(const float* W, int K, int N, bf16* WT, int k0, int n0, int drow0, LAS float* scr, int lane) {
    const int kr = lane >> 3, n4 = (lane & 7) * 4; f32x4 v[8];
#pragma unroll
    for (int i = 0; i < 8; ++i) v[i] = *(const GAS f32x4*)(W + (size_t)(k0 + 8 * i + kr) * N + n0 + n4);
#pragma unroll
    for (int i = 0; i < 8; ++i) { LAS float* d = scr + (8 * i + kr) * 33 + n4; d[0] = v[i][0]; d[1] = v[i][1]; d[2] = v[i][2]; d[3] = v[i][3]; }
    LDS_WAIT(); asm volatile("" ::: "memory");
    const int c = lane & 7;
#pragma unroll
    for (int j = 0; j < 4; ++j) { const int n = (lane >> 3) + 8 * j; const LAS float* s = scr + (8 * c) * 33 + n;
        v4u o; o.x = pk2(s[0 * 33], s[1 * 33]); o.y = pk2(s[2 * 33], s[3 * 33]); o.z = pk2(s[4 * 33], s[5 * 33]); o.w = pk2(s[6 * 33], s[7 * 33]);
        *(GAS v4u*)(WT + (size_t)(drow0 + n) * K + k0 + 8 * c) = o; }
    LDS_WAIT(); asm volatile("" ::: "memory");
}
__device__ __forceinline__ void p_prologue(Frame& F) {
    const int gw = F.bid * NWAVES + F.wave, NGW = F.G * NWAVES;
    LAS float* scr = (LAS float*)(F.lds + F.wave * 16384);
    constexpr int I_IN = 16 * 144, I_SQ = 16 * 32;
    constexpr int NIT = 2 * (I_IN + 2 * I_SQ);
    for (int it = gw; it < NIT; it += NGW) {
        int r = it; const int l = r / (I_IN + 2 * I_SQ); r -= l * (I_IN + 2 * I_SQ);
        if (r < I_IN) { const int kb = r / 144, nb = r % 144; transpose_item(F.kin[7] + (size_t)l * D * INW, D, INW, (bf16*)(F.ws + WS_WIN) + (size_t)l * INW * D, kb * 64, nb * 32, nb * 32, scr, F.lane); continue; }
        r -= I_IN;
        const int which = r / I_SQ; r -= which * I_SQ; const int kb = r / 32, nb = r % 32;
        transpose_item(F.kin[which ? 17 : 15] + (size_t)l * D * D, D, D, (bf16*)(F.ws + (which ? WS_WO : WS_WR)) + (size_t)l * D * D, kb * 64, nb * 32, nb * 32, scr, F.lane);
    }
    __syncthreads();
    LAS float* T4 = (LAS float*)(F.lds + 65536);
    for (int o = F.tid; o < 4096; o += NTHR) T4[o] = cospif((float)o * (2.0f / 4096.0f));
    __syncthreads();
    for (int o = F.bid * NTHR + F.tid; o < 2 * D * D; o += F.G * NTHR) {
        const int l = o >> 20, rem = o & (D * D - 1), kk = rem >> 10, n = rem & 1023;
        const int ch = kk & 511, g = ch >> 7, cc = ch & 127; const bool sn = kk >= 512;
        const float* wf = F.kin[16] + (size_t)l * 512 * D + (size_t)(g * 128) * D + n; float s = 0.f;
#pragma unroll 8
        for (int m = 0; m < 128; ++m) { const int ph = (cc * m) & 127;
            s += T4[(32 * ph + (sn ? 1024 : 0)) & 4095] * wf[(size_t)m * D]; }
        ((bf16*)(F.ws + WS_WF))[(size_t)l * D * D + (size_t)n * D + kk] = (bf16)f2bf(s);
    }
    { const float scl = 1.0f / sqrtf(4096.f * 128.f), scc = 1.0f / sqrtf(256.f * 128.f);
      for (size_t o = (size_t)F.bid * NTHR + F.tid; o < (size_t)8192 * 512; o += (size_t)F.G * NTHR) {
          const int r = (int)(o >> 9), t0 = (int)(o & 511) * 8, rr = r & 4095, sh = r < 4096 ? 0 : 3072; float v[8];
#pragma unroll
          for (int j = 0; j < 8; ++j) v[j] = T4[(rr * (t0 + j) + sh) & 4095] * scl;
          *(GAS v4u*)((bf16*)(F.ws + WS_CSL) + (size_t)r * 4096 + t0) = pack8(v); }
      for (int o = F.bid * NTHR + F.tid; o < 512 * 32; o += F.G * NTHR) {
          const int r = o >> 5, t0 = (o & 31) * 8, rr = r & 255, sh = r < 256 ? 0 : 3072; float v[8];
#pragma unroll
          for (int j = 0; j < 8; ++j) v[j] = T4[(16 * ((rr * (t0 + j)) & 255) + sh) & 4095] * scc;
          *(GAS v4u*)((bf16*)(F.ws + WS_CSC) + (size_t)r * 256 + t0) = pack8(v); } }
    for (int o = F.bid * NTHR + F.tid; o < 2 * 2 * 1024; o += F.G * NTHR) { const float lam = F.kin[14][o]; const float sp = (-lam > 20.f) ? -lam : log1pf(__expf(-lam));
        ((float*)(F.ws + WS_MODS + 512 * 1024))[o] = -8.0f * sp; }
    __syncthreads();
    { LAS float* sc = (LAS float*)(F.lds + 131072 - 9 * 1024 * 4);
      LAS float* red = (LAS float*)F.lds;
      for (int o = F.tid; o < 9 * 1024; o += NTHR) { const float cv = o < 8192 ? F.kin[1][o] : F.kin[3][o - 8192]; sc[o] = siluf_(cv); }
      __syncthreads();
      for (int it = F.bid; it < 2 * (NMOD * D / 64); it += F.G) {
          const int l = it / (NMOD * D / 64), n = (it % (NMOD * D / 64)) * 64 + F.lane; const float* w = F.kin[4] + (size_t)l * D * NMOD * D + n; float acc[9];
#pragma unroll
          for (int q = 0; q < 9; ++q) acc[q] = 0.f;
#pragma unroll 16
          for (int k = F.wave * 128; k < F.wave * 128 + 128; ++k) { const float wv = w[(size_t)k * NMOD * D];
#pragma unroll
              for (int q = 0; q < 9; ++q) acc[q] += sc[q * 1024 + k] * wv; }
#pragma unroll
          for (int q = 0; q < 9; ++q) red[(F.wave * 9 + q) * 64 + F.lane] = acc[q];
          __syncthreads();
          for (int o = F.tid; o < 9 * 64; o += NTHR) { const int q = o >> 6, ln = o & 63; float s = 0.f;
#pragma unroll
              for (int wv = 0; wv < 8; ++wv) s += red[(wv * 9 + q) * 64 + ln];
              const int nn = (it % (NMOD * D / 64)) * 64 + ln;
              ((float*)(F.ws + WS_MODS))[((size_t)(l * 9 + q)) * NMOD * D + nn] = s + F.kin[5][(size_t)l * NMOD * D + nn]; }
          __syncthreads();
      } }
}

__device__ __forceinline__ void p_norm1(Frame& F, int l) {
    const int gw = F.bid * NWAVES + F.wave, NGW = F.G * NWAVES;
    const float* gn = F.kin[6] + (size_t)l * D;
    bf16* hx = (bf16*)(F.ws + WS_RA); const bf16* c01 = (const bf16*)(F.ws + WS_C01);
    for (int r = gw; r < NT; r += NGW) {
        const int mb = mb_of(r);
        const float* src = l == 0 ? (r < NL ? F.kin[0] + (size_t)r * D : F.kin[2] + (size_t)(r - NL) * D)
                                  : (r < NL ? F.out + (size_t)r * D : (const float*)(F.ws + WS_HCTX) + (size_t)(r - NL) * D);
        f32x4 v[4]; float ss = 0.f;
#pragma unroll
        for (int j = 0; j < 4; ++j) v[j] = *(const GAS f32x4*)(src + F.lane * 4 + 256 * j);
        if (l == 1) { const float* g2 = modp(F, 0, mb, 5);
#pragma unroll
            for (int j = 0; j < 4; ++j) { const int k = F.lane * 4 + 256 * j; const v2u a = *(const GAS v2u*)(c01 + (size_t)r * D + k), b = *(const GAS v2u*)(c01 + ((size_t)NT + r) * D + k);
                const f32x4 gv = *(const GAS f32x4*)(g2 + k);
                v[j][0] += gv[0] * (bflo(a.x) + bflo(b.x)); v[j][1] += gv[1] * (bfhi(a.x) + bfhi(b.x)); v[j][2] += gv[2] * (bflo(a.y) + bflo(b.y)); v[j][3] += gv[3] * (bfhi(a.y) + bfhi(b.y));
                *(GAS f32x4*)((float*)src + k) = v[j]; } }
#pragma unroll
        for (int j = 0; j < 4; ++j) ss += (v[j][0] * v[j][0] + v[j][1] * v[j][1]) + (v[j][2] * v[j][2] + v[j][3] * v[j][3]);
        const float rstd = rsqrtf(wave_sum(ss, F.lane) * (1.f / D) + RMS_EPS);
        const float *sh = modp(F, l, mb, 0), *sc = modp(F, l, mb, 1);
#pragma unroll
        for (int j = 0; j < 4; ++j) { const int k = F.lane * 4 + 256 * j; const f32x4 g = *(const GAS f32x4*)(gn + k), s1 = *(const GAS f32x4*)(sc + k), s0 = *(const GAS f32x4*)(sh + k);
            float o[4];
#pragma unroll
            for (int q = 0; q < 4; ++q) o[q] = v[j][q] * rstd * g[q] * (1.f + s1[q]) + s0[q];
            v2u w; w.x = pk2(o[0], o[1]); w.y = pk2(o[2], o[3]); *(GAS v2u*)(hx + (size_t)r * D + k) = w; }
    }
}
__device__ __forceinline__ void p_final(Frame& F) {
    const int gw = F.bid * NWAVES + F.wave, NGW = F.G * NWAVES;
    const bf16* c01 = (const bf16*)(F.ws + WS_C01);
    for (int r = gw; r < NL; r += NGW) {
        const int mb = r >> 12; float* src = F.out + (size_t)r * D; const float* g2 = modp(F, 1, mb, 5);
        f32x4 v[4]; float ss = 0.f;
#pragma unroll
        for (int j = 0; j < 4; ++j) { const int k = F.lane * 4 + 256 * j; v[j] = *(const GAS f32x4*)(src + k);
            const v2u a = *(const GAS v2u*)(c01 + (size_t)r * D + k), b = *(const GAS v2u*)(c01 + ((size_t)NT + r) * D + k); const f32x4 gv = *(const GAS f32x4*)(g2 + k);
            v[j][0] += gv[0] * (bflo(a.x) + bflo(b.x)); v[j][1] += gv[1] * (bfhi(a.x) + bfhi(b.x)); v[j][2] += gv[2] * (bflo(a.y) + bflo(b.y)); v[j][3] += gv[3] * (bfhi(a.y) + bfhi(b.y));
            ss += (v[j][0] * v[j][0] + v[j][1] * v[j][1]) + (v[j][2] * v[j][2] + v[j][3] * v[j][3]); }
        const float rstd = rsqrtf(wave_sum(ss, F.lane) * (1.f / D) + RMS_EPS);
#pragma unroll
        for (int j = 0; j < 4; ++j) { const int k = F.lane * 4 + 256 * j; const f32x4 g = *(const GAS f32x4*)(F.kin[24] + k); f32x4 o;
#pragma unroll
            for (int q = 0; q < 4; ++q) o[q] = v[j][q] * rstd * g[q];
            *(GAS f32x4*)(src + k) = o; }
    }
}
__device__ __forceinline__ void p_transpose(Frame& F) {
    LAS bf16* tile = (LAS bf16*)F.lds;
    const bf16* uf = (const bf16*)(F.ws + WS_RF); bf16* ut = (bf16*)(F.ws + WS_RG);
    for (int it = F.bid; it < 4096 + 256; it += F.G) {
        int b, tb, cb, L; size_t rowbase; bf16* dst;
        if (it < 4096) { b = it >> 9; tb = (it >> 3) & 63; cb = it & 7; L = 4096; rowbase = (size_t)b * 4096 + tb * 64; dst = ut + (size_t)b * 512 * 4096; }
        else { const int j = it - 4096; b = j >> 5; tb = (j >> 3) & 3; cb = j & 7; L = 256; rowbase = (size_t)NL + b * 256 + tb * 64; dst = ut + (size_t)8 * 512 * 4096 + (size_t)b * 512 * 256; }
        { const int t = F.tid >> 3, c8 = (F.tid & 7) * 8; const v4u w = *(const GAS v4u*)(uf + (rowbase + t) * 512 + cb * 64 + c8);
          LAS unsigned* p = (LAS unsigned*)(tile + t * 72 + c8); p[0] = w.x; p[1] = w.y; p[2] = w.z; p[3] = w.w; }
        __syncthreads();
        { const int c = F.tid >> 3, t8 = (F.tid & 7) * 8; v4u o; unsigned h[8];
#pragma unroll
          for (int j = 0; j < 8; ++j) h[j] = tile[(t8 + j) * 72 + c];
          o.x = h[0] | (h[1] << 16); o.y = h[2] | (h[3] << 16); o.z = h[4] | (h[5] << 16); o.w = h[6] | (h[7] << 16);
          *(GAS v4u*)(dst + (size_t)(cb * 64 + c) * L + tb * 64 + t8) = o; }
        __syncthreads();
    }
}
__device__ __forceinline__ void p_scan_simple(Frame& F, int l) {
    if (F.bid >= 128) return;
    const int b = F.bid >> 4, h = (F.bid >> 1) & 7, d = F.bid & 1;
    LAS float* U = (LAS float*)F.lds;
    LAS float* RAg = U + 64 * 128;
    LAS float* XIg = RAg + 64 * 128;
    const bf16* urnn = (const bf16*)(F.ws + WS_RB);
    bf16* hout = (bf16*)(F.ws + (d ? WS_RF : WS_RA));
    const float* cw = F.kin[8] + (size_t)l * 4 * D + h * 128; const float* cb = F.kin[9] + (size_t)l * D + h * 128;
    const float* Wa = F.kin[10] + ((size_t)(l * 2 + d) * 8 + h) * 128 * 128; const float* Wx = F.kin[12] + ((size_t)(l * 2 + d) * 8 + h) * 128 * 128;
    const float* ba = F.kin[11] + ((size_t)(l * 2 + d) * 8 + h) * 128; const float* bx = F.kin[13] + ((size_t)(l * 2 + d) * 8 + h) * 128;
    const float* n8 = (const float*)(F.ws + WS_MODS + 512 * 1024) + (size_t)(l * 2 + d) * 1024 + h * 128;
    const int ch = F.tid & 127, tq = F.tid >> 7;
    float hstate = 0.f;
    for (int step = 0; step < 68; ++step) {
        const int j = d == 0 ? step : (step < 4 ? 3 - step : 71 - step);
        const bool isctx = j < 4; const size_t row0 = isctx ? (size_t)NL + b * 256 + j * 64 : (size_t)b * 4096 + (size_t)(j - 4) * 64;
        __syncthreads();
        for (int o = F.tid; o < 64 * 128; o += NTHR) { const int t = o >> 7, c = o & 127; float s = cb[c];
#pragma unroll
            for (int k = 0; k < 4; ++k) { const int tt = t + k - 2; bool ok; if (isctx) { const int g = j * 64 + tt; ok = g >= 0 && g < 256; } else ok = tt >= 0 && tt < 64;
                if (ok) s += cw[(size_t)k * D + c] * bf2f(urnn[(row0 + tt) * D + h * 128 + c]); }
            U[o] = s; }
        __syncthreads();
        { float ar[16], ax[16];
#pragma unroll
          for (int q = 0; q < 16; ++q) { ar[q] = 0.f; ax[q] = 0.f; }
          for (int k = 0; k < 128; ++k) { const float wa = Wa[(size_t)k * 128 + ch], wx = Wx[(size_t)k * 128 + ch];
#pragma unroll
              for (int q = 0; q < 16; ++q) { const float uv = U[(tq * 16 + q) * 128 + k]; ar[q] += uv * wa; ax[q] += uv * wx; } }
          const float bav = ba[ch], bxv = bx[ch], n8v = n8[ch];
#pragma unroll
          for (int q = 0; q < 16; ++q) { const int t = tq * 16 + q; const float r = sigmoidf_(ar[q] + bav), ig = sigmoidf_(ax[q] + bxv);
              const float la = n8v * r, a = __expf(la), y2 = 2.f * la;
              const float om = (y2 > -0.02f) ? -(y2 * (1.f + y2 * (0.5f + y2 * (1.f / 6.f)))) : 1.f - __expf(y2);
              RAg[t * 128 + ch] = a; XIg[t * 128 + ch] = sqrtf(om) * ig * U[t * 128 + ch]; } }
        __syncthreads();
        if (F.tid < 128) {
            for (int q = 0; q < 64; ++q) { const int t = d == 0 ? q : 63 - q; hstate = RAg[t * 128 + ch] * hstate + XIg[t * 128 + ch]; RAg[t * 128 + ch] = hstate; } }
        __syncthreads();
        for (int o = F.tid; o < 64 * 16; o += NTHR) { const int t = o >> 4, c8 = (o & 15) * 8; float v[8];
#pragma unroll
            for (int q = 0; q < 8; ++q) v[q] = RAg[t * 128 + c8 + q];
            *(GAS v4u*)(hout + (row0 + t) * D + h * 128 + c8) = pack8(v); }
    }
}
constexpr size_t WS_SUM = 588 * MiB;
constexpr size_t WS_CIN = 597 * MiB;
constexpr size_t WS_END2 = 602 * MiB;
constexpr int SC_XRAW = 0, SC_U32 = 17408, SC_UBF = SC_U32 + 32768, SC_YT = SC_UBF + 16384, SC_CW = SC_YT + 16384;
__device__ __forceinline__ float fast_sigmoid(float x) { return __builtin_amdgcn_rcpf(1.f + __expf(-x)); }
template <int PASS> __device__ __forceinline__ void p_scan_fast(Frame& F, int l) {
    LAS unsigned char* lds = F.lds;
    const int tid = F.tid, lane = F.lane, w = F.wave, fr = lane & 15, fq = lane >> 4;
    const bf16* urnn = (const bf16*)(F.ws + WS_RB); const bf16* gate = (const bf16*)(F.ws + WS_RC); bf16* yout = (bf16*)(F.ws + WS_RA);
    float* SUM = (float*)(F.ws + WS_SUM); const float* CIN = (const float*)(F.ws + WS_CIN);
    const int h = F.bid & 7, qi = F.bid >> 3, nq = (F.G - h + 7) >> 3;
    bf16x8 bw[4][4];
    float bia[4];
    const unsigned wloff = (unsigned)((8 * fq) * 128 + 16 * w + fr) * 4u;
#pragma unroll
    for (int ty = 0; ty < 4; ++ty) { const int d = ty >> 1; const char* Wh = (const char*)(F.kin[(ty & 1) ? 12 : 10] + ((size_t)(l * 2 + d) * 8 + h) * 128 * 128);
#pragma unroll
        for (int ks = 0; ks < 4; ++ks) { float t8[8];
#pragma unroll
            for (int q = 0; q < 8; ++q) t8[q] = *(const GAS float*)(Wh + (size_t)(32 * ks + q) * 512 + wloff);
            const v4u pk = pack8(t8); bw[ty][ks] = __builtin_bit_cast(bf16x8, pk); }
        bia[ty] = F.kin[(ty & 1) ? 13 : 11][((size_t)(l * 2 + d) * 8 + h) * 128 + 16 * w + fr]; }
    const float n8f = ((const float*)(F.ws + WS_MODS + 512 * 1024))[(size_t)(l * 2 + 0) * 1024 + h * 128 + 16 * w + fr];
    const float n8b = ((const float*)(F.ws + WS_MODS + 512 * 1024))[(size_t)(l * 2 + 1) * 1024 + h * 128 + 16 * w + fr];
    { LAS float* CW = (LAS float*)(lds + SC_CW);
      for (int o = tid; o < 5 * 128; o += NTHR) CW[o] = o < 512 ? F.kin[8][(size_t)l * 4 * D + (size_t)(o >> 7) * D + h * 128 + (o & 127)] : F.kin[9][(size_t)l * D + h * 128 + (o & 127)]; }
    v4u raw[3];
#define SC_LOAD_RAW(PI) do { const int b_ = (PI) / 68, j_ = (PI) % 68; const bool ic_ = j_ < 4; const size_t r0_ = ic_ ? (size_t)NL + b_ * 256 + j_ * 64 : (size_t)b_ * 4096 + (size_t)(j_ - 4) * 64; \
        _Pragma("unroll") for (int q3 = 0; q3 < 3; ++q3) { const int p_ = tid + q3 * 512, rr_ = p_ >> 4, c16_ = p_ & 15, tt_ = rr_ - 2; bool ok_ = p_ < 68 * 16; \
            if (ic_) { const int g_ = j_ * 64 + tt_; ok_ = ok_ && g_ >= 0 && g_ < 256; } else ok_ = ok_ && tt_ >= 0 && tt_ < 64; \
            const v4u v_ = *(const GAS v4u*)(urnn + (r0_ + (ok_ ? tt_ : 0)) * D + h * 128 + c16_ * 8);     \
            raw[q3].x = ok_ ? v_.x : 0u; raw[q3].y = ok_ ? v_.y : 0u; raw[q3].z = ok_ ? v_.z : 0u; raw[q3].w = ok_ ? v_.w : 0u; } } while (0)
    if (qi < 544) SC_LOAD_RAW(qi);
    for (int pi = qi; pi < 544; pi += nq) {
        const int b = pi / 68, j = pi % 68;
        const bool isctx = j < 4; const size_t row0 = isctx ? (size_t)NL + b * 256 + j * 64 : (size_t)b * 4096 + (size_t)(j - 4) * 64;
        __syncthreads();
#pragma unroll
        for (int q3 = 0; q3 < 3; ++q3) { const int p = tid + q3 * 512; if (p < 68 * 16) *(LAS v4u*)(lds + SC_XRAW + (p >> 4) * 256 + (p & 15) * 16) = raw[q3]; }
        __syncthreads();
        if (pi + nq < 544) SC_LOAD_RAW(pi + nq);
        v4u gt0 = (v4u){0u, 0u, 0u, 0u}, gt1 = gt0; float cinf = 0.f, cinb = 0.f;
        if (PASS == 2) { const bf16* gp = gate + (row0 + (tid >> 3)) * D + h * 128 + (tid & 7) * 16; gt0 = *(const GAS v4u*)gp; gt1 = *(const GAS v4u*)(gp + 8);
            cinf = CIN[(((size_t)b * 2 + 0) * 68 + j) * 1024 + h * 128 + 16 * w + fr]; cinb = CIN[(((size_t)b * 2 + 1) * 68 + j) * 1024 + h * 128 + 16 * w + fr]; }
        { const int t = tid >> 3, cg = tid & 7; const LAS float* CW = (const LAS float*)(lds + SC_CW); float u[16];
#pragma unroll
          for (int q = 0; q < 16; ++q) u[q] = CW[512 + cg * 16 + q];
#pragma unroll
          for (int k = 0; k < 4; ++k) { float x[16]; unpack8(*(const LAS v4u*)(lds + SC_XRAW + (t + k) * 256 + cg * 32), x); unpack8(*(const LAS v4u*)(lds + SC_XRAW + (t + k) * 256 + cg * 32 + 16), x + 8);
#pragma unroll
              for (int q = 0; q < 16; ++q) u[q] += CW[k * 128 + cg * 16 + q] * x[q]; }
#pragma unroll
          for (int q = 0; q < 4; ++q) *(LAS f32x4*)(lds + SC_U32 + t * 512 + cg * 64 + q * 16) = (f32x4){u[4 * q], u[4 * q + 1], u[4 * q + 2], u[4 * q + 3]};
          const int ft = (t & 3) | (((t >> 4) & 3) << 2);
          *(LAS v4u*)(lds + SC_UBF + t * 256 + (((cg * 2) ^ ft) << 4)) = pack8(u); *(LAS v4u*)(lds + SC_UBF + t * 256 + (((cg * 2 + 1) ^ ft) << 4)) = pack8(u + 8); }
        __syncthreads();
        const int c = 16 * w + fr;
        float hs[16];
#pragma unroll
        for (int d = 0; d < 2; ++d) {
            f32x4 acc[2][4];
#pragma unroll
            for (int ty = 0; ty < 2; ++ty)
#pragma unroll
                for (int m = 0; m < 4; ++m) acc[ty][m] = (f32x4){0.f, 0.f, 0.f, 0.f};
#pragma unroll
            for (int m = 0; m < 4; ++m) { const int tau = 16 * (fr >> 2) + 4 * m + (fr & 3);
#pragma unroll
                for (int ks = 0; ks < 4; ++ks) { const bf16x8 af = *(const LAS bf16x8*)(lds + SC_UBF + tau * 256 + (((4 * ks + fq) ^ fr) << 4));
                    acc[0][m] = __builtin_amdgcn_mfma_f32_16x16x32_bf16(af, bw[2 * d][ks], acc[0][m], 0, 0, 0); acc[1][m] = __builtin_amdgcn_mfma_f32_16x16x32_bf16(af, bw[2 * d + 1][ks], acc[1][m], 0, 0, 0); } }
            float av[16], bv[16]; const float n8 = d ? n8b : n8f, b_a = bia[2 * d], b_x = bia[2 * d + 1];
#pragma unroll
            for (int q = 0; q < 16; ++q) { const float r = fast_sigmoid(acc[0][q >> 2][q & 3] + b_a), ig = fast_sigmoid(acc[1][q >> 2][q & 3] + b_x);
                const float la = n8 * r, a = __expf(la), y2 = 2.f * la;
                const float ser = -(y2 * (1.f + y2 * (0.5f + y2 * (1.f / 6.f)))), dif = 1.f - a * a;
                const float om = (y2 > -0.02f) ? ser : dif;
                av[q] = a; bv[q] = __builtin_amdgcn_sqrtf(om) * ig * *(const LAS float*)(lds + SC_U32 + (16 * fq + q) * 512 + c * 4);
                if ((q & 3) == 3) __builtin_amdgcn_sched_barrier(0); }
            float P = 1.f, H = 0.f;
#pragma unroll
            for (int q = 0; q < 16; ++q) { const int t = d ? 15 - q : q; H = av[t] * H + bv[t]; P *= av[t]; }
            float Ps[4], Hs[4];
#pragma unroll
            for (int sgi = 0; sgi < 4; ++sgi) { Ps[sgi] = __builtin_bit_cast(float, __builtin_amdgcn_ds_bpermute(((sgi << 4) | fr) << 2, __builtin_bit_cast(int, P)));
                                              Hs[sgi] = __builtin_bit_cast(float, __builtin_amdgcn_ds_bpermute(((sgi << 4) | fr) << 2, __builtin_bit_cast(int, H))); }
            if (PASS == 1) {
                float Pt = 1.f, Ht = 0.f;
#pragma unroll
                for (int q = 0; q < 4; ++q) { const int sgi = d ? 3 - q : q; Ht = Ps[sgi] * Ht + Hs[sgi]; Pt *= Ps[sgi]; }
                if (fq == 0) { float* dst = SUM + ((((size_t)b * 2 + d) * 68 + j) * 2) * 1024 + h * 128 + c; dst[0] = Pt; dst[1024] = Ht; }
            } else {
                float cin = d ? cinb : cinf;
#pragma unroll
                for (int q = 0; q < 3; ++q) { const int sgi = d ? 3 - q : q; const bool before = d ? (sgi > fq) : (sgi < fq); if (before) cin = Ps[sgi] * cin + Hs[sgi]; }
                float hh = cin;
#pragma unroll
                for (int q = 0; q < 16; ++q) { const int t = d ? 15 - q : q; hh = av[t] * hh + bv[t]; if (d == 0) hs[t] = hh; else hs[t] += hh; }
            }
        }
        if (PASS == 2) {
#pragma unroll
            for (int q = 0; q < 16; ++q) *(LAS bf16*)(lds + SC_YT + (16 * fq + q) * 256 + c * 2) = (bf16)f2bf(hs[q]);
            __syncthreads();
            { const int t = tid >> 3, cg = tid & 7; float yv[16], gv[16];
              unpack8(*(const LAS v4u*)(lds + SC_YT + t * 256 + cg * 32), yv); unpack8(*(const LAS v4u*)(lds + SC_YT + t * 256 + cg * 32 + 16), yv + 8);
              unpack8(gt0, gv); unpack8(gt1, gv + 8);
#pragma unroll
              for (int q = 0; q < 16; ++q) yv[q] *= gv[q];
              bf16* yp = yout + (row0 + t) * D + h * 128 + cg * 16; *(GAS v4u*)yp = pack8(yv); *(GAS v4u*)(yp + 8) = pack8(yv + 8); }
        }
    }
#undef SC_LOAD_RAW
    __syncthreads();
}
__device__ __forceinline__ void p_scan_carry(Frame& F) {
    const float* SUM = (const float*)(F.ws + WS_SUM); float* CIN = (float*)(F.ws + WS_CIN);
    for (int g = F.bid * NTHR + F.tid; g < 8 * 2 * 1024; g += F.G * NTHR) {
        const int b = g >> 11, d = (g >> 10) & 1, ch = g & 1023; float cst = 0.f;
        const float* sp = SUM + (((size_t)b * 2 + d) * 68) * 2 * 1024 + ch; float* cp = CIN + (((size_t)b * 2 + d) * 68) * 1024 + ch;
#pragma unroll 4
        for (int step = 0; step < 68; ++step) { const int j = d == 0 ? step : (step < 4 ? 3 - step : 71 - step);
            const float P = sp[(size_t)j * 2048], H = sp[(size_t)j * 2048 + 1024]; cp[(size_t)j * 1024] = cst; cst = P * cst + H; }
    }
}

__device__ __forceinline__ void p_ycombine(Frame& F) {
    bf16* hf = (bf16*)(F.ws + WS_RA); const bf16* hb = (const bf16*)(F.ws + WS_RF); const bf16* gt = (const bf16*)(F.ws + WS_RC);
    for (size_t o = ((size_t)F.bid * NTHR + F.tid) * 8; o < (size_t)NT * D; o += (size_t)F.G * NTHR * 8) {
        float a[8], b[8], g[8]; unpack8(*(const GAS v4u*)(hf + o), a); unpack8(*(const GAS v4u*)(hb + o), b); unpack8(*(const GAS v4u*)(gt + o), g);
#pragma unroll
        for (int j = 0; j < 8; ++j) a[j] = (a[j] + b[j]) * g[j];
        *(GAS v4u*)(hf + o) = pack8(a); }
}
__device__ __forceinline__ void p_norm2_route(Frame& F, int l) {
    LAS float* RW = (LAS float*)F.lds;
    LAS int* lcnt = (LAS int*)(F.lds + 65536);
    LAS int* rinfo = lcnt + 64;
    const int rpb = (NT + F.G - 1) / F.G, r0 = F.bid * rpb, r1 = (r0 + rpb < NT) ? r0 + rpb : NT;
    for (int o = F.tid; o < 1024 * 16; o += NTHR) RW[o] = F.kin[19][o];
    if (F.tid < 32) lcnt[F.tid] = 0;
    __syncthreads();
    const float* gn = F.kin[18] + (size_t)l * D; bf16* hx2 = (bf16*)(F.ws + WS_RA);
    float rb[16];
#pragma unroll
    for (int e = 0; e < 16; ++e) rb[e] = F.kin[20][e];
    for (int r = r0 + F.wave; r < r1; r += NWAVES) {
        const int mb = mb_of(r);
        const float* src = r < NL ? F.out + (size_t)r * D : (const float*)(F.ws + WS_HCTX) + (size_t)(r - NL) * D;
        f32x4 v[4]; float ss = 0.f;
#pragma unroll
        for (int j = 0; j < 4; ++j) { v[j] = *(const GAS f32x4*)(src + F.lane * 4 + 256 * j); ss += (v[j][0] * v[j][0] + v[j][1] * v[j][1]) + (v[j][2] * v[j][2] + v[j][3] * v[j][3]); }
        const float rstd = rsqrtf(wave_sum(ss, F.lane) * (1.f / D) + RMS_EPS);
        const float *sh = modp(F, l, mb, 3), *sc = modp(F, l, mb, 4);
        float lg[16];
#pragma unroll
        for (int e = 0; e < 16; ++e) lg[e] = 0.f;
#pragma unroll
        for (int j = 0; j < 4; ++j) { const int k = F.lane * 4 + 256 * j; const f32x4 g = *(const GAS f32x4*)(gn + k), s1 = *(const GAS f32x4*)(sc + k), s0 = *(const GAS f32x4*)(sh + k);
            float o[4];
#pragma unroll
            for (int q = 0; q < 4; ++q) { o[q] = v[j][q] * rstd * g[q] * (1.f + s1[q]) + s0[q];
                const LAS f32x4* rw = (const LAS f32x4*)(RW + (k + q) * 16);
#pragma unroll
                for (int e4 = 0; e4 < 4; ++e4) { const f32x4 w = rw[e4]; lg[4 * e4] += o[q] * w[0]; lg[4 * e4 + 1] += o[q] * w[1]; lg[4 * e4 + 2] += o[q] * w[2]; lg[4 * e4 + 3] += o[q] * w[3]; } }
            v2u w; w.x = pk2(o[0], o[1]); w.y = pk2(o[2], o[3]); *(GAS v2u*)(hx2 + (size_t)r * D + k) = w; }
        float aff[16], sel[16];
#pragma unroll
        for (int e = 0; e < 16; ++e) { lg[e] = wave_sum(lg[e], F.lane); aff[e] = sigmoidf_(lg[e]); sel[e] = aff[e] + rb[e]; }
        int grp = 0; float best = -1e30f;
#pragma unroll
        for (int g = 0; g < 4; ++g) { const float a = sel[4 * g], b = sel[4 * g + 1], c = sel[4 * g + 2], dd = sel[4 * g + 3];
            const float s = fmaxf(fmaxf(fmaxf(a + b, a + c), fmaxf(a + dd, b + c)), fmaxf(b + dd, c + dd));
            if (s > best) { best = s; grp = g; } }
        float s4[4], a4[4];
#pragma unroll
        for (int q = 0; q < 4; ++q) { s4[q] = grp == 0 ? sel[q] : grp == 1 ? sel[4 + q] : grp == 2 ? sel[8 + q] : sel[12 + q]; a4[q] = grp == 0 ? aff[q] : grp == 1 ? aff[4 + q] : grp == 2 ? aff[8 + q] : aff[12 + q]; }
        int i0 = 0; float m0 = s4[0], af0 = a4[0];
#pragma unroll
        for (int q = 1; q < 4; ++q) if (s4[q] > m0) { m0 = s4[q]; i0 = q; af0 = a4[q]; }
        int i1 = -1; float m1 = -1e30f, af1 = 0.f;
#pragma unroll
        for (int q = 0; q < 4; ++q) if (q != i0 && s4[q] > m1) { m1 = s4[q]; i1 = q; af1 = a4[q]; }
        const int e0 = grp * 4 + i0, e1 = grp * 4 + i1; const float inv = 1.f / (af0 + af1);
        if (F.lane == 0) { const int lr0 = __hip_atomic_fetch_add(lcnt + e0, 1, __ATOMIC_RELAXED, __HIP_MEMORY_SCOPE_WORKGROUP), lr1 = __hip_atomic_fetch_add(lcnt + e1, 1, __ATOMIC_RELAXED, __HIP_MEMORY_SCOPE_WORKGROUP);
            LAS int* ri = rinfo + (r - r0) * 5; ri[0] = e0 | (e1 << 8); ri[1] = lr0; ri[2] = lr1; ri[3] = __builtin_bit_cast(int, af0 * inv); ri[4] = __builtin_bit_cast(int, af1 * inv); }
    }
    __syncthreads();
    if (F.tid < 16) lcnt[16 + F.tid] = (int)__hip_atomic_fetch_add(F.ctl + CW_CNT + 64 * l + F.tid, (unsigned)lcnt[F.tid], __ATOMIC_RELAXED, __HIP_MEMORY_SCOPE_AGENT);
    __syncthreads();
    int2* list = (int2*)(F.ws + WS_LIST);
    for (int rl = F.tid; rl < r1 - r0; rl += NTHR) { const LAS int* ri = rinfo + rl * 5; const int e0 = ri[0] & 255, e1 = ri[0] >> 8, r = r0 + rl;
        list[(size_t)e0 * NT + lcnt[16 + e0] + ri[1]] = make_int2(r, ri[3]);
        list[(size_t)e1 * NT + lcnt[16 + e1] + ri[2]] = make_int2(r | (int)0x80000000, ri[4]); }
}
__device__ __forceinline__ void p_moe_wconv(Frame& F, int l) {
    __syncthreads();
    { const int gw = F.bid * NWAVES + F.wave, NGW = F.G * NWAVES; LAS float* scr = (LAS float*)(F.lds + F.wave * 16384);
      bf16* mw = (bf16*)(F.ws + WS_MOEW);
      for (int it = gw; it < 16 * 3 * 512; it += NGW) { const int e = it / 1536, rem = it % 1536, m = rem / 512, q = rem % 512, kb = q >> 5, nb = q & 31;
          const float* W = F.kin[m == 0 ? 21 : m == 1 ? 22 : 23] + ((size_t)l * 16 + e) * D * D; bf16* dst = mw + (size_t)e * 3 * D * D + (m == 2 ? (size_t)2 * D * D : 0);
          const int n0 = nb * 32; const int drow = m == 2 ? n0 : ((n0 >> 7) * 256 + (m == 1 ? 128 : 0) + (n0 & 127));
          transpose_item(W, D, D, dst, kb * 64, n0, drow, scr, F.lane); } }
}
__device__ __forceinline__ void moe_table(Frame& F, int l, LAS int* ts, LAS int* cn) {
    __syncthreads();
    if (F.tid == 0) { int acc = 0;
        for (int e = 0; e < 16; ++e) { const int c = (int)__hip_atomic_load(F.ctl + CW_CNT + 64 * l + e, __ATOMIC_RELAXED, __HIP_MEMORY_SCOPE_AGENT); cn[e] = c; ts[e] = acc; acc += (c + 255) >> 8; }
        ts[16] = acc; }
    __syncthreads();
}

constexpr int NPH = 24;
struct Args { const float* in[25]; float* out; unsigned char* ws; int ph_lo, ph_hi; };
__global__ void __launch_bounds__(NTHR, 2) fwd_kernel(Args args) {
    extern __shared__ __attribute__((aligned(16))) unsigned char lds[];
    Frame F;
    F.lds = (LAS unsigned char*)lds; F.tid = threadIdx.x; F.lane = F.tid & 63; F.wave = __builtin_amdgcn_readfirstlane(F.tid >> 6);
    F.G = gridDim.x; F.bid = blockIdx.x; F.ws = args.ws; F.out = args.out; F.ctl = (unsigned*)(args.ws + WS_CTL);
    F.kin = (const float* const __attribute__((address_space(4)))*)__builtin_amdgcn_kernarg_segment_ptr();
    volatile LAS unsigned* MISC = (volatile LAS unsigned*)(F.lds + MISC_OFF);
    if (F.tid < 32) MISC[F.tid] = 0u;
    __syncthreads();
    XcdBarrier bar; bar.bar = F.ctl + CW_BAR; bar.x = 0; bar.st = nullptr;
    if (MK_N_LAUNCHES == 1) bar = xcd_barrier_post(F.ctl + CW_BAR, MISC + 8);
    LAS int* ts = (LAS int*)(F.lds + MISC_OFF + 256); LAS int* cn = ts + 32;
    const int lo = args.ph_lo, hi = args.ph_hi;
#ifndef SITE_MASK
#define SITE_MASK 0xfffffu
#endif
#define SITE(j) (((SITE_MASK) >> (j)) & 1u)
#ifndef REP_MASK
#define REP_MASK 0u
#endif
#define IN(k) (lo <= (k) && (k) < hi)
#define LAUNDER() do { asm volatile("v_mbcnt_lo_u32_b32 %0, -1, 0\n\tv_mbcnt_hi_u32_b32 %0, -1, %0" : "=v"(F.lane)); asm volatile("" : "+s"(F.ws), "+s"(F.out), "+s"(F.kin), "+s"(F.ctl), "+s"(F.lds), "+s"(F.wave), "+s"(F.bid), "+s"(F.G), "+v"(F.lane)); F.tid = F.wave * 64 + F.lane; } while (0)
#define TWICE(j, stmt) do { stmt; if (((REP_MASK) >> (j)) & 1u) { __syncthreads(); LAUNDER(); stmt; } } while (0)
#define SEAM(k) do { if (MK_N_LAUNCHES == 1 && IN((k) + 1)) xcd_barrier(bar); } while (0)

    if (SITE(0) && IN(0)) { LAUNDER(); TWICE(0, p_prologue(F)); SEAM(0); }
    for (int l = 0; l < 2; ++l) {
        const int pb = 1 + 11 * l;
        if (SITE(1) && IN(pb + 0)) { LAUNDER(); p_norm1(F, l); SEAM(pb + 0); }
        if (SITE(2) && IN(pb + 1)) { LAUNDER();
            PInproj p; p.G = F.G; p.c = F.bid; p.l = l; p.hx = (const bf16*)(F.ws + WS_RA); p.wt = (const bf16*)(F.ws + WS_WIN) + (size_t)l * INW * D;
            p.urnn = (bf16*)(F.ws + WS_RB); p.gate = (bf16*)(F.ws + WS_RC); p.ufour = (bf16*)(F.ws + WS_RF); p.sgr = (bf16*)(F.ws + WS_RD); p.sgf = (bf16*)(F.ws + WS_RE);
            TWICE(2, fast_gemm_phase(F, p)); SEAM(pb + 1); }
        if (SITE(3) && IN(pb + 2)) { LAUNDER(); TWICE(3, p_scan_fast<1>(F, l); p_transpose(F)); SEAM(pb + 2); }
        if (SITE(4) && IN(pb + 3)) { LAUNDER(); TWICE(4, p_scan_carry(F)); SEAM(pb + 3); }
        if (SITE(5) && IN(pb + 4)) { LAUNDER();
            PDft p; p.G = F.G; p.c = F.bid; p.csl = (const bf16*)(F.ws + WS_CSL); p.csc = (const bf16*)(F.ws + WS_CSC); p.ut = (const bf16*)(F.ws + WS_RG); p.g = (bf16*)(F.ws + WS_RH);
            TWICE(5, fast_gemm_phase(F, p)); SEAM(pb + 4); }
        if (SITE(6) && IN(pb + 5)) { LAUNDER(); TWICE(6, p_scan_fast<2>(F, l)); SEAM(pb + 5); }
        if (SITE(7) && IN(pb + 6)) { LAUNDER();
            PMerge p; p.G = F.G; p.c = F.bid; p.gm = (const bf16*)(F.ws + WS_RH); p.y = (const bf16*)(F.ws + WS_RA); p.wf = (const bf16*)(F.ws + WS_WF) + (size_t)l * D * D; p.wr = (const bf16*)(F.ws + WS_WR) + (size_t)l * D * D;
            p.sgr = (const bf16*)(F.ws + WS_RD); p.sgf = (const bf16*)(F.ws + WS_RE); p.t1 = (bf16*)(F.ws + WS_RB); p.mg = (bf16*)(F.ws + WS_RC);
            TWICE(7, fast_gemm_phase(F, p)); SEAM(pb + 6); }
        if (SITE(8) && IN(pb + 7)) { LAUNDER();
            PWout p; p.G = F.G; p.c = F.bid; p.mg = (const bf16*)(F.ws + WS_RC); p.wo = (const bf16*)(F.ws + WS_WO) + (size_t)l * D * D;
            p.xold_l = l == 0 ? F.kin[0] : F.out; p.xold_c = l == 0 ? F.kin[2] : (const float*)(F.ws + WS_HCTX); p.xnew_l = F.out; p.xnew_c = (float*)(F.ws + WS_HCTX); p.g1 = modp(F, l, 0, 2);
            TWICE(8, fast_gemm_phase(F, p)); SEAM(pb + 7); }
        if (SITE(9) && IN(pb + 8)) { LAUNDER(); p_norm2_route(F, l); TWICE(9, p_moe_wconv(F, l)); SEAM(pb + 8); }
        if (SITE(10) && IN(pb + 9)) { LAUNDER();
            moe_table(F, l, ts, cn);
            PMoe1 p; p.G = F.G; p.c = F.bid; p.hx2 = (const bf16*)(F.ws + WS_RA); p.w = (const bf16*)(F.ws + WS_MOEW); p.list = (const int2*)(F.ws + WS_LIST); p.he = (bf16*)(F.ws + WS_HE); p.ts = ts; p.cn = cn;
            TWICE(10, fast_gemm_phase(F, p)); SEAM(pb + 9); }
        if (SITE(11) && IN(pb + 10)) { LAUNDER();
            moe_table(F, l, ts, cn);
            PMoe2 p; p.G = F.G; p.c = F.bid; p.he = (const bf16*)(F.ws + WS_HE); p.w = (const bf16*)(F.ws + WS_MOEW); p.list = (const int2*)(F.ws + WS_LIST); p.c01 = (bf16*)(F.ws + WS_C01); p.ts = ts; p.cn = cn;
            TWICE(11, fast_gemm_phase(F, p)); SEAM(pb + 10); }
    }
    if (SITE(12) && IN(23)) { LAUNDER(); p_final(F); }
#undef IN
#undef SEAM
}

extern "C" void kernel_launch(void* const* d_in, const int* in_sizes, int n_in, void* d_out, int out_size, void* d_ws, size_t ws_size, hipStream_t stream) {
    static int grid = 0;
    if (grid == 0) {
        if (n_in != 25 || out_size != NL * D || ws_size < WS_END2) { fprintf(stderr, "kernel_launch: unexpected shapes (n_in %d, out %d, ws %zu)\n", n_in, out_size, ws_size); grid = -1; return; }
        int dev = 0, cus = 0, per_cu = 0;
        if (hipGetDevice(&dev) != hipSuccess || hipDeviceGetAttribute(&cus, hipDeviceAttributeMultiprocessorCount, dev) != hipSuccess) { grid = -1; return; }
        if (hipFuncSetAttribute((const void*)fwd_kernel, hipFuncAttributeMaxDynamicSharedMemorySize, LDS_BYTES) != hipSuccess) { fprintf(stderr, "kernel_launch: hipFuncSetAttribute failed\n"); grid = -1; return; }
        if (hipOccupancyMaxActiveBlocksPerMultiprocessor(&per_cu, (const void*)fwd_kernel, NTHR, LDS_BYTES) != hipSuccess || per_cu < 1) { fprintf(stderr, "kernel_launch: occupancy query says %d\n", per_cu); }
        (void)hipGetLastError();
        grid = cus;
    }
    if (grid < 0) return;
    (void)hipMemsetAsync((char*)d_ws + WS_CTL, 0, CTL_ZERO_BYTES, stream);
    Args a{};
    for (int i = 0; i < 25; ++i) a.in[i] = (const float*)d_in[i];
    a.out = (float*)d_out; a.ws = (unsigned char*)d_ws;
    if (MK_N_LAUNCHES == 1) { a.ph_lo = 0; a.ph_hi = NPH; hipLaunchKernelGGL(fwd_kernel, dim3(grid), dim3(NTHR), LDS_BYTES, stream, a); }
    else for (int p = 0; p < NPH; ++p) { a.ph_lo = p; a.ph_hi = p + 1; hipLaunchKernelGGL(fwd_kernel, dim3(grid), dim3(NTHR), LDS_BYTES, stream, a); }
}
```

```cpp
#include <hip/hip_runtime.h>
#include <cstdio>
#include <cstdint>

#ifndef MK_N_LAUNCHES
#define MK_N_LAUNCHES 1
#endif

#define GAS __attribute__((address_space(1)))
#define LAS __attribute__((address_space(3)))
typedef unsigned short bf16;
typedef unsigned v4u __attribute__((ext_vector_type(4)));
typedef unsigned v2u __attribute__((ext_vector_type(2)));
typedef float f32x4 __attribute__((ext_vector_type(4)));
typedef short bf16x8 __attribute__((ext_vector_type(8)));

constexpr int D = 1024, NB = 8, SEQ = 4096, CTX = 256, NL = NB * SEQ, NC = NB * CTX, NT = NL + NC;
constexpr int NPAN = NT / 256;
constexpr int INW = 4608, NE = 16, NMOD = 6;
constexpr float RMS_EPS = 1e-6f;
constexpr int NWAVES = 8, NTHR = 512;

constexpr size_t MiB = 1u << 20;
constexpr size_t WS_CTL = 0, CTL_ZERO_BYTES = 1 * MiB;
constexpr size_t WS_MODS = 1 * MiB;
constexpr size_t WS_WIN = 2 * MiB;
constexpr size_t WS_WR = 20 * MiB, WS_WF = 24 * MiB, WS_WO = 28 * MiB;
constexpr size_t WS_LRU = 32 * MiB;
constexpr size_t WS_CSC = 34 * MiB;
constexpr size_t WS_HCTX = 35 * MiB;
constexpr size_t WS_LIST = 43 * MiB;
constexpr size_t WS_CSL = 48 * MiB;
constexpr size_t WS_RA = 112 * MiB;
constexpr size_t WS_RB = 180 * MiB;
constexpr size_t WS_RC = 248 * MiB;
constexpr size_t WS_RD = 316 * MiB;
constexpr size_t WS_RE = 384 * MiB;
constexpr size_t WS_RF = 452 * MiB;
constexpr size_t WS_RG = 486 * MiB;
constexpr size_t WS_RH = 520 * MiB;
constexpr size_t WS_END = 588 * MiB;
constexpr size_t WS_MOEW = 180 * MiB;
constexpr size_t WS_HE = 276 * MiB;
constexpr size_t WS_C01 = 420 * MiB;
constexpr size_t WS_SUM = 588 * MiB;
constexpr size_t WS_CIN = 597 * MiB;
constexpr size_t WS_END2 = 602 * MiB;
static_assert(WS_C01 + (size_t)2 * NT * D * 2 <= WS_END, "map");
static_assert(WS_RA + (size_t)NT * D * 2 <= WS_RB && WS_RH + (size_t)NT * D * 2 <= WS_END, "map");

constexpr int CW_TMO = 0;
constexpr int CW_CNT = 64;
constexpr int CW_BAR = 4096;

constexpr int LDS_BYTES = 147456;
constexpr int MISC_OFF = 131072 + 8192;

__device__ __forceinline__ unsigned f2bf(float f) { unsigned u = __builtin_bit_cast(unsigned, f); return (u + 0x7fffu + ((u >> 16) & 1u)) >> 16; }
__device__ __forceinline__ unsigned pk2(float lo, float hi) { return f2bf(lo) | (f2bf(hi) << 16); }
__device__ __forceinline__ float bflo(unsigned w) { return __builtin_bit_cast(float, w << 16); }
__device__ __forceinline__ float bfhi(unsigned w) { return __builtin_bit_cast(float, w & 0xffff0000u); }
__device__ __forceinline__ float bf2f(bf16 h) { return __builtin_bit_cast(float, ((unsigned)h) << 16); }
__device__ __forceinline__ v4u pack8(const float* v) { v4u o; o.x = pk2(v[0], v[1]); o.y = pk2(v[2], v[3]); o.z = pk2(v[4], v[5]); o.w = pk2(v[6], v[7]); return o; }
__device__ __forceinline__ void unpack8(v4u w, float* v) { v[0] = bflo(w.x); v[1] = bfhi(w.x); v[2] = bflo(w.y); v[3] = bfhi(w.y); v[4] = bflo(w.z); v[5] = bfhi(w.z); v[6] = bflo(w.w); v[7] = bfhi(w.w); }
__device__ __forceinline__ float sigmoidf_(float x) { return __builtin_amdgcn_rcpf(1.f + __expf(-x)); }
__device__ __forceinline__ float siluf_(float x) { return x * __builtin_amdgcn_rcpf(1.f + __expf(-x)); }
__device__ __forceinline__ float gelu_tanh(float x) { const float u = 0.7978845608028654f * (x + 0.044715f * x * x * x); const float e = __expf(2.f * u); const float t = 1.f - 2.f * __builtin_amdgcn_rcpf(e + 1.f); return 0.5f * x * (1.f + t); }
__device__ __forceinline__ float wave_sum(float v, int lane) {
#pragma unroll
    for (int o = 1; o < 64; o <<= 1) v += __builtin_bit_cast(float, __builtin_amdgcn_ds_bpermute((lane ^ o) << 2, __builtin_bit_cast(int, v)));
    return v;
}
#define LDS_WAIT() asm volatile("s_waitcnt lgkmcnt(0)" ::: "memory")
#define VM_WAIT() asm volatile("s_waitcnt vmcnt(0)" ::: "memory")

#define XB_TMO      128
#define XB_XCNT(j)  (256  + 64 * (j))
#define XB_XSUB(j)  (1280 + 64 * (j))
#define XB_XGEN(j)  (2304 + 64 * (j))
#define XB_TOP      3328
#define XB_TOPGEN   3392
#define XCD_BAR_WORDS 3456
#define XB_SPIN_CAP (1u << 18)
__device__ __forceinline__ unsigned xb_ld(unsigned* p)              { return __hip_atomic_load(p, __ATOMIC_RELAXED, __HIP_MEMORY_SCOPE_AGENT); }
__device__ __forceinline__ unsigned xb_add(unsigned* p, unsigned v) { return __hip_atomic_fetch_add(p, v, __ATOMIC_RELAXED, __HIP_MEMORY_SCOPE_AGENT); }
__device__ __forceinline__ unsigned xb_xcc_id() { return (unsigned)__builtin_amdgcn_s_getreg((3 << 11) | 20) & 0xFu; }
#define XB_SPIN(cond, bar) do { unsigned _sp = 0; while (cond) { __builtin_amdgcn_s_sleep(1); \
    if ((++_sp & 255u) == 0u) { if (xb_ld(&(bar)[XB_TMO])) break; if (_sp > XB_SPIN_CAP) { atomicAdd(&(bar)[XB_TMO], 1u); break; } } } } while (0)
struct XcdBarrier { unsigned* bar; unsigned x; volatile LAS unsigned* st; };
__device__ __forceinline__ XcdBarrier xcd_barrier_post(unsigned* bar, volatile LAS unsigned* st) {
    XcdBarrier b; b.bar = bar; b.x = xb_xcc_id(); b.st = st;
    if (threadIdx.x == 0) (void)xb_add(&bar[XB_XCNT(b.x)], 1u);
    return b;
}
__device__ __forceinline__ void xcd_barrier_complete(unsigned* bar, unsigned x, unsigned& nloc, unsigned& nx) {
    const unsigned G = gridDim.x * gridDim.y * gridDim.z;
    unsigned sum, cnt, mine, sp = 0u;
    for (;;) {
        sum = 0u; cnt = 0u; mine = 0u;
#pragma unroll
        for (unsigned j = 0; j < 16; ++j) { const unsigned c = xb_ld(&bar[XB_XCNT(j)]); sum += c; cnt += (c > 0u) ? 1u : 0u; mine = (j == x) ? c : mine; }
        if (sum == G) break;
        __builtin_amdgcn_s_sleep(1);
        if ((++sp & 255u) == 0u) { if (xb_ld(&bar[XB_TMO])) break; if (sp > XB_SPIN_CAP) { atomicAdd(&bar[XB_TMO], 1u); break; } }
    }
    nloc = mine > 0u ? mine : 1u; nx = cnt > 0u ? cnt : 1u;
}
__device__ __forceinline__ void xcd_barrier(const XcdBarrier& b) {
    asm volatile("s_waitcnt vmcnt(0)" ::: "memory");
    __syncthreads();
    if (threadIdx.x == 0) {
        unsigned* bar = b.bar;
        __builtin_amdgcn_s_waitcnt(0);
        unsigned nloc = b.st[0], nx = b.st[1];
        if (nloc == 0u) { xcd_barrier_complete(bar, b.x, nloc, nx); b.st[0] = nloc; b.st[1] = nx; }
        const unsigned old = xb_add(&bar[XB_XSUB(b.x)], 1u);
        const unsigned gen = old / nloc;
        if (old + 1u == (gen + 1u) * nloc) {
            __builtin_amdgcn_fence(__ATOMIC_RELEASE, "agent");
            asm volatile("s_waitcnt vmcnt(0)" ::: "memory");
            const unsigned og = xb_add(&bar[XB_TOP], 1u);
            const unsigned tg = og / nx;
            if (og + 1u == (tg + 1u) * nx) xb_add(&bar[XB_TOPGEN], 1u);
            else XB_SPIN(xb_ld(&bar[XB_TOPGEN]) == tg, bar);
            __builtin_amdgcn_fence(__ATOMIC_ACQUIRE, "agent");
            xb_add(&bar[XB_XGEN(b.x)], 1u);
            asm volatile("s_waitcnt vmcnt(0)" ::: "memory");
        } else {
            XB_SPIN(xb_ld(&bar[XB_XGEN(b.x)]) == gen, bar);
            __builtin_amdgcn_fence(__ATOMIC_ACQUIRE, "agent");
            asm volatile("s_waitcnt vmcnt(0)" ::: "memory");
        }
    }
    __syncthreads();
}

struct Frame {
    LAS unsigned char* lds;
    int tid, lane, wave, G, bid;
    unsigned* ctl;
    const float* const __attribute__((address_space(4)))* kin;
    float* out;
    unsigned char* ws;
};
__device__ __forceinline__ const float* modp(const Frame& F, int l, int mb, int which) { return (const float*)(F.ws + WS_MODS) + ((size_t)(l * 9 + mb) * NMOD + which) * D; }
__device__ __forceinline__ int mb_of(int r) { return r < NL ? (r >> 12) : 8; }

struct Unit { const bf16* A; const bf16* B; int lda, ldb, K; int pm, pn, x0, x1, x2; };

constexpr int HTB = 128 * 64 * 2;
__device__ __forceinline__ int lds_byte(int r, int c) { const int st = (r >> 4) * 2 + (c >> 5), rr = r & 15, cc = c & 31, ob = rr * 64 + cc * 2; return st * 1024 + (ob ^ (((ob >> 9) & 1) << 5)); }
__device__ __forceinline__ void stage_rc(int b, int& R, int& C) { const int st = b / 1024, sb = b % 1024, swz = sb ^ (((sb >> 9) & 1) << 5); R = (st >> 1) * 16 + swz / 64; C = (st & 1) * 32 + (swz % 64) / 2; }
__device__ __forceinline__ int perm32(int rho) { const int n = rho >> 4, i = rho & 15; return 8 * (i >> 2) + 4 * n + (i & 3); }
template <class P> __device__ __forceinline__ void fast_gemm_phase(Frame& F, const P& p) {
    LAS unsigned char* lds = F.lds;
    const int tid = F.tid, wid = F.wave, lane = F.lane, wr = wid >> 2, wc = wid & 3, fr = lane & 15, fq = lane >> 4;
    int R0, C0, R1, C1; stage_rc(tid * 16, R0, C0); stage_rc(tid * 16 + 8192, R1, C1);
    const int Rb0 = (R0 & ~31) + perm32(R0 & 31), Rb1 = (R1 & ~31) + perm32(R1 & 31);
    const unsigned ldsw = (unsigned)wid * 1024u;
    const int aoffL = lds_byte(wr * 64 + fr, fq * 8), boffL = lds_byte(wc * 32 + fr, fq * 8);
    Unit cur, nxt; int ui = 0;
    if (!p.next(0, cur)) return;
    const char* sA; const char* sB; unsigned sa00, sa01, sa10, sa11, sb0, sb1; size_t shB;
#define FG_SET(u) do { sA = (const char*)(u).A; sB = (const char*)(u).B; shB = (size_t)128 * (u).ldb * 2; \
        sa00 = p.a_off((u), R0) + C0 * 2; sa01 = p.a_off((u), R1) + C1 * 2; sa10 = p.a_off((u), 128 + R0) + C0 * 2; sa11 = p.a_off((u), 128 + R1) + C1 * 2; \
        sb0 = (unsigned)(Rb0 * (u).ldb + C0) * 2u; sb1 = (unsigned)(Rb1 * (u).ldb + C1) * 2u; } while (0)
#define FG_SA(b, h) (((b) * 2 + (h)) * HTB)
#define FG_SB(b, h) ((4 + (b) * 2 + (h)) * HTB)
#define FG_GLDS(src, bufoff, i) __builtin_amdgcn_global_load_lds((const unsigned*)(src), (LAS unsigned*)(lds + (bufoff) + ldsw + (i) * 8192), 16, 0, 0)
#define FG_STAGE_A0(bufoff, kt) do { const char* _pa = sA + (size_t)(kt) * 128; FG_GLDS(_pa + sa00, bufoff, 0); FG_GLDS(_pa + sa01, bufoff, 1); } while (0)
#define FG_STAGE_A1(bufoff, kt) do { const char* _pa = sA + (size_t)(kt) * 128; FG_GLDS(_pa + sa10, bufoff, 0); FG_GLDS(_pa + sa11, bufoff, 1); } while (0)
#define FG_STAGE_B(bufoff, h, kt) do { const char* _pb = sB + ((size_t)(h) * shB + (size_t)(kt) * 128); FG_GLDS(_pb + sb0, bufoff, 0); FG_GLDS(_pb + sb1, bufoff, 1); } while (0)
#define FG_LDA(dst, b, h) do { _Pragma("unroll") for (int m = 0; m < 4; ++m) _Pragma("unroll") for (int k = 0; k < 2; ++k) dst[m][k] = *(const LAS bf16x8*)(lds + FG_SA(b, h) + aoffL + m * 2048 + k * 1024); } while (0)
#define FG_LDB(dst, b, h) do { _Pragma("unroll") for (int n = 0; n < 2; ++n) _Pragma("unroll") for (int k = 0; k < 2; ++k) dst[n][k] = *(const LAS bf16x8*)(lds + FG_SB(b, h) + boffL + n * 2048 + k * 1024); } while (0)
#define FG_MMA(ai, bj, At, Bt) do { __builtin_amdgcn_s_setprio(1); _Pragma("unroll") for (int m = 0; m < 4; ++m) _Pragma("unroll") for (int n = 0; n < 2; ++n) _Pragma("unroll") for (int k = 0; k < 2; ++k) \
        acc[ai][bj][m][n] = __builtin_amdgcn_mfma_f32_16x16x32_bf16(Bt[n][k], At[m][k], acc[ai][bj][m][n], 0, 0, 0); __builtin_amdgcn_s_setprio(0); } while (0)
#define FG_WAIT_V(n) asm volatile("s_waitcnt vmcnt(" #n ")" ::: "memory")
#define FG_WAIT_L(n) asm volatile("s_waitcnt lgkmcnt(" #n ")" ::: "memory")
#define FG_BAR __builtin_amdgcn_s_barrier()
#define FG_SCHED __builtin_amdgcn_sched_barrier(0)
    f32x4 acc[2][2][4][2];
#pragma unroll
    for (int a = 0; a < 2; ++a)
#pragma unroll
        for (int b = 0; b < 2; ++b)
#pragma unroll
            for (int m = 0; m < 4; ++m)
#pragma unroll
                for (int n = 0; n < 2; ++n) acc[a][b][m][n] = (f32x4){0.f, 0.f, 0.f, 0.f};
    bf16x8 At[4][2], B0[2][2], B1[2][2];
    FG_SET(cur);
    FG_STAGE_B(FG_SB(0, 0), 0, 0); FG_STAGE_B(FG_SB(0, 1), 1, 0); FG_STAGE_A0(FG_SA(0, 0), 0); FG_STAGE_A1(FG_SA(0, 1), 0);
    if (wr == 1) FG_BAR;
    FG_WAIT_V(2); FG_BAR;
    FG_STAGE_B(FG_SB(1, 0), 0, 1); FG_STAGE_A0(FG_SA(1, 0), 1); FG_STAGE_B(FG_SB(1, 1), 1, 1);
    FG_WAIT_V(6); FG_BAR;
    for (;;) {
        const bool has_next = p.next(ui + 1, nxt);
        const int nt = cur.K >> 6;
        for (int t = 0; t < nt; t += 2) {
            const bool last = (t == nt - 2);
            const int k2 = last ? 0 : t + 2, k3 = k2 + 1;
            FG_LDB(B0, 0, 0); FG_LDB(B1, 0, 1); FG_SCHED; FG_LDA(At, 0, 0); FG_STAGE_A1(FG_SA(1, 1), t + 1);
            if (last && has_next) FG_SET(nxt);
            FG_WAIT_V(8); FG_WAIT_L(0); FG_BAR; FG_MMA(0, 0, At, B0); FG_MMA(0, 1, At, B1); FG_BAR; FG_SCHED;
            FG_LDA(At, 0, 1); FG_STAGE_B(FG_SB(0, 0), 0, k2); FG_STAGE_B(FG_SB(0, 1), 1, k2); FG_STAGE_A0(FG_SA(0, 0), k2);
            FG_WAIT_V(8); FG_WAIT_L(0); FG_BAR; FG_MMA(1, 0, At, B0); FG_MMA(1, 1, At, B1); FG_BAR; FG_SCHED;
            FG_LDB(B0, 1, 0); FG_LDB(B1, 1, 1); FG_SCHED; FG_LDA(At, 1, 0); FG_STAGE_A1(FG_SA(0, 1), k2);
            FG_WAIT_V(8); FG_WAIT_L(0); FG_BAR; FG_MMA(0, 0, At, B0); FG_MMA(0, 1, At, B1); FG_BAR; FG_SCHED;
            FG_LDA(At, 1, 1); FG_STAGE_B(FG_SB(1, 0), 0, k3); FG_STAGE_B(FG_SB(1, 1), 1, k3); FG_STAGE_A0(FG_SA(1, 0), k3);
            FG_WAIT_V(8); FG_WAIT_L(0); FG_BAR; FG_MMA(1, 0, At, B0); FG_MMA(1, 1, At, B1); FG_BAR; FG_SCHED;
        }
        if (wr == 0) FG_BAR;
        { const typename P::UPre up = p.upre(cur, wc * 32 + fq * 8);
#pragma unroll
          for (int ai = 0; ai < 2; ++ai) {
            typename P::Pre pre[4];
#pragma unroll
            for (int m = 0; m < 4; ++m) pre[m] = p.pre(cur, ai * 128 + wr * 64 + m * 16 + fr, wc * 32 + fq * 8);
#pragma unroll
            for (int m = 0; m < 4; ++m) {
                const float v0[8] = {acc[ai][0][m][0][0], acc[ai][0][m][0][1], acc[ai][0][m][0][2], acc[ai][0][m][0][3], acc[ai][0][m][1][0], acc[ai][0][m][1][1], acc[ai][0][m][1][2], acc[ai][0][m][1][3]};
                const float v1[8] = {acc[ai][1][m][0][0], acc[ai][1][m][0][1], acc[ai][1][m][0][2], acc[ai][1][m][0][3], acc[ai][1][m][1][0], acc[ai][1][m][1][1], acc[ai][1][m][1][2], acc[ai][1][m][1][3]};
                p.epi(cur, ai * 128 + wr * 64 + m * 16 + fr, wc * 32 + fq * 8, v0, v1, pre[m], up);
            } } }
        if (!has_next) break;
#pragma unroll
        for (int a = 0; a < 2; ++a)
#pragma unroll
            for (int b = 0; b < 2; ++b)
#pragma unroll
                for (int m = 0; m < 4; ++m)
#pragma unroll
                    for (int n = 0; n < 2; ++n) acc[a][b][m][n] = (f32x4){0.f, 0.f, 0.f, 0.f};
        cur = nxt; ++ui;
        if (wr == 1) FG_BAR;
    }
    FG_WAIT_V(0);
    FG_BAR;
#undef FG_SET
#undef FG_SA
#undef FG_SB
#undef FG_GLDS
#undef FG_STAGE_A0
#undef FG_STAGE_A1
#undef FG_STAGE_B
#undef FG_LDA
#undef FG_LDB
#undef FG_MMA
#undef FG_WAIT_V
#undef FG_WAIT_L
#undef FG_BAR
#undef FG_SCHED
}

__device__ __forceinline__ void order2d(int L, int nM, int nN, int& pm, int& pn) {
    const int nwg = nM * nN; int wgid = L; { const int q = nwg >> 3, r = nwg & 7, xcd = wgid & 7, off = wgid >> 3; wgid = (xcd < r ? xcd * (q + 1) : r * (q + 1) + (xcd - r) * q) + off; }
    const int nig = 8 * nN, gid = wgid / nig, fm = gid * 8, gsz = (nM - fm) < 8 ? (nM - fm) : 8;
    pm = fm + ((wgid % nig) % gsz); pn = (wgid % nig) / gsz;
}
struct NoPre {};
struct PInproj {
    int G, c, l; const bf16* hx; const bf16* wt; bf16 *urnn, *gate, *ufour, *sgr, *sgf;
    __device__ __forceinline__ bool next(int i, Unit& u) const {
        const int idx = i * G + c; if (idx >= NPAN * 18) return false;
        order2d(idx, NPAN, 18, u.pm, u.pn); u.A = hx + (size_t)u.pm * 256 * D; u.lda = D; u.B = wt + (size_t)u.pn * 256 * D; u.ldb = D; u.K = D; return true; }
    __device__ __forceinline__ unsigned a_off(const Unit& u, int row) const { return (unsigned)row * (D * 2); }
    typedef NoPre Pre; typedef NoPre UPre;
    __device__ __forceinline__ NoPre pre(const Unit&, int, int) const { return NoPre{}; }
    __device__ __forceinline__ NoPre upre(const Unit&, int) const { return NoPre{}; }
    __device__ __forceinline__ void epi(const Unit& u, int row, int c8, const float* v0, const float* v1, const NoPre&, const NoPre&) const {
        const size_t r = (size_t)u.pm * 256 + row; const int col = u.pn * 256 + c8;
        float a[8], b[8];
        if (col < 1024) { *(GAS v4u*)(urnn + r * D + col) = pack8(v0); *(GAS v4u*)(urnn + r * D + col + 128) = pack8(v1); }
        else if (col < 2048) {
#pragma unroll
            for (int j = 0; j < 8; ++j) { a[j] = gelu_tanh(v0[j]); b[j] = gelu_tanh(v1[j]); }
            *(GAS v4u*)(gate + r * D + col - 1024) = pack8(a); *(GAS v4u*)(gate + r * D + col - 1024 + 128) = pack8(b); }
        else if (col < 2560) { *(GAS v4u*)(ufour + r * 512 + col - 2048) = pack8(v0); *(GAS v4u*)(ufour + r * 512 + col - 2048 + 128) = pack8(v1); }
        else {
#pragma unroll
            for (int j = 0; j < 8; ++j) { a[j] = sigmoidf_(v0[j]); b[j] = sigmoidf_(v1[j]); }
            bf16* dst = col < 3584 ? sgr + r * D + (col - 2560) : sgf + r * D + (col - 3584);
            *(GAS v4u*)dst = pack8(a); *(GAS v4u*)(dst + 128) = pack8(b); }
    }
};
struct PDft {
    int G, c, nun; const bf16 *csl, *csc, *ut; bf16* g;
    __device__ __forceinline__ bool next(int i, Unit& u) const {
        const int idx = i * G + c; if (idx >= nun) return false;
        if (idx < 512) { const int x = idx & 7, k = (idx >> 3) & 31, rnd = idx >> 8, bp = 8 * rnd + (k >> 2), b = bp >> 1;
            u.pm = 4 * x + (k & 3); u.pn = bp & 1; u.x0 = b; u.x1 = 0;
            u.A = csl + (size_t)u.pm * 256 * 4096; u.lda = 4096; u.B = ut + ((size_t)b * 512 + u.pn * 256) * 4096; u.ldb = 4096; u.K = 4096; }
        else { const int j = idx - 512, b = j >> 2, rem = j & 3; u.pm = rem >> 1; u.pn = rem & 1; u.x0 = b; u.x1 = 1;
            u.A = csc + (size_t)u.pm * 256 * 256; u.lda = 256; u.B = ut + (size_t)8 * 512 * 4096 + ((size_t)b * 512 + u.pn * 256) * 256; u.ldb = 256; u.K = 256; }
        return true; }
    __device__ __forceinline__ unsigned a_off(const Unit& u, int row) const { return (unsigned)(row * u.lda) * 2u; }
    typedef NoPre Pre; typedef NoPre UPre;
    __device__ __forceinline__ NoPre pre(const Unit&, int, int) const { return NoPre{}; }
    __device__ __forceinline__ NoPre upre(const Unit&, int) const { return NoPre{}; }
    __device__ __forceinline__ void epi(const Unit& u, int row, int c8, const float* v0, const float* v1, const NoPre&, const NoPre&) const {
        size_t r; int col;
        if (u.x1 == 0) { r = (size_t)u.x0 * 4096 + (u.pm & 15) * 256 + row; col = (u.pm >> 4) * 512 + u.pn * 256 + c8; }
        else { r = (size_t)NL + u.x0 * 256 + row; col = u.pm * 512 + u.pn * 256 + c8; }
        *(GAS v4u*)(g + r * D + col) = pack8(v0); *(GAS v4u*)(g + r * D + col + 128) = pack8(v1);
    }
};
struct PMerge {
    int G, c, npan; const bf16 *gm, *y, *wf, *wr, *sgr, *sgf; bf16 *t1, *mg;
    __device__ __forceinline__ bool next(int i, Unit& u) const {
        const int tile = (i >> 1) * G + c; if (tile >= npan * 4) return false;
        order2d(tile, npan, 4, u.pm, u.pn); u.x0 = i & 1; u.lda = D; u.ldb = D; u.K = D;
        u.A = (u.x0 ? y : gm) + (size_t)u.pm * 256 * D; u.B = (u.x0 ? wr : wf) + (size_t)u.pn * 256 * D; return true; }
    __device__ __forceinline__ unsigned a_off(const Unit& u, int row) const { return (unsigned)row * (D * 2); }
    struct Pre { v4u a0, a1, b0, b1; }; typedef NoPre UPre;
    __device__ __forceinline__ NoPre upre(const Unit&, int) const { return NoPre{}; }
    __device__ __forceinline__ Pre pre(const Unit& u, int row, int c8) const {
        const size_t o = ((size_t)u.pm * 256 + row) * D + u.pn * 256 + c8; Pre r; const bf16* s = u.x0 ? sgr : sgf;
        r.a0 = *(const GAS v4u*)(s + o); r.a1 = *(const GAS v4u*)(s + o + 128); r.b0 = r.a0; r.b1 = r.a1;
        if (u.x0) { r.b0 = *(const GAS v4u*)(t1 + o); r.b1 = *(const GAS v4u*)(t1 + o + 128); }
        return r; }
    __device__ __forceinline__ void epi(const Unit& u, int row, int c8, const float* v0, const float* v1, const Pre& pr, const NoPre&) const {
        const size_t o = ((size_t)u.pm * 256 + row) * D + u.pn * 256 + c8;
#pragma unroll
        for (int h = 0; h < 2; ++h) { const float* v = h ? v1 : v0; const size_t oo = o + h * 128; float s[8], r[8], t[8];
            unpack8(h ? pr.a1 : pr.a0, s); unpack8(h ? pr.b1 : pr.b0, t);
            if (u.x0 == 0) {
#pragma unroll
                for (int j = 0; j < 8; ++j) r[j] = s[j] * v[j];
                *(GAS v4u*)(t1 + oo) = pack8(r); }
            else {
#pragma unroll
                for (int j = 0; j < 8; ++j) r[j] = s[j] * v[j] + t[j];
                *(GAS v4u*)(mg + oo) = pack8(r); } }
    }
};
struct PWout {
    int G, c, npan; const bf16 *mg, *wo; const float *xold_l, *xold_c; float *xnew_l, *xnew_c; const float* g1;
    __device__ __forceinline__ bool next(int i, Unit& u) const {
        const int idx = i * G + c; if (idx >= npan * 4) return false;
        order2d(idx, npan, 4, u.pm, u.pn); u.lda = D; u.ldb = D; u.K = D; u.A = mg + (size_t)u.pm * 256 * D; u.B = wo + (size_t)u.pn * 256 * D; return true; }
    __device__ __forceinline__ unsigned a_off(const Unit& u, int row) const { return (unsigned)row * (D * 2); }
    struct Pre { f32x4 x[4]; }; struct UPre { f32x4 g[4]; };
    __device__ __forceinline__ UPre upre(const Unit& u, int c8) const { const float* gg = g1 + (size_t)mb_of(u.pm * 256) * NMOD * D + u.pn * 256 + c8; UPre r;
        r.g[0] = *(const GAS f32x4*)gg; r.g[1] = *(const GAS f32x4*)(gg + 4); r.g[2] = *(const GAS f32x4*)(gg + 128); r.g[3] = *(const GAS f32x4*)(gg + 132); return r; }
    __device__ __forceinline__ Pre pre(const Unit& u, int row, int c8) const { const int r = u.pm * 256 + row;
        const float* xo = (r < NL ? xold_l + (size_t)r * D : xold_c + (size_t)(r - NL) * D) + u.pn * 256 + c8; Pre p;
        p.x[0] = *(const GAS f32x4*)xo; p.x[1] = *(const GAS f32x4*)(xo + 4); p.x[2] = *(const GAS f32x4*)(xo + 128); p.x[3] = *(const GAS f32x4*)(xo + 132); return p; }
    __device__ __forceinline__ void epi(const Unit& u, int row, int c8, const float* v0, const float* v1, const Pre& pr, const UPre& up) const {
        const int r = u.pm * 256 + row;
        float* xn = (r < NL ? xnew_l + (size_t)r * D : xnew_c + (size_t)(r - NL) * D) + u.pn * 256 + c8;
#pragma unroll
        for (int q = 0; q < 4; ++q) { const float* v = (q < 2 ? v0 : v1) + 4 * (q & 1); f32x4 o;
            o[0] = pr.x[q][0] + up.g[q][0] * v[0]; o[1] = pr.x[q][1] + up.g[q][1] * v[1]; o[2] = pr.x[q][2] + up.g[q][2] * v[2]; o[3] = pr.x[q][3] + up.g[q][3] * v[3];
            *(GAS f32x4*)(xn + (q >> 1) * 128 + (q & 1) * 4) = o; }
    }
};
struct PMoe1 {
    int G, c; const bf16* hx2; const bf16* w; const int2* list; bf16* he; const LAS int* ts; const LAS int* cn;
    __device__ __forceinline__ bool next(int i, Unit& u) const {
        const int ntl = __builtin_amdgcn_readfirstlane(ts[16]); const int idx = i * G + c; if (idx >= ntl * 8) return false;
        int tile; order2d(idx, ntl, 8, tile, u.pn); u.pm = tile; int e = 0;
#pragma unroll
        for (int j = 1; j < 16; ++j) e += (tile >= ts[j]) ? 1 : 0;
        e = __builtin_amdgcn_readfirstlane(e);
        u.x0 = e; u.x1 = (tile - __builtin_amdgcn_readfirstlane(ts[e])) * 256; u.x2 = __builtin_amdgcn_readfirstlane(cn[e]);
        u.A = hx2; u.lda = D; u.B = w + (size_t)e * 3 * D * D + (size_t)u.pn * 256 * D; u.ldb = D; u.K = D; return true; }
    __device__ __forceinline__ unsigned a_off(const Unit& u, int row) const {
        int p = u.x1 + row; p = p < u.x2 ? p : u.x2 - 1; const int r = ((const GAS int*)list)[2 * ((size_t)u.x0 * NT + p)] & 0x7fffffff; return (unsigned)r * (D * 2); }
    typedef NoPre Pre; typedef NoPre UPre;
    __device__ __forceinline__ NoPre pre(const Unit&, int, int) const { return NoPre{}; }
    __device__ __forceinline__ NoPre upre(const Unit&, int) const { return NoPre{}; }
    __device__ __forceinline__ void epi(const Unit& u, int row, int c8, const float* v0, const float* v1, const NoPre&, const NoPre&) const {
        float r[8];
#pragma unroll
        for (int j = 0; j < 8; ++j) r[j] = siluf_(v0[j]) * v1[j];
        *(GAS v4u*)(he + ((size_t)u.pm * 256 + row) * D + u.pn * 128 + c8) = pack8(r);
    }
};
struct PMoe2 {
    int G, c; const bf16* he; const bf16* w; const int2* list; bf16* c01; const LAS int* ts; const LAS int* cn;
    __device__ __forceinline__ bool next(int i, Unit& u) const {
        const int ntl = __builtin_amdgcn_readfirstlane(ts[16]); const int idx = i * G + c; if (idx >= ntl * 4) return false;
        int tile; order2d(idx, ntl, 4, tile, u.pn); u.pm = tile; int e = 0;
#pragma unroll
        for (int j = 1; j < 16; ++j) e += (tile >= ts[j]) ? 1 : 0;
        e = __builtin_amdgcn_readfirstlane(e);
        u.x0 = e; u.x1 = (tile - __builtin_amdgcn_readfirstlane(ts[e])) * 256; u.x2 = __builtin_amdgcn_readfirstlane(cn[e]);
        u.A = he + (size_t)tile * 256 * D; u.lda = D; u.B = w + (size_t)e * 3 * D * D + (size_t)2 * D * D + (size_t)u.pn * 256 * D; u.ldb = D; u.K = D; return true; }
    __device__ __forceinline__ unsigned a_off(const Unit& u, int row) const { return (unsigned)row * (D * 2); }
    struct Pre { int2 en; }; typedef NoPre UPre;
    __device__ __forceinline__ NoPre upre(const Unit&, int) const { return NoPre{}; }
    __device__ __forceinline__ Pre pre(const Unit& u, int row, int) const { int p = u.x1 + row; p = p < u.x2 ? p : u.x2 - 1; Pre r; const v2u e2 = *(const GAS v2u*)(list + (size_t)u.x0 * NT + p); r.en.x = (int)e2.x; r.en.y = (int)e2.y; return r; }
    __device__ __forceinline__ void epi(const Unit& u, int row, int c8, const float* v0, const float* v1, const Pre& pr, const NoPre&) const {
        const int p = u.x1 + row; if (p >= u.x2) return;
        const int2 en = pr.en; const int r = en.x & 0x7fffffff, s = (en.x >> 31) & 1; const float w8 = __builtin_bit_cast(float, en.y);
        bf16* dst = c01 + ((size_t)s * NT + r) * D + u.pn * 256 + c8; float a[8], b[8];
#pragma unroll
        for (int j = 0; j < 8; ++j) { a[j] = w8 * v0[j]; b[j] = w8 * v1[j]; }
        *(GAS v4u*)dst = pack8(a); *(GAS v4u*)(dst + 128) = pack8(b);
    }
};

__device__ __forceinline__ void transpose_item(const float* W, int K, int N, bf16* WT, int k0, int n0, int drow0, LAS float* scr, int lane) {
    const int kr = lane >> 3, n4 = (lane & 7) * 4; f32x4 v[8];
#pragma unroll
    for (int i = 0; i < 8; ++i) v[i] = *(const GAS f32x4*)(W + (size_t)(k0 + 8 * i + kr) * N + n0 + n4);
#pragma unroll
    for (int i = 0; i < 8; ++i) { LAS float* d = scr + (8 * i + kr) * 33 + n4; d[0] = v[i][0]; d[1] = v[i][1]; d[2] = v[i][2]; d[3] = v[i][3]; }
    LDS_WAIT(); asm volatile("" ::: "memory");
    const int c = lane & 7;
#pragma unroll
    for (int j = 0; j < 4; ++j) { const int n = (lane >> 3) + 8 * j; const LAS float* s = scr + (8 * c) * 33 + n;
        v4u o; o.x = pk2(s[0 * 33], s[1 * 33]); o.y = pk2(s[2 * 33], s[3 * 33]); o.z = pk2(s[4 * 33], s[5 * 33]); o.w = pk2(s[6 * 33], s[7 * 33]);
        *(GAS v4u*)(WT + (size_t)(drow0 + n) * K + k0 + 8 * c) = o; }
    LDS_WAIT(); asm volatile("" ::: "memory");
}
__device__ __forceinline__ void p_prologue(Frame& F) {
    const int gw = F.bid * NWAVES + F.wave, NGW = F.G * NWAVES;
    LAS float* scr = (LAS float*)(F.lds + F.wave * 16384);
    constexpr int I_IN = 16 * 144, I_SQ = 16 * 32;
    constexpr int NIT = 2 * (I_IN + 2 * I_SQ);
    for (int it = gw; it < NIT; it += NGW) {
        int r = it; const int l = r / (I_IN + 2 * I_SQ); r -= l * (I_IN + 2 * I_SQ);
        if (r < I_IN) { const int kb = r / 144, nb = r % 144; transpose_item(F.kin[7] + (size_t)l * D * INW, D, INW, (bf16*)(F.ws + WS_WIN) + (size_t)l * INW * D, kb * 64, nb * 32, nb * 32, scr, F.lane); continue; }
        r -= I_IN;
        const int which = r / I_SQ; r -= which * I_SQ; const int kb = r / 32, nb = r % 32;
        transpose_item(F.kin[which ? 17 : 15] + (size_t)l * D * D, D, D, (bf16*)(F.ws + (which ? WS_WO : WS_WR)) + (size_t)l * D * D, kb * 64, nb * 32, nb * 32, scr, F.lane);
    }
    __syncthreads();
    LAS float* T4 = (LAS float*)(F.lds + 65536);
    for (int o = F.tid; o < 4096; o += NTHR) T4[o] = cospif((float)o * (2.0f / 4096.0f));
    __syncthreads();
    for (int o = F.bid * NTHR + F.tid; o < 2 * D * D; o += F.G * NTHR) {
        const int l = o >> 20, rem = o & (D * D - 1), kk = rem >> 10, n = rem & 1023;
        const int ch = kk & 511, g = ch >> 7, cc = ch & 127; const bool sn = kk >= 512;
        const float* wf = F.kin[16] + (size_t)l * 512 * D + (size_t)(g * 128) * D + n; float s = 0.f;
#pragma unroll 8
        for (int m = 0; m < 128; ++m) { const int ph = (cc * m) & 127;
            s += T4[(32 * ph + (sn ? 1024 : 0)) & 4095] * wf[(size_t)m * D]; }
        ((bf16*)(F.ws + WS_WF))[(size_t)l * D * D + (size_t)n * D + kk] = (bf16)f2bf(s);
    }
    { const float scl = 1.0f / sqrtf(4096.f * 128.f), scc = 1.0f / sqrtf(256.f * 128.f);
      for (size_t o = (size_t)F.bid * NTHR + F.tid; o < (size_t)8192 * 512; o += (size_t)F.G * NTHR) {
          const int r = (int)(o >> 9), t0 = (int)(o & 511) * 8, rr = r & 4095, sh = r < 4096 ? 0 : 3072; float v[8];
#pragma unroll
          for (int j = 0; j < 8; ++j) v[j] = T4[(rr * (t0 + j) + sh) & 4095] * scl;
          *(GAS v4u*)((bf16*)(F.ws + WS_CSL) + (size_t)r * 4096 + t0) = pack8(v); }
      for (int o = F.bid * NTHR + F.tid; o < 512 * 32; o += F.G * NTHR) {
          const int r = o >> 5, t0 = (o & 31) * 8, rr = r & 255, sh = r < 256 ? 0 : 3072; float v[8];
#pragma unroll
          for (int j = 0; j < 8; ++j) v[j] = T4[(16 * ((rr * (t0 + j)) & 255) + sh) & 4095] * scc;
          *(GAS v4u*)((bf16*)(F.ws + WS_CSC) + (size_t)r * 256 + t0) = pack8(v); } }
    for (int o = F.bid * NTHR + F.tid; o < 2 * 2 * 1024; o += F.G * NTHR) { const float lam = F.kin[14][o]; const float sp = (-lam > 20.f) ? -lam : log1pf(__expf(-lam));
        ((float*)(F.ws + WS_MODS + 512 * 1024))[o] = -8.0f * sp; }
    __syncthreads();
    { LAS float* sc = (LAS float*)(F.lds + 131072 - 9 * 1024 * 4);
      LAS float* red = (LAS float*)F.lds;
      for (int o = F.tid; o < 9 * 1024; o += NTHR) { const float cv = o < 8192 ? F.kin[1][o] : F.kin[3][o - 8192]; sc[o] = siluf_(cv); }
      __syncthreads();
      for (int it = F.bid; it < 2 * (NMOD * D / 64); it += F.G) {
          const int l = it / (NMOD * D / 64), n = (it % (NMOD * D / 64)) * 64 + F.lane; const float* w = F.kin[4] + (size_t)l * D * NMOD * D + n; float acc[9];
#pragma unroll
          for (int q = 0; q < 9; ++q) acc[q] = 0.f;
#pragma unroll 16
          for (int k = F.wave * 128; k < F.wave * 128 + 128; ++k) { const float wv = w[(size_t)k * NMOD * D];
#pragma unroll
              for (int q = 0; q < 9; ++q) acc[q] += sc[q * 1024 + k] * wv; }
#pragma unroll
          for (int q = 0; q < 9; ++q) red[(F.wave * 9 + q) * 64 + F.lane] = acc[q];
          __syncthreads();
          for (int o = F.tid; o < 9 * 64; o += NTHR) { const int q = o >> 6, ln = o & 63; float s = 0.f;
#pragma unroll
              for (int wv = 0; wv < 8; ++wv) s += red[(wv * 9 + q) * 64 + ln];
              const int nn = (it % (NMOD * D / 64)) * 64 + ln;
              ((float*)(F.ws + WS_MODS))[((size_t)(l * 9 + q)) * NMOD * D + nn] = s + F.kin[5][(size_t)l * NMOD * D + nn]; }
          __syncthreads();
      } }
}

template <int MODE> __device__ __forceinline__ void p_rows(Frame& F, int l, int dummy = 0) {
    const int NR = (MODE == 2 || (MODE == 1 && l == 1)) ? NL : NT;
    const bool comb = (MODE == 0 && l == 1) || MODE == 2;
    const int lane = F.lane;
    LAS float* RW = (LAS float*)F.lds;
    LAS int* lcnt = (LAS int*)(F.lds + 65536);
    LAS int* rinfo = lcnt + 64;
    const int rpb = (NR + F.G - 1) / F.G, r0 = F.bid * rpb, r1 = (r0 + rpb < NR) ? r0 + rpb : NR;
    const int rpw = (rpb + NWAVES - 1) / NWAVES, w0 = r0 + F.wave * rpw, w1 = (w0 + rpw < r1) ? w0 + rpw : r1;
    if (MODE == 1) {
#pragma unroll
        for (int i = 0; i < 8; ++i) { const int f = F.tid + NTHR * i, k = f >> 2, e4 = f & 3; const f32x4 wv = *(const GAS f32x4*)(F.kin[19] + (size_t)f * 4);
            *(LAS f32x4*)(RW + ((((k >> 8) * 4 + (k & 3)) * 4 + e4) * 64 + ((k & 255) >> 2)) * 4) = wv; }
        if (F.tid < 32) lcnt[F.tid] = 0; __syncthreads(); }
    const float* gn = MODE == 0 ? F.kin[6] + (size_t)l * D : MODE == 1 ? F.kin[18] + (size_t)l * D : F.kin[24];
    bf16* hx = (bf16*)(F.ws + WS_RA); const bf16* c01 = (const bf16*)(F.ws + WS_C01);
    const float* xin_l = (MODE == 0 && l == 0) ? F.kin[0] : F.out; const float* xin_c = (MODE == 0 && l == 0) ? F.kin[2] : (const float*)(F.ws + WS_HCTX);
    float cA[16], cB[16], g2v[16]; int cur_mb = -1;
#pragma unroll
    for (int q = 0; q < 16; ++q) { cA[q] = 0.f; cB[q] = 0.f; g2v[q] = 0.f; }
    f32x4 nv[4]; v2u nc0[4], nc1[4];
#pragma unroll
    for (int j = 0; j < 4; ++j) { nv[j] = (f32x4){0.f, 0.f, 0.f, 0.f}; nc0[j] = (v2u){0u, 0u}; nc1[j] = (v2u){0u, 0u}; }
#define PR_LOAD(R) do { const int r_ = (R); const float* s_ = r_ < NL ? xin_l + (size_t)r_ * D : xin_c + (size_t)(r_ - NL) * D; \
        _Pragma("unroll") for (int j = 0; j < 4; ++j) { nv[j] = *(const GAS f32x4*)(s_ + lane * 4 + 256 * j); \
            if (comb) { nc0[j] = *(const GAS v2u*)(c01 + (size_t)r_ * D + lane * 4 + 256 * j); nc1[j] = *(const GAS v2u*)(c01 + ((size_t)NT + r_) * D + lane * 4 + 256 * j); } } } while (0)
    if (w0 < w1) PR_LOAD(w0);
    for (int r = w0; r < w1; ++r) {
        f32x4 v[4]; v2u c0[4], c1[4];
#pragma unroll
        for (int j = 0; j < 4; ++j) { v[j] = nv[j]; c0[j] = nc0[j]; c1[j] = nc1[j]; }
        if (r + 1 < w1) PR_LOAD(r + 1);
        const int mb = mb_of(r);
        if (mb != cur_mb) { cur_mb = mb;
            const float *sh = modp(F, l, mb, MODE == 1 ? 3 : 0), *sc = modp(F, l, mb, MODE == 1 ? 4 : 1), *g2 = modp(F, MODE == 2 ? 1 : 0, mb, 5);
#pragma unroll
            for (int j = 0; j < 4; ++j) { const int k = lane * 4 + 256 * j; const f32x4 g = *(const GAS f32x4*)(gn + k);
                if (MODE != 2) { const f32x4 s1 = *(const GAS f32x4*)(sc + k), s0 = *(const GAS f32x4*)(sh + k);
#pragma unroll
                    for (int q = 0; q < 4; ++q) { cA[4 * j + q] = g[q] * (1.f + s1[q]); cB[4 * j + q] = s0[q]; } }
                else {
#pragma unroll
                    for (int q = 0; q < 4; ++q) cA[4 * j + q] = g[q]; }
                if (comb) { const f32x4 gv = *(const GAS f32x4*)(g2 + k);
#pragma unroll
                    for (int q = 0; q < 4; ++q) g2v[4 * j + q] = gv[q]; } } }
        float* xrow = r < NL ? F.out + (size_t)r * D : (float*)(F.ws + WS_HCTX) + (size_t)(r - NL) * D;
        float ss = 0.f;
#pragma unroll
        for (int j = 0; j < 4; ++j) {
            if (comb) { v[j][0] += g2v[4 * j] * (bflo(c0[j].x) + bflo(c1[j].x)); v[j][1] += g2v[4 * j + 1] * (bfhi(c0[j].x) + bfhi(c1[j].x));
                        v[j][2] += g2v[4 * j + 2] * (bflo(c0[j].y) + bflo(c1[j].y)); v[j][3] += g2v[4 * j + 3] * (bfhi(c0[j].y) + bfhi(c1[j].y));
                        if (MODE == 0) *(GAS f32x4*)(xrow + lane * 4 + 256 * j) = v[j]; }
            ss += (v[j][0] * v[j][0] + v[j][1] * v[j][1]) + (v[j][2] * v[j][2] + v[j][3] * v[j][3]); }
        const float rstd = rsqrtf(wave_sum(ss, lane) * (1.f / D) + RMS_EPS);
        float lg[16];
#pragma unroll
        for (int e = 0; e < 16; ++e) lg[e] = 0.f;
#pragma unroll
        for (int j = 0; j < 4; ++j) { const int k = lane * 4 + 256 * j; float o[4];
#pragma unroll
            for (int q = 0; q < 4; ++q) { o[q] = v[j][q] * rstd * cA[4 * j + q] + cB[4 * j + q];
                if (MODE == 1) { const LAS f32x4* rw = (const LAS f32x4*)RW + ((j * 4 + q) * 4) * 64 + lane;
#pragma unroll
                    for (int e4 = 0; e4 < 4; ++e4) { const f32x4 w = rw[e4 * 64]; lg[4 * e4] += o[q] * w[0]; lg[4 * e4 + 1] += o[q] * w[1]; lg[4 * e4 + 2] += o[q] * w[2]; lg[4 * e4 + 3] += o[q] * w[3]; } } }
            if (MODE == 2) *(GAS f32x4*)(xrow + k) = (f32x4){o[0], o[1], o[2], o[3]};
            else { v2u w; w.x = pk2(o[0], o[1]); w.y = pk2(o[2], o[3]); *(GAS v2u*)(hx + (size_t)r * D + k) = w; } }
        if (MODE == 1) {
#define PR_BP(x, m) __builtin_bit_cast(float, __builtin_amdgcn_ds_bpermute((lane ^ (m)) << 2, __builtin_bit_cast(int, (x))))
            float t8[8], t4[4], t2[2]; const bool b3 = lane & 8, b2 = lane & 4, b1 = lane & 2, b0 = lane & 1;
#pragma unroll
            for (int i = 0; i < 8; ++i) { const float snd = b3 ? lg[i] : lg[i + 8]; t8[i] = (b3 ? lg[i + 8] : lg[i]) + PR_BP(snd, 8); }
#pragma unroll
            for (int i = 0; i < 4; ++i) { const float snd = b2 ? t8[i] : t8[i + 4]; t4[i] = (b2 ? t8[i + 4] : t8[i]) + PR_BP(snd, 4); }
#pragma unroll
            for (int i = 0; i < 2; ++i) { const float snd = b1 ? t4[i] : t4[i + 2]; t2[i] = (b1 ? t4[i + 2] : t4[i]) + PR_BP(snd, 2); }
            float val; { const float snd = b0 ? t2[0] : t2[1]; val = (b0 ? t2[1] : t2[0]) + PR_BP(snd, 1); }
            val += PR_BP(val, 16); val += PR_BP(val, 32);
#undef PR_BP
            float aff[16], sel[16];
#pragma unroll
            for (int e = 0; e < 16; ++e) { const float lgt = __builtin_bit_cast(float, __builtin_amdgcn_readlane(__builtin_bit_cast(int, val), e)); aff[e] = sigmoidf_(lgt); sel[e] = aff[e] + F.kin[20][e]; }
            int grp = 0; float best = -1e30f;
#pragma unroll
            for (int g = 0; g < 4; ++g) { const float a = sel[4 * g], b = sel[4 * g + 1], c = sel[4 * g + 2], dd = sel[4 * g + 3];
                const float s = fmaxf(fmaxf(fmaxf(a + b, a + c), fmaxf(a + dd, b + c)), fmaxf(b + dd, c + dd));
                if (s > best) { best = s; grp = g; } }
            float s4[4], a4[4];
#pragma unroll
            for (int q = 0; q < 4; ++q) { s4[q] = grp == 0 ? sel[q] : grp == 1 ? sel[4 + q] : grp == 2 ? sel[8 + q] : sel[12 + q]; a4[q] = grp == 0 ? aff[q] : grp == 1 ? aff[4 + q] : grp == 2 ? aff[8 + q] : aff[12 + q]; }
            int i0 = 0; float m0 = s4[0], af0 = a4[0];
#pragma unroll
            for (int q = 1; q < 4; ++q) if (s4[q] > m0) { m0 = s4[q]; i0 = q; af0 = a4[q]; }
            int i1 = -1; float m1 = -1e30f, af1 = 0.f;
#pragma unroll
            for (int q = 0; q < 4; ++q) if (q != i0 && s4[q] > m1) { m1 = s4[q]; i1 = q; af1 = a4[q]; }
            const int e0 = grp * 4 + i0, e1 = grp * 4 + i1; const float inv = 1.f / (af0 + af1);
            if (lane == 0) { const int lr0 = __hip_atomic_fetch_add(lcnt + e0, 1, __ATOMIC_RELAXED, __HIP_MEMORY_SCOPE_WORKGROUP), lr1 = __hip_atomic_fetch_add(lcnt + e1, 1, __ATOMIC_RELAXED, __HIP_MEMORY_SCOPE_WORKGROUP);
                LAS int* ri = rinfo + (r - r0) * 5; ri[0] = e0 | (e1 << 8); ri[1] = lr0; ri[2] = lr1; ri[3] = __builtin_bit_cast(int, af0 * inv); ri[4] = __builtin_bit_cast(int, af1 * inv); }
        }
    }
#undef PR_LOAD
    if (MODE == 1) {
        __syncthreads();
        if (F.tid < 16) lcnt[16 + F.tid] = (int)__hip_atomic_fetch_add(F.ctl + CW_CNT + 64 * l + 128 * dummy + F.tid, (unsigned)lcnt[F.tid], __ATOMIC_RELAXED, __HIP_MEMORY_SCOPE_AGENT);
        __syncthreads();
        int2* list = (int2*)(F.ws + (dummy ? WS_SUM : WS_LIST));
        for (int rl = F.tid; rl < r1 - r0; rl += NTHR) { const LAS int* ri = rinfo + rl * 5; const int e0 = ri[0] & 255, e1 = ri[0] >> 8, r = r0 + rl;
            list[(size_t)e0 * NT + lcnt[16 + e0] + ri[1]] = make_int2(r, ri[3]);
            list[(size_t)e1 * NT + lcnt[16 + e1] + ri[2]] = make_int2(r | (int)0x80000000, ri[4]); }
    }
}
__device__ __forceinline__ void p_transpose(Frame& F, int l) {
    LAS bf16* tile = (LAS bf16*)F.lds;
    const bf16* uf = (const bf16*)(F.ws + WS_RF); bf16* ut = (bf16*)(F.ws + WS_RG);
    for (int it = F.bid; it < 4096 + (l == 1 ? 0 : 256); it += F.G) {
        int b, tb, cb, L; size_t rowbase; bf16* dst;
        if (it < 4096) { b = it >> 9; tb = (it >> 3) & 63; cb = it & 7; L = 4096; rowbase = (size_t)b * 4096 + tb * 64; dst = ut + (size_t)b * 512 * 4096; }
        else { const int j = it - 4096; b = j >> 5; tb = (j >> 3) & 3; cb = j & 7; L = 256; rowbase = (size_t)NL + b * 256 + tb * 64; dst = ut + (size_t)8 * 512 * 4096 + (size_t)b * 512 * 256; }
        { const int t = F.tid >> 3, c8 = (F.tid & 7) * 8; const v4u w = *(const GAS v4u*)(uf + (rowbase + t) * 512 + cb * 64 + c8);
          LAS unsigned* p = (LAS unsigned*)(tile + t * 72 + c8); p[0] = w.x; p[1] = w.y; p[2] = w.z; p[3] = w.w; }
        __syncthreads();
        { const int c = F.tid >> 3, t8 = (F.tid & 7) * 8; v4u o; unsigned h[8];
#pragma unroll
          for (int j = 0; j < 8; ++j) h[j] = tile[(t8 + j) * 72 + c];
          o.x = h[0] | (h[1] << 16); o.y = h[2] | (h[3] << 16); o.z = h[4] | (h[5] << 16); o.w = h[6] | (h[7] << 16);
          *(GAS v4u*)(dst + (size_t)(cb * 64 + c) * L + tb * 64 + t8) = o; }
        __syncthreads();
    }
}
__device__ __forceinline__ void p_scan_simple(Frame& F, int l) {
    if (F.bid >= 128) return;
    const int b = F.bid >> 4, h = (F.bid >> 1) & 7, d = F.bid & 1;
    LAS float* U = (LAS float*)F.lds;
    LAS float* RAg = U + 64 * 128;
    LAS float* XIg = RAg + 64 * 128;
    const bf16* urnn = (const bf16*)(F.ws + WS_RB);
    bf16* hout = (bf16*)(F.ws + (d ? WS_RF : WS_RA));
    const float* cw = F.kin[8] + (size_t)l * 4 * D + h * 128; const float* cb = F.kin[9] + (size_t)l * D + h * 128;
    const float* Wa = F.kin[10] + ((size_t)(l * 2 + d) * 8 + h) * 128 * 128; const float* Wx = F.kin[12] + ((size_t)(l * 2 + d) * 8 + h) * 128 * 128;
    const float* ba = F.kin[11] + ((size_t)(l * 2 + d) * 8 + h) * 128; const float* bx = F.kin[13] + ((size_t)(l * 2 + d) * 8 + h) * 128;
    const float* n8 = (const float*)(F.ws + WS_MODS + 512 * 1024) + (size_t)(l * 2 + d) * 1024 + h * 128;
    const int ch = F.tid & 127, tq = F.tid >> 7;
    float hstate = 0.f;
    for (int step = 0; step < 68; ++step) {
        const int j = d == 0 ? step : (step < 4 ? 3 - step : 71 - step);
        const bool isctx = j < 4; const size_t row0 = isctx ? (size_t)NL + b * 256 + j * 64 : (size_t)b * 4096 + (size_t)(j - 4) * 64;
        __syncthreads();
        for (int o = F.tid; o < 64 * 128; o += NTHR) { const int t = o >> 7, c = o & 127; float s = cb[c];
#pragma unroll
            for (int k = 0; k < 4; ++k) { const int tt = t + k - 2; bool ok; if (isctx) { const int g = j * 64 + tt; ok = g >= 0 && g < 256; } else ok = tt >= 0 && tt < 64;
                if (ok) s += cw[(size_t)k * D + c] * bf2f(urnn[(row0 + tt) * D + h * 128 + c]); }
            U[o] = s; }
        __syncthreads();
        { float ar[16], ax[16];
#pragma unroll
          for (int q = 0; q < 16; ++q) { ar[q] = 0.f; ax[q] = 0.f; }
          for (int k = 0; k < 128; ++k) { const float wa = Wa[(size_t)k * 128 + ch], wx = Wx[(size_t)k * 128 + ch];
#pragma unroll
              for (int q = 0; q < 16; ++q) { const float uv = U[(tq * 16 + q) * 128 + k]; ar[q] += uv * wa; ax[q] += uv * wx; } }
          const float bav = ba[ch], bxv = bx[ch], n8v = n8[ch];
#pragma unroll
          for (int q = 0; q < 16; ++q) { const int t = tq * 16 + q; const float r = sigmoidf_(ar[q] + bav), ig = sigmoidf_(ax[q] + bxv);
              const float la = n8v * r, a = __expf(la), y2 = 2.f * la;
              const float om = (y2 > -0.02f) ? -(y2 * (1.f + y2 * (0.5f + y2 * (1.f / 6.f)))) : 1.f - __expf(y2);
              RAg[t * 128 + ch] = a; XIg[t * 128 + ch] = sqrtf(om) * ig * U[t * 128 + ch]; } }
        __syncthreads();
        if (F.tid < 128) {
            for (int q = 0; q < 64; ++q) { const int t = d == 0 ? q : 63 - q; hstate = RAg[t * 128 + ch] * hstate + XIg[t * 128 + ch]; RAg[t * 128 + ch] = hstate; } }
        __syncthreads();
        for (int o = F.tid; o < 64 * 16; o += NTHR) { const int t = o >> 4, c8 = (o & 15) * 8; float v[8];
#pragma unroll
            for (int q = 0; q < 8; ++q) v[q] = RAg[t * 128 + c8 + q];
            *(GAS v4u*)(hout + (row0 + t) * D + h * 128 + c8) = pack8(v); }
    }
}
constexpr int SC_XRAW = 0, SC_U32 = 17408, SC_UBF = SC_U32 + 32768, SC_YT = SC_UBF + 16384, SC_CW = SC_YT + 16384;
__device__ __forceinline__ float fast_sigmoid(float x) { return __builtin_amdgcn_rcpf(1.f + __expf(-x)); }
template <int PASS> __device__ __forceinline__ void p_scan_fast(Frame& F, int l) {
    LAS unsigned char* lds = F.lds;
    const int tid = F.tid, lane = F.lane, w = F.wave, fr = lane & 15, fq = lane >> 4;
    const bf16* urnn = (const bf16*)(F.ws + WS_RB); const bf16* gate = (const bf16*)(F.ws + WS_RC); bf16* yout = (bf16*)(F.ws + WS_RA);
    float* SUM = (float*)(F.ws + WS_SUM); const float* CIN = (const float*)(F.ws + WS_CIN);
    const int h = F.bid & 7, qi = F.bid >> 3, nq = (F.G - h + 7) >> 3;
    bf16x8 bw[4][4];
    float bia[4];
    const unsigned wloff = (unsigned)((8 * fq) * 128 + 16 * w + fr) * 4u;
#pragma unroll
    for (int ty = 0; ty < 4; ++ty) { const int d = ty >> 1; const char* Wh = (const char*)(F.kin[(ty & 1) ? 12 : 10] + ((size_t)(l * 2 + d) * 8 + h) * 128 * 128);
#pragma unroll
        for (int ks = 0; ks < 4; ++ks) { float t8[8];
#pragma unroll
            for (int q = 0; q < 8; ++q) t8[q] = *(const GAS float*)(Wh + (size_t)(32 * ks + q) * 512 + wloff);
            const v4u pk = pack8(t8); bw[ty][ks] = __builtin_bit_cast(bf16x8, pk); }
        bia[ty] = F.kin[(ty & 1) ? 13 : 11][((size_t)(l * 2 + d) * 8 + h) * 128 + 16 * w + fr]; }
    const float n8f = ((const float*)(F.ws + WS_MODS + 512 * 1024))[(size_t)(l * 2 + 0) * 1024 + h * 128 + 16 * w + fr];
    const float n8b = ((const float*)(F.ws + WS_MODS + 512 * 1024))[(size_t)(l * 2 + 1) * 1024 + h * 128 + 16 * w + fr];
    { LAS float* CW = (LAS float*)(lds + SC_CW);
      for (int o = tid; o < 5 * 128; o += NTHR) CW[o] = o < 512 ? F.kin[8][(size_t)l * 4 * D + (size_t)(o >> 7) * D + h * 128 + (o & 127)] : F.kin[9][(size_t)l * D + h * 128 + (o & 127)]; }
    v4u raw[3];
#define SC_LOAD_RAW(PI) do { const int b_ = skipctx ? ((PI) >> 6) : (PI) / 68, j_ = skipctx ? 4 + ((PI) & 63) : (PI) % 68; const bool ic_ = j_ < 4; const size_t r0_ = ic_ ? (size_t)NL + b_ * 256 + j_ * 64 : (size_t)b_ * 4096 + (size_t)(j_ - 4) * 64; \
        _Pragma("unroll") for (int q3 = 0; q3 < 3; ++q3) { const int p_ = tid + q3 * 512, rr_ = p_ >> 4, c16_ = p_ & 15, tt_ = rr_ - 2; bool ok_ = p_ < 68 * 16; \
            if (ic_) { const int g_ = j_ * 64 + tt_; ok_ = ok_ && g_ >= 0 && g_ < 256; } else ok_ = ok_ && tt_ >= 0 && tt_ < 64; \
            const v4u v_ = *(const GAS v4u*)(urnn + (r0_ + (ok_ ? tt_ : 0)) * D + h * 128 + c16_ * 8);     \
            raw[q3].x = ok_ ? v_.x : 0u; raw[q3].y = ok_ ? v_.y : 0u; raw[q3].z = ok_ ? v_.z : 0u; raw[q3].w = ok_ ? v_.w : 0u; } } while (0)
    const bool skipctx = PASS == 2 && l == 1;
    const int npair = skipctx ? 512 : 544;
    if (qi < npair) SC_LOAD_RAW(qi);
    for (int pi = qi; pi < npair; pi += nq) {
        const int b = skipctx ? (pi >> 6) : pi / 68, j = skipctx ? 4 + (pi & 63) : pi % 68;
        const bool isctx = j < 4; const size_t row0 = isctx ? (size_t)NL + b * 256 + j * 64 : (size_t)b * 4096 + (size_t)(j - 4) * 64;
        __syncthreads();
#pragma unroll
        for (int q3 = 0; q3 < 3; ++q3) { const int p = tid + q3 * 512; if (p < 68 * 16) *(LAS v4u*)(lds + SC_XRAW + (p >> 4) * 256 + (p & 15) * 16) = raw[q3]; }
        __syncthreads();
        if (pi + nq < npair) SC_LOAD_RAW(pi + nq);
        v4u gt0 = (v4u){0u, 0u, 0u, 0u}, gt1 = gt0; float cinf = 0.f, cinb = 0.f;
        if (PASS == 2) { const bf16* gp = gate + (row0 + (tid >> 3)) * D + h * 128 + (tid & 7) * 16; gt0 = *(const GAS v4u*)gp; gt1 = *(const GAS v4u*)(gp + 8);
            cinf = CIN[(((size_t)b * 2 + 0) * 68 + j) * 1024 + h * 128 + 16 * w + fr]; cinb = CIN[(((size_t)b * 2 + 1) * 68 + j) * 1024 + h * 128 + 16 * w + fr]; }
        { const int t = tid >> 3, cg = tid & 7; const LAS float* CW = (const LAS float*)(lds + SC_CW); float u[16];
#pragma unroll
          for (int q = 0; q < 16; ++q) u[q] = CW[512 + cg * 16 + q];
#pragma unroll
          for (int k = 0; k < 4; ++k) { float x[16]; unpack8(*(const LAS v4u*)(lds + SC_XRAW + (t + k) * 256 + cg * 32), x); unpack8(*(const LAS v4u*)(lds + SC_XRAW + (t + k) * 256 + cg * 32 + 16), x + 8);
#pragma unroll
              for (int q = 0; q < 16; ++q) u[q] += CW[k * 128 + cg * 16 + q] * x[q]; }
#pragma unroll
          for (int q = 0; q < 4; ++q) *(LAS f32x4*)(lds + SC_U32 + t * 512 + cg * 64 + q * 16) = (f32x4){u[4 * q], u[4 * q + 1], u[4 * q + 2], u[4 * q + 3]};
          const int ft = (t & 3) | (((t >> 4) & 3) << 2);
          *(LAS v4u*)(lds + SC_UBF + t * 256 + (((cg * 2) ^ ft) << 4)) = pack8(u); *(LAS v4u*)(lds + SC_UBF + t * 256 + (((cg * 2 + 1) ^ ft) << 4)) = pack8(u + 8); }
        __syncthreads();
        const int c = 16 * w + fr;
        float hs[16];
#pragma unroll
        for (int d = 0; d < 2; ++d) {
            f32x4 acc[2][4];
#pragma unroll
            for (int ty = 0; ty < 2; ++ty)
#pragma unroll
                for (int m = 0; m < 4; ++m) acc[ty][m] = (f32x4){0.f, 0.f, 0.f, 0.f};
#pragma unroll
            for (int m = 0; m < 4; ++m) { const int tau = 16 * (fr >> 2) + 4 * m + (fr & 3);
#pragma unroll
                for (int ks = 0; ks < 4; ++ks) { const bf16x8 af = *(const LAS bf16x8*)(lds + SC_UBF + tau * 256 + (((4 * ks + fq) ^ fr) << 4));
                    acc[0][m] = __builtin_amdgcn_mfma_f32_16x16x32_bf16(af, bw[2 * d][ks], acc[0][m], 0, 0, 0); acc[1][m] = __builtin_amdgcn_mfma_f32_16x16x32_bf16(af, bw[2 * d + 1][ks], acc[1][m], 0, 0, 0); } }
            float av[16], bv[16]; const float n8 = d ? n8b : n8f, b_a = bia[2 * d], b_x = bia[2 * d + 1];
#pragma unroll
            for (int q = 0; q < 16; ++q) { const float r = fast_sigmoid(acc[0][q >> 2][q & 3] + b_a), ig = fast_sigmoid(acc[1][q >> 2][q & 3] + b_x);
                const float la = n8 * r, a = __expf(la), y2 = 2.f * la;
                const float ser = -(y2 * (1.f + y2 * (0.5f + y2 * (1.f / 6.f)))), dif = 1.f - a * a;
                const float om = (y2 > -0.02f) ? ser : dif;
                av[q] = a; bv[q] = __builtin_amdgcn_sqrtf(om) * ig * *(const LAS float*)(lds + SC_U32 + (16 * fq + q) * 512 + c * 4);
                if ((q & 3) == 3) __builtin_amdgcn_sched_barrier(0); }
            float P = 1.f, H = 0.f;
#pragma unroll
            for (int q = 0; q < 16; ++q) { const int t = d ? 15 - q : q; H = av[t] * H + bv[t]; P *= av[t]; }
            float Ps[4], Hs[4];
#pragma unroll
            for (int sgi = 0; sgi < 4; ++sgi) { Ps[sgi] = __builtin_bit_cast(float, __builtin_amdgcn_ds_bpermute(((sgi << 4) | fr) << 2, __builtin_bit_cast(int, P)));
                                              Hs[sgi] = __builtin_bit_cast(float, __builtin_amdgcn_ds_bpermute(((sgi << 4) | fr) << 2, __builtin_bit_cast(int, H))); }
            if (PASS == 1) {
                float Pt = 1.f, Ht = 0.f;
#pragma unroll
                for (int q = 0; q < 4; ++q) { const int sgi = d ? 3 - q : q; Ht = Ps[sgi] * Ht + Hs[sgi]; Pt *= Ps[sgi]; }
                if (fq == 0) { float* dst = SUM + ((((size_t)b * 2 + d) * 68 + j) * 2) * 1024 + h * 128 + c; dst[0] = Pt; dst[1024] = Ht; }
            } else {
                float cin = d ? cinb : cinf;
#pragma unroll
                for (int q = 0; q < 3; ++q) { const int sgi = d ? 3 - q : q; const bool before = d ? (sgi > fq) : (sgi < fq); if (before) cin = Ps[sgi] * cin + Hs[sgi]; }
                float hh = cin;
#pragma unroll
                for (int q = 0; q < 16; ++q) { const int t = d ? 15 - q : q; hh = av[t] * hh + bv[t]; if (d == 0) hs[t] = hh; else hs[t] += hh; }
            }
        }
        if (PASS == 2) {
#pragma unroll
            for (int q = 0; q < 16; ++q) *(LAS bf16*)(lds + SC_YT + (16 * fq + q) * 256 + c * 2) = (bf16)f2bf(hs[q]);
            __syncthreads();
            { const int t = tid >> 3, cg = tid & 7; float yv[16], gv[16];
              unpack8(*(const LAS v4u*)(lds + SC_YT + t * 256 + cg * 32), yv); unpack8(*(const LAS v4u*)(lds + SC_YT + t * 256 + cg * 32 + 16), yv + 8);
              unpack8(gt0, gv); unpack8(gt1, gv + 8);
#pragma unroll
              for (int q = 0; q < 16; ++q) yv[q] *= gv[q];
              bf16* yp = yout + (row0 + t) * D + h * 128 + cg * 16; *(GAS v4u*)yp = pack8(yv); *(GAS v4u*)(yp + 8) = pack8(yv + 8); }
        }
    }
#undef SC_LOAD_RAW
    __syncthreads();
}
__device__ __forceinline__ void p_scan_carry(Frame& F) {
    const float* SUM = (const float*)(F.ws + WS_SUM); float* CIN = (float*)(F.ws + WS_CIN);
    for (int g = F.bid * NTHR + F.tid; g < 8 * 2 * 1024; g += F.G * NTHR) {
        const int b = g >> 11, d = (g >> 10) & 1, ch = g & 1023; float cst = 0.f;
        const float* sp = SUM + (((size_t)b * 2 + d) * 68) * 2 * 1024 + ch; float* cp = CIN + (((size_t)b * 2 + d) * 68) * 1024 + ch;
#pragma unroll 4
        for (int step = 0; step < 68; ++step) { const int j = d == 0 ? step : (step < 4 ? 3 - step : 71 - step);
            const float P = sp[(size_t)j * 2048], H = sp[(size_t)j * 2048 + 1024]; cp[(size_t)j * 1024] = cst; cst = P * cst + H; }
    }
}

__device__ __forceinline__ void p_ycombine(Frame& F) {
    bf16* hf = (bf16*)(F.ws + WS_RA); const bf16* hb = (const bf16*)(F.ws + WS_RF); const bf16* gt = (const bf16*)(F.ws + WS_RC);
    for (size_t o = ((size_t)F.bid * NTHR + F.tid) * 8; o < (size_t)NT * D; o += (size_t)F.G * NTHR * 8) {
        float a[8], b[8], g[8]; unpack8(*(const GAS v4u*)(hf + o), a); unpack8(*(const GAS v4u*)(hb + o), b); unpack8(*(const GAS v4u*)(gt + o), g);
#pragma unroll
        for (int j = 0; j < 8; ++j) a[j] = (a[j] + b[j]) * g[j];
        *(GAS v4u*)(hf + o) = pack8(a); }
}
__device__ __forceinline__ void p_moe_wconv(Frame& F, int l) {
    __syncthreads();
    { const int gw = F.bid * NWAVES + F.wave, NGW = F.G * NWAVES; LAS float* scr = (LAS float*)(F.lds + F.wave * 16384);
      bf16* mw = (bf16*)(F.ws + WS_MOEW);
      for (int it = gw; it < 16 * 3 * 512; it += NGW) { const int e = it / 1536, rem = it % 1536, m = rem / 512, q = rem % 512, kb = q >> 5, nb = q & 31;
          const float* W = F.kin[m == 0 ? 21 : m == 1 ? 22 : 23] + ((size_t)l * 16 + e) * D * D; bf16* dst = mw + (size_t)e * 3 * D * D + (m == 2 ? (size_t)2 * D * D : 0);
          const int n0 = nb * 32; const int drow = m == 2 ? n0 : ((n0 >> 7) * 256 + (m == 1 ? 128 : 0) + (n0 & 127));
          transpose_item(W, D, D, dst, kb * 64, n0, drow, scr, F.lane); } }
}
__device__ __forceinline__ void moe_table(Frame& F, int l, LAS int* ts, LAS int* cn) {
    __syncthreads();
    if (F.tid == 0) { int acc = 0;
        for (int e = 0; e < 16; ++e) { const int c = (int)__hip_atomic_load(F.ctl + CW_CNT + 64 * l + e, __ATOMIC_RELAXED, __HIP_MEMORY_SCOPE_AGENT); cn[e] = c; ts[e] = acc; acc += (c + 255) >> 8; }
        ts[16] = acc; }
    __syncthreads();
}

constexpr int NPH = 24;
struct Args { const float* in[25]; float* out; unsigned char* ws; int ph_lo, ph_hi; };
__global__ void __launch_bounds__(NTHR, 2) fwd_kernel(Args args) {
    extern __shared__ __attribute__((aligned(16))) unsigned char lds[];
    Frame F;
    F.lds = (LAS unsigned char*)lds; F.tid = threadIdx.x; F.lane = F.tid & 63; F.wave = __builtin_amdgcn_readfirstlane(F.tid >> 6);
    F.G = gridDim.x; F.bid = blockIdx.x; F.ws = args.ws; F.out = args.out; F.ctl = (unsigned*)(args.ws + WS_CTL);
    F.kin = (const float* const __attribute__((address_space(4)))*)__builtin_amdgcn_kernarg_segment_ptr();
    volatile LAS unsigned* MISC = (volatile LAS unsigned*)(F.lds + MISC_OFF);
    if (F.tid < 32) MISC[F.tid] = 0u;
    __syncthreads();
    XcdBarrier bar; bar.bar = F.ctl + CW_BAR; bar.x = 0; bar.st = nullptr;
    if (MK_N_LAUNCHES == 1) bar = xcd_barrier_post(F.ctl + CW_BAR, MISC + 8);
    LAS int* ts = (LAS int*)(F.lds + MISC_OFF + 256); LAS int* cn = ts + 32;
    const int lo = args.ph_lo, hi = args.ph_hi;
#ifndef SITE_MASK
#define SITE_MASK 0xfffffu
#endif
#define SITE(j) (((SITE_MASK) >> (j)) & 1u)
#ifndef REP_MASK
#define REP_MASK 0u
#endif
#define IN(k) (lo <= (k) && (k) < hi)
#define LAUNDER() do { asm volatile("v_mbcnt_lo_u32_b32 %0, -1, 0\n\tv_mbcnt_hi_u32_b32 %0, -1, %0" : "=v"(F.lane)); asm volatile("" : "+s"(F.ws), "+s"(F.out), "+s"(F.kin), "+s"(F.ctl), "+s"(F.lds), "+s"(F.wave), "+s"(F.bid), "+s"(F.G), "+v"(F.lane)); F.tid = F.wave * 64 + F.lane; } while (0)
#define TWICE(j, stmt) do { stmt; if (((REP_MASK) >> (j)) & 1u) { __syncthreads(); LAUNDER(); stmt; } } while (0)
#define SEAM(k) do { if (MK_N_LAUNCHES == 1 && IN((k) + 1)) xcd_barrier(bar); } while (0)

    if (SITE(0) && IN(0)) { LAUNDER(); TWICE(0, p_prologue(F)); SEAM(0); }
    for (int l = 0; l < 2; ++l) {
        const int pb = 1 + 11 * l;
        if (SITE(1) && IN(pb + 0)) { LAUNDER(); p_rows<0>(F, l); if (((REP_MASK >> 1) & 1u) && l == 0) { __syncthreads(); LAUNDER(); p_rows<0>(F, 0); } SEAM(pb + 0); }
        if (SITE(2) && IN(pb + 1)) { LAUNDER();
            PInproj p; p.G = F.G; p.c = F.bid; p.l = l; p.hx = (const bf16*)(F.ws + WS_RA); p.wt = (const bf16*)(F.ws + WS_WIN) + (size_t)l * INW * D;
            p.urnn = (bf16*)(F.ws + WS_RB); p.gate = (bf16*)(F.ws + WS_RC); p.ufour = (bf16*)(F.ws + WS_RF); p.sgr = (bf16*)(F.ws + WS_RD); p.sgf = (bf16*)(F.ws + WS_RE);
            TWICE(2, fast_gemm_phase(F, p)); SEAM(pb + 1); }
        if (SITE(3) && IN(pb + 2)) { LAUNDER(); TWICE(3, p_scan_fast<1>(F, l); p_transpose(F, l)); SEAM(pb + 2); }
        if (SITE(4) && IN(pb + 3)) { LAUNDER(); TWICE(4, p_scan_carry(F)); SEAM(pb + 3); }
        if (SITE(5) && IN(pb + 4)) { LAUNDER();
            PDft p; p.G = F.G; p.c = F.bid; p.nun = l == 1 ? 512 : 544; p.csl = (const bf16*)(F.ws + WS_CSL); p.csc = (const bf16*)(F.ws + WS_CSC); p.ut = (const bf16*)(F.ws + WS_RG); p.g = (bf16*)(F.ws + WS_RH);
            TWICE(5, fast_gemm_phase(F, p)); SEAM(pb + 4); }
        if (SITE(6) && IN(pb + 5)) { LAUNDER(); TWICE(6, p_scan_fast<2>(F, l)); SEAM(pb + 5); }
        if (SITE(7) && IN(pb + 6)) { LAUNDER();
            PMerge p; p.G = F.G; p.c = F.bid; p.npan = l == 1 ? NL / 256 : NPAN;     p.gm = (const bf16*)(F.ws + WS_RH); p.y = (const bf16*)(F.ws + WS_RA); p.wf = (const bf16*)(F.ws + WS_WF) + (size_t)l * D * D; p.wr = (const bf16*)(F.ws + WS_WR) + (size_t)l * D * D;
            p.sgr = (const bf16*)(F.ws + WS_RD); p.sgf = (const bf16*)(F.ws + WS_RE); p.t1 = (bf16*)(F.ws + WS_RB); p.mg = (bf16*)(F.ws + WS_RC);
            TWICE(7, fast_gemm_phase(F, p)); SEAM(pb + 6); }
        if (SITE(8) && IN(pb + 7)) { LAUNDER();
            PWout p; p.G = F.G; p.c = F.bid; p.npan = l == 1 ? NL / 256 : NPAN; p.mg = (const bf16*)(F.ws + WS_RC); p.wo = (const bf16*)(F.ws + WS_WO) + (size_t)l * D * D;
            p.xold_l = l == 0 ? F.kin[0] : F.out; p.xold_c = l == 0 ? F.kin[2] : (const float*)(F.ws + WS_HCTX); p.xnew_l = F.out; p.xnew_c = (float*)(F.ws + WS_HCTX); p.g1 = modp(F, l, 0, 2);
            TWICE(8, fast_gemm_phase(F, p)); SEAM(pb + 7); }
        if (SITE(9) && IN(pb + 8)) { LAUNDER(); p_rows<1>(F, l); if ((REP_MASK >> 13) & 1u) { __syncthreads(); LAUNDER(); p_rows<1>(F, l, 1); } TWICE(9, p_moe_wconv(F, l)); SEAM(pb + 8); }
        if (SITE(10) && IN(pb + 9)) { LAUNDER();
            moe_table(F, l, ts, cn);
            PMoe1 p; p.G = F.G; p.c = F.bid; p.hx2 = (const bf16*)(F.ws + WS_RA); p.w = (const bf16*)(F.ws + WS_MOEW); p.list = (const int2*)(F.ws + WS_LIST); p.he = (bf16*)(F.ws + WS_HE); p.ts = ts; p.cn = cn;
            TWICE(10, fast_gemm_phase(F, p)); SEAM(pb + 9); }
        if (SITE(11) && IN(pb + 10)) { LAUNDER();
            moe_table(F, l, ts, cn);
            PMoe2 p; p.G = F.G; p.c = F.bid; p.he = (const bf16*)(F.ws + WS_HE); p.w = (const bf16*)(F.ws + WS_MOEW); p.list = (const int2*)(F.ws + WS_LIST); p.c01 = (bf16*)(F.ws + WS_C01); p.ts = ts; p.cn = cn;
            TWICE(11, fast_gemm_phase(F, p)); SEAM(pb + 10); }
    }
    if (SITE(12) && IN(23)) { LAUNDER(); p_rows<2>(F, 1); }
#undef IN
#undef SEAM
}

extern "C" void kernel_launch(void* const* d_in, const int* in_sizes, int n_in, void* d_out, int out_size, void* d_ws, size_t ws_size, hipStream_t stream) {
    static int grid = 0;
    if (grid == 0) {
        if (n_in != 25 || out_size != NL * D || ws_size < WS_END2) { fprintf(stderr, "kernel_launch: unexpected shapes (n_in %d, out %d, ws %zu)\n", n_in, out_size, ws_size); grid = -1; return; }
        int dev = 0, cus = 0, per_cu = 0;
        if (hipGetDevice(&dev) != hipSuccess || hipDeviceGetAttribute(&cus, hipDeviceAttributeMultiprocessorCount, dev) != hipSuccess) { grid = -1; return; }
        if (hipFuncSetAttribute((const void*)fwd_kernel, hipFuncAttributeMaxDynamicSharedMemorySize, LDS_BYTES) != hipSuccess) { fprintf(stderr, "kernel_launch: hipFuncSetAttribute failed\n"); grid = -1; return; }
        if (hipOccupancyMaxActiveBlocksPerMultiprocessor(&per_cu, (const void*)fwd_kernel, NTHR, LDS_BYTES) != hipSuccess || per_cu < 1) { fprintf(stderr, "kernel_launch: occupancy query says %d\n", per_cu); }
        (void)hipGetLastError();
        grid = cus;
    }
    if (grid < 0) return;
    (void)hipMemsetAsync((char*)d_ws + WS_CTL, 0, CTL_ZERO_BYTES, stream);
    Args a{};
    for (int i = 0; i < 25; ++i) a.in[i] = (const float*)d_in[i];
    a.out = (float*)d_out; a.ws = (unsigned char*)d_ws;
    if (MK_N_LAUNCHES == 1) { a.ph_lo = 0; a.ph_hi = NPH; hipLaunchKernelGGL(fwd_kernel, dim3(grid), dim3(NTHR), LDS_BYTES, stream, a); }
    else for (int p = 0; p < NPH; ++p) { a.ph_lo = p; a.ph_hi = p + 1; hipLaunchKernelGGL(fwd_kernel, dim3(grid), dim3(NTHR), LDS_BYTES, stream, a); }
}
```

```cpp
#include <hip/hip_runtime.h>
#include <cstdio>
#include <cstdint>

#ifndef MK_N_LAUNCHES
#define MK_N_LAUNCHES 1
#endif

#define GAS __attribute__((address_space(1)))
#define LAS __attribute__((address_space(3)))
typedef unsigned short bf16;
typedef unsigned v4u __attribute__((ext_vector_type(4)));
typedef unsigned v2u __attribute__((ext_vector_type(2)));
typedef float f32x4 __attribute__((ext_vector_type(4)));
typedef short bf16x8 __attribute__((ext_vector_type(8)));

constexpr int D = 1024, NB = 8, SEQ = 4096, CTX = 256, NL = NB * SEQ, NC = NB * CTX, NT = NL + NC;
constexpr int NPAN = NT / 256;
constexpr int INW = 4608, NE = 16, NMOD = 6;
constexpr float RMS_EPS = 1e-6f;
constexpr int NWAVES = 8, NTHR = 512;

constexpr size_t MiB = 1u << 20;
constexpr size_t WS_CTL = 0, CTL_ZERO_BYTES = 1 * MiB;
constexpr size_t WS_MODS = 1 * MiB;
constexpr size_t WS_WIN = 2 * MiB;
constexpr size_t WS_WR = 20 * MiB, WS_WF = 24 * MiB, WS_WO = 28 * MiB;
constexpr size_t WS_LRU = 32 * MiB;
constexpr size_t WS_CSC = 34 * MiB;
constexpr size_t WS_HCTX = 35 * MiB;
constexpr size_t WS_LIST = 43 * MiB;
constexpr size_t WS_CSL = 48 * MiB;
constexpr size_t WS_RA = 112 * MiB;
constexpr size_t WS_RB = 180 * MiB;
constexpr size_t WS_RC = 248 * MiB;
constexpr size_t WS_RD = 316 * MiB;
constexpr size_t WS_RE = 384 * MiB;
constexpr size_t WS_RF = 452 * MiB;
constexpr size_t WS_RG = 486 * MiB;
constexpr size_t WS_RH = 520 * MiB;
constexpr size_t WS_END = 588 * MiB;
constexpr size_t WS_MOEW = 180 * MiB;
constexpr size_t WS_HE = 276 * MiB;
constexpr size_t WS_C01 = 420 * MiB;
constexpr size_t WS_SUM = 588 * MiB;
constexpr size_t WS_CIN = 597 * MiB;
constexpr size_t WS_END2 = 602 * MiB;
static_assert(WS_C01 + (size_t)2 * NT * D * 2 <= WS_END, "map");
static_assert(WS_RA + (size_t)NT * D * 2 <= WS_RB && WS_RH + (size_t)NT * D * 2 <= WS_END, "map");

constexpr int CW_TMO = 0;
constexpr int CW_CNT = 64;
constexpr int CW_BAR = 4096;

constexpr int LDS_BYTES = 147456;
constexpr int MISC_OFF = 131072 + 8192;

__device__ __forceinline__ unsigned f2bf(float f) { unsigned u = __builtin_bit_cast(unsigned, f); return (u + 0x7fffu + ((u >> 16) & 1u)) >> 16; }
__device__ __forceinline__ unsigned pk2(float lo, float hi) { return f2bf(lo) | (f2bf(hi) << 16); }
__device__ __forceinline__ float bflo(unsigned w) { return __builtin_bit_cast(float, w << 16); }
__device__ __forceinline__ float bfhi(unsigned w) { return __builtin_bit_cast(float, w & 0xffff0000u); }
__device__ __forceinline__ float bf2f(bf16 h) { return __builtin_bit_cast(float, ((unsigned)h) << 16); }
__device__ __forceinline__ v4u pack8(const float* v) { v4u o; o.x = pk2(v[0], v[1]); o.y = pk2(v[2], v[3]); o.z = pk2(v[4], v[5]); o.w = pk2(v[6], v[7]); return o; }
__device__ __forceinline__ void unpack8(v4u w, float* v) { v[0] = bflo(w.x); v[1] = bfhi(w.x); v[2] = bflo(w.y); v[3] = bfhi(w.y); v[4] = bflo(w.z); v[5] = bfhi(w.z); v[6] = bflo(w.w); v[7] = bfhi(w.w); }
__device__ __forceinline__ float sigmoidf_(float x) { return __builtin_amdgcn_rcpf(1.f + __expf(-x)); }
__device__ __forceinline__ float siluf_(float x) { return x * __builtin_amdgcn_rcpf(1.f + __expf(-x)); }
__device__ __forceinline__ float gelu_tanh(float x) { const float u = 0.7978845608028654f * (x + 0.044715f * x * x * x); const float e = __expf(2.f * u); const float t = 1.f - 2.f * __builtin_amdgcn_rcpf(e + 1.f); return 0.5f * x * (1.f + t); }
__device__ __forceinline__ float wave_sum(float v, int lane) {
#pragma unroll
    for (int o = 1; o < 64; o <<= 1) v += __builtin_bit_cast(float, __builtin_amdgcn_ds_bpermute((lane ^ o) << 2, __builtin_bit_cast(int, v)));
    return v;
}
#define LDS_WAIT() asm volatile("s_waitcnt lgkmcnt(0)" ::: "memory")
#define VM_WAIT() asm volatile("s_waitcnt vmcnt(0)" ::: "memory")

#define XB_TMO      128
#define XB_XCNT(j)  (256  + 64 * (j))
#define XB_XSUB(j)  (1280 + 64 * (j))
#define XB_XGEN(j)  (2304 + 64 * (j))
#define XB_TOP      3328
#define XB_TOPGEN   3392
#define XCD_BAR_WORDS 3456
#define XB_SPIN_CAP (1u << 18)
__device__ __forceinline__ unsigned xb_ld(unsigned* p)              { return __hip_atomic_load(p, __ATOMIC_RELAXED, __HIP_MEMORY_SCOPE_AGENT); }
__device__ __forceinline__ unsigned xb_add(unsigned* p, unsigned v) { return __hip_atomic_fetch_add(p, v, __ATOMIC_RELAXED, __HIP_MEMORY_SCOPE_AGENT); }
__device__ __forceinline__ unsigned xb_xcc_id() { return (unsigned)__builtin_amdgcn_s_getreg((3 << 11) | 20) & 0xFu; }
#define XB_SPIN(cond, bar) do { unsigned _sp = 0; while (cond) { __builtin_amdgcn_s_sleep(1); \
    if ((++_sp & 255u) == 0u) { if (xb_ld(&(bar)[XB_TMO])) break; if (_sp > XB_SPIN_CAP) { atomicAdd(&(bar)[XB_TMO], 1u); break; } } } } while (0)
struct XcdBarrier { unsigned* bar; unsigned x; volatile LAS unsigned* st; };
__device__ __forceinline__ XcdBarrier xcd_barrier_post(unsigned* bar, volatile LAS unsigned* st) {
    XcdBarrier b; b.bar = bar; b.x = xb_xcc_id(); b.st = st;
    if (threadIdx.x == 0) (void)xb_add(&bar[XB_XCNT(b.x)], 1u);
    return b;
}
__device__ __forceinline__ void xcd_barrier_complete(unsigned* bar, unsigned x, unsigned& nloc, unsigned& nx) {
    const unsigned G = gridDim.x * gridDim.y * gridDim.z;
    unsigned sum, cnt, mine, sp = 0u;
    for (;;) {
        sum = 0u; cnt = 0u; mine = 0u;
#pragma unroll
        for (unsigned j = 0; j < 16; ++j) { const unsigned c = xb_ld(&bar[XB_XCNT(j)]); sum += c; cnt += (c > 0u) ? 1u : 0u; mine = (j == x) ? c : mine; }
        if (sum == G) break;
        __builtin_amdgcn_s_sleep(1);
        if ((++sp & 255u) == 0u) { if (xb_ld(&bar[XB_TMO])) break; if (sp > XB_SPIN_CAP) { atomicAdd(&bar[XB_TMO], 1u); break; } }
    }
    nloc = mine > 0u ? mine : 1u; nx = cnt > 0u ? cnt : 1u;
}
__device__ __forceinline__ void xcd_barrier(const XcdBarrier& b) {
    asm volatile("s_waitcnt vmcnt(0)" ::: "memory");
    __syncthreads();
    if (threadIdx.x == 0) {
        unsigned* bar = b.bar;
        __builtin_amdgcn_s_waitcnt(0);
        unsigned nloc = b.st[0], nx = b.st[1];
        if (nloc == 0u) { xcd_barrier_complete(bar, b.x, nloc, nx); b.st[0] = nloc; b.st[1] = nx; }
        const unsigned old = xb_add(&bar[XB_XSUB(b.x)], 1u);
        const unsigned gen = old / nloc;
        if (old + 1u == (gen + 1u) * nloc) {
            __builtin_amdgcn_fence(__ATOMIC_RELEASE, "agent");
            asm volatile("s_waitcnt vmcnt(0)" ::: "memory");
            const unsigned og = xb_add(&bar[XB_TOP], 1u);
            const unsigned tg = og / nx;
            if (og + 1u == (tg + 1u) * nx) xb_add(&bar[XB_TOPGEN], 1u);
            else XB_SPIN(xb_ld(&bar[XB_TOPGEN]) == tg, bar);
            __builtin_amdgcn_fence(__ATOMIC_ACQUIRE, "agent");
            xb_add(&bar[XB_XGEN(b.x)], 1u);
            asm volatile("s_waitcnt vmcnt(0)" ::: "memory");
        } else {
            XB_SPIN(xb_ld(&bar[XB_XGEN(b.x)]) == gen, bar);
            __builtin_amdgcn_fence(__ATOMIC_ACQUIRE, "agent");
            asm volatile("s_waitcnt vmcnt(0)" ::: "memory");
        }
    }
    __syncthreads();
}

struct Frame {
    LAS unsigned char* lds;
    int tid, lane, wave, G, bid;
    unsigned* ctl;
    const float* const __attribute__((address_space(4)))* kin;
    float* out;
    unsigned char* ws;
};
__device__ __forceinline__ const float* modp(const Frame& F, int l, int mb, int which) { return (const float*)(F.ws + WS_MODS) + ((size_t)(l * 9 + mb) * NMOD + which) * D; }
__device__ __forceinline__ int mb_of(int r) { return r < NL ? (r >> 12) : 8; }

struct Unit { const bf16* A; const bf16* B; int lda, ldb, K; int pm, pn, x0, x1, x2; };

constexpr int HTB = 128 * 64 * 2;
__device__ __forceinline__ int lds_byte(int r, int c) { const int st = (r >> 4) * 2 + (c >> 5), rr = r & 15, cc = c & 31, ob = rr * 64 + cc * 2; return st * 1024 + (ob ^ (((ob >> 9) & 1) << 5)); }
__device__ __forceinline__ void stage_rc(int b, int& R, int& C) { const int st = b / 1024, sb = b % 1024, swz = sb ^ (((sb >> 9) & 1) << 5); R = (st >> 1) * 16 + swz / 64; C = (st & 1) * 32 + (swz % 64) / 2; }
__device__ __forceinline__ int perm32(int rho) { const int n = rho >> 4, i = rho & 15; return 8 * (i >> 2) + 4 * n + (i & 3); }
template <class P> __device__ __forceinline__ void fast_gemm_phase(Frame& F, const P& p) {
    LAS unsigned char* lds = F.lds;
    const int tid = F.tid, wid = F.wave, lane = F.lane, wr = wid >> 2, wc = wid & 3, fr = lane & 15, fq = lane >> 4;
    int R0, C0, R1, C1; stage_rc(tid * 16, R0, C0); stage_rc(tid * 16 + 8192, R1, C1);
    const int Rb0 = (R0 & ~31) + perm32(R0 & 31), Rb1 = (R1 & ~31) + perm32(R1 & 31);
    const unsigned ldsw = (unsigned)wid * 1024u;
    const int aoffL = lds_byte(wr * 64 + fr, fq * 8), boffL = lds_byte(wc * 32 + fr, fq * 8);
    Unit cur, nxt; int ui = 0;
    if (!p.next(0, cur)) return;
    const char* sA; const char* sB; unsigned sa00, sa01, sa10, sa11, sb0, sb1; size_t shB;
#define FG_SET(u) do { sA = (const char*)(u).A; sB = (const char*)(u).B; shB = (size_t)128 * (u).ldb * 2; \
        sa00 = p.a_off((u), R0) + C0 * 2; sa01 = p.a_off((u), R1) + C1 * 2; sa10 = p.a_off((u), 128 + R0) + C0 * 2; sa11 = p.a_off((u), 128 + R1) + C1 * 2; \
        sb0 = (unsigned)(Rb0 * (u).ldb + C0) * 2u; sb1 = (unsigned)(Rb1 * (u).ldb + C1) * 2u; } while (0)
#define FG_SA(b, h) (((b) * 2 + (h)) * HTB)
#define FG_SB(b, h) ((4 + (b) * 2 + (h)) * HTB)
#define FG_GLDS(src, bufoff, i) __builtin_amdgcn_global_load_lds((const unsigned*)(src), (LAS unsigned*)(lds + (bufoff) + ldsw + (i) * 8192), 16, 0, 0)
#define FG_STAGE_A0(bufoff, kt) do { const char* _pa = sA + (size_t)(kt) * 128; FG_GLDS(_pa + sa00, bufoff, 0); FG_GLDS(_pa + sa01, bufoff, 1); } while (0)
#define FG_STAGE_A1(bufoff, kt) do { const char* _pa = sA + (size_t)(kt) * 128; FG_GLDS(_pa + sa10, bufoff, 0); FG_GLDS(_pa + sa11, bufoff, 1); } while (0)
#define FG_STAGE_B(bufoff, h, kt) do { const char* _pb = sB + ((size_t)(h) * shB + (size_t)(kt) * 128); FG_GLDS(_pb + sb0, bufoff, 0); FG_GLDS(_pb + sb1, bufoff, 1); } while (0)
#define FG_LDA(dst, b, h) do { _Pragma("unroll") for (int m = 0; m < 4; ++m) _Pragma("unroll") for (int k = 0; k < 2; ++k) dst[m][k] = *(const LAS bf16x8*)(lds + FG_SA(b, h) + aoffL + m * 2048 + k * 1024); } while (0)
#define FG_LDB(dst, b, h) do { _Pragma("unroll") for (int n = 0; n < 2; ++n) _Pragma("unroll") for (int k = 0; k < 2; ++k) dst[n][k] = *(const LAS bf16x8*)(lds + FG_SB(b, h) + boffL + n * 2048 + k * 1024); } while (0)
#define FG_MMA(ai, bj, At, Bt) do { __builtin_amdgcn_s_setprio(1); _Pragma("unroll") for (int m = 0; m < 4; ++m) _Pragma("unroll") for (int n = 0; n < 2; ++n) _Pragma("unroll") for (int k = 0; k < 2; ++k) \
        acc[ai][bj][m][n] = __builtin_amdgcn_mfma_f32_16x16x32_bf16(Bt[n][k], At[m][k], acc[ai][bj][m][n], 0, 0, 0); __builtin_amdgcn_s_setprio(0); } while (0)
#define FG_WAIT_V(n) asm volatile("s_waitcnt vmcnt(" #n ")" ::: "memory")
#define FG_WAIT_L(n) asm volatile("s_waitcnt lgkmcnt(" #n ")" ::: "memory")
#define FG_BAR __builtin_amdgcn_s_barrier()
#define FG_SCHED __builtin_amdgcn_sched_barrier(0)
    f32x4 acc[2][2][4][2];
#pragma unroll
    for (int a = 0; a < 2; ++a)
#pragma unroll
        for (int b = 0; b < 2; ++b)
#pragma unroll
            for (int m = 0; m < 4; ++m)
#pragma unroll
                for (int n = 0; n < 2; ++n) acc[a][b][m][n] = (f32x4){0.f, 0.f, 0.f, 0.f};
    bf16x8 At[4][2], B0[2][2], B1[2][2];
    FG_SET(cur);
    FG_STAGE_B(FG_SB(0, 0), 0, 0); FG_STAGE_B(FG_SB(0, 1), 1, 0); FG_STAGE_A0(FG_SA(0, 0), 0); FG_STAGE_A1(FG_SA(0, 1), 0);
    if (wr == 1) FG_BAR;
    FG_WAIT_V(2); FG_BAR;
    FG_STAGE_B(FG_SB(1, 0), 0, 1); FG_STAGE_A0(FG_SA(1, 0), 1); FG_STAGE_B(FG_SB(1, 1), 1, 1);
    FG_WAIT_V(6); FG_BAR;
    for (;;) {
        const bool has_next = p.next(ui + 1, nxt);
        int nt = cur.K >> 6; asm volatile("" : "+s"(nt));
        for (int t = 0; t < nt; t += 2) {
            const bool last = (t == nt - 2);
            const int k2 = last ? 0 : t + 2, k3 = k2 + 1;
            FG_LDB(B0, 0, 0); FG_LDB(B1, 0, 1); FG_SCHED; FG_LDA(At, 0, 0); FG_STAGE_A1(FG_SA(1, 1), t + 1);
            if (last && has_next) FG_SET(nxt);
            FG_WAIT_V(8); FG_WAIT_L(0); FG_BAR; FG_MMA(0, 0, At, B0); FG_MMA(0, 1, At, B1); FG_BAR; FG_SCHED;
            FG_LDA(At, 0, 1); FG_STAGE_B(FG_SB(0, 0), 0, k2); FG_STAGE_B(FG_SB(0, 1), 1, k2); FG_STAGE_A0(FG_SA(0, 0), k2);
            FG_WAIT_V(8); FG_WAIT_L(0); FG_BAR; FG_MMA(1, 0, At, B0); FG_MMA(1, 1, At, B1); FG_BAR; FG_SCHED;
            FG_LDB(B0, 1, 0); FG_LDB(B1, 1, 1); FG_SCHED; FG_LDA(At, 1, 0); FG_STAGE_A1(FG_SA(0, 1), k2);
            FG_WAIT_V(8); FG_WAIT_L(0); FG_BAR; FG_MMA(0, 0, At, B0); FG_MMA(0, 1, At, B1); FG_BAR; FG_SCHED;
            FG_LDA(At, 1, 1); FG_STAGE_B(FG_SB(1, 0), 0, k3); FG_STAGE_B(FG_SB(1, 1), 1, k3); FG_STAGE_A0(FG_SA(1, 0), k3);
            FG_WAIT_V(8); FG_WAIT_L(0); FG_BAR; FG_MMA(1, 0, At, B0); FG_MMA(1, 1, At, B1); FG_BAR; FG_SCHED;
        }
        if (wr == 0) FG_BAR;
        if constexpr (P::PAIRED) {
#pragma unroll
            for (int m = 0; m < 4; ++m) {
                const float r0[8] = {acc[0][0][m][0][0], acc[0][0][m][0][1], acc[0][0][m][0][2], acc[0][0][m][0][3], acc[0][0][m][1][0], acc[0][0][m][1][1], acc[0][0][m][1][2], acc[0][0][m][1][3]};
                const float r1[8] = {acc[0][1][m][0][0], acc[0][1][m][0][1], acc[0][1][m][0][2], acc[0][1][m][0][3], acc[0][1][m][1][0], acc[0][1][m][1][1], acc[0][1][m][1][2], acc[0][1][m][1][3]};
                const float i0[8] = {acc[1][0][m][0][0], acc[1][0][m][0][1], acc[1][0][m][0][2], acc[1][0][m][0][3], acc[1][0][m][1][0], acc[1][0][m][1][1], acc[1][0][m][1][2], acc[1][0][m][1][3]};
                const float i1[8] = {acc[1][1][m][0][0], acc[1][1][m][0][1], acc[1][1][m][0][2], acc[1][1][m][0][3], acc[1][1][m][1][0], acc[1][1][m][1][1], acc[1][1][m][1][2], acc[1][1][m][1][3]};
                p.epi2(cur, wr * 64 + m * 16 + fr, wc * 32 + fq * 8, r0, r1, i0, i1);
                __builtin_amdgcn_sched_barrier(0);
            }
        } else
        { const typename P::UPre up = p.upre(cur, wc * 32 + fq * 8);
#pragma unroll
          for (int ai = 0; ai < 2; ++ai)
#pragma unroll
          for (int mb = 0; mb < 4; mb += P::EB) {
            typename P::Pre pre[4];
#pragma unroll
            for (int m = mb; m < mb + P::EB; ++m) pre[m] = p.pre(cur, ai * 128 + wr * 64 + m * 16 + fr, wc * 32 + fq * 8);
#pragma unroll
            for (int m = mb; m < mb + P::EB; ++m) {
                const float v0[8] = {acc[ai][0][m][0][0], acc[ai][0][m][0][1], acc[ai][0][m][0][2], acc[ai][0][m][0][3], acc[ai][0][m][1][0], acc[ai][0][m][1][1], acc[ai][0][m][1][2], acc[ai][0][m][1][3]};
                const float v1[8] = {acc[ai][1][m][0][0], acc[ai][1][m][0][1], acc[ai][1][m][0][2], acc[ai][1][m][0][3], acc[ai][1][m][1][0], acc[ai][1][m][1][1], acc[ai][1][m][1][2], acc[ai][1][m][1][3]};
                p.epi(cur, ai * 128 + wr * 64 + m * 16 + fr, wc * 32 + fq * 8, v0, v1, pre[m], up);
            } } }
        if (!has_next) break;
#pragma unroll
        for (int a = 0; a < 2; ++a)
#pragma unroll
            for (int b = 0; b < 2; ++b)
#pragma unroll
                for (int m = 0; m < 4; ++m)
#pragma unroll
                    for (int n = 0; n < 2; ++n) acc[a][b][m][n] = (f32x4){0.f, 0.f, 0.f, 0.f};
        cur = nxt; ++ui;
        if (wr == 1) FG_BAR;
    }
    FG_WAIT_V(0);
    FG_BAR;
#undef FG_SET
#undef FG_SA
#undef FG_SB
#undef FG_GLDS
#undef FG_STAGE_A0
#undef FG_STAGE_A1
#undef FG_STAGE_B
#undef FG_LDA
#undef FG_LDB
#undef FG_MMA
#undef FG_WAIT_V
#undef FG_WAIT_L
#undef FG_BAR
#undef FG_SCHED
}

__device__ __forceinline__ void order2d(int L, int nM, int nN, int& pm, int& pn) {
    const int nwg = nM * nN; int wgid = L; { const int q = nwg >> 3, r = nwg & 7, xcd = wgid & 7, off = wgid >> 3; wgid = (xcd < r ? xcd * (q + 1) : r * (q + 1) + (xcd - r) * q) + off; }
    const int nig = 8 * nN, gid = wgid / nig, fm = gid * 8, gsz = (nM - fm) < 8 ? (nM - fm) : 8;
    pm = fm + ((wgid % nig) % gsz); pn = (wgid % nig) / gsz;
}
struct NoPre {};
struct PInproj {
    static constexpr bool PAIRED = false; static constexpr int EB = 4;
    int G, c, l; const bf16* hx; const bf16* wt; bf16 *urnn, *gate, *ufour, *sgr, *sgf;
    __device__ __forceinline__ bool next(int i, Unit& u) const {
        const int idx = i * G + c; if (idx >= NPAN * 18) return false;
        order2d(idx, NPAN, 18, u.pm, u.pn); u.A = hx + (size_t)u.pm * 256 * D; u.lda = D; u.B = wt + (size_t)u.pn * 256 * D; u.ldb = D; u.K = D; return true; }
    __device__ __forceinline__ unsigned a_off(const Unit& u, int row) const { return (unsigned)row * (D * 2); }
    typedef NoPre Pre; typedef NoPre UPre;
    __device__ __forceinline__ NoPre pre(const Unit&, int, int) const { return NoPre{}; }
    __device__ __forceinline__ NoPre upre(const Unit&, int) const { return NoPre{}; }
    __device__ __forceinline__ void epi(const Unit& u, int row, int c8, const float* v0, const float* v1, const NoPre&, const NoPre&) const {
        const size_t r = (size_t)u.pm * 256 + row; const int col = u.pn * 256 + c8;
        float a[8], b[8];
        if (col < 1024) { *(GAS v4u*)(urnn + r * D + col) = pack8(v0); *(GAS v4u*)(urnn + r * D + col + 128) = pack8(v1); }
        else if (col < 2048) {
#pragma unroll
            for (int j = 0; j < 8; ++j) { a[j] = gelu_tanh(v0[j]); b[j] = gelu_tanh(v1[j]); }
            *(GAS v4u*)(gate + r * D + col - 1024) = pack8(a); *(GAS v4u*)(gate + r * D + col - 1024 + 128) = pack8(b); }
        else if (col < 2560) { *(GAS v4u*)(ufour + r * 512 + col - 2048) = pack8(v0); *(GAS v4u*)(ufour + r * 512 + col - 2048 + 128) = pack8(v1); }
        else {
#pragma unroll
            for (int j = 0; j < 8; ++j) { a[j] = sigmoidf_(v0[j]); b[j] = sigmoidf_(v1[j]); }
            bf16* dst = col < 3584 ? sgr + r * D + (col - 2560) : sgf + r * D + (col - 3584);
            *(GAS v4u*)dst = pack8(a); *(GAS v4u*)(dst + 128) = pack8(b); }
    }
};
struct PDft {
    static constexpr bool PAIRED = false; static constexpr int EB = 4;
    int G, c; const bf16 *csc, *ut; bf16* g;
    __device__ __forceinline__ bool next(int i, Unit& u) const {
        const int j = i * G + c; if (j >= 32) return false;
        const int b = j >> 2, rem = j & 3; u.pm = rem >> 1; u.pn = rem & 1; u.x0 = b;
        u.A = csc + (size_t)u.pm * 256 * 256; u.lda = 256; u.B = ut + ((size_t)b * 512 + u.pn * 256) * 256; u.ldb = 256; u.K = 256; return true; }
    __device__ __forceinline__ unsigned a_off(const Unit& u, int row) const { return (unsigned)row * 512u; }
    typedef NoPre Pre; typedef NoPre UPre;
    __device__ __forceinline__ NoPre pre(const Unit&, int, int) const { return NoPre{}; }
    __device__ __forceinline__ NoPre upre(const Unit&, int) const { return NoPre{}; }
    __device__ __forceinline__ void epi(const Unit& u, int row, int c8, const float* v0, const float* v1, const NoPre&, const NoPre&) const {
        const size_t r = (size_t)NL + u.x0 * 256 + row; const int col = u.pm * 512 + u.pn * 256 + c8;
        *(GAS v4u*)(g + r * D + col) = pack8(v0); *(GAS v4u*)(g + r * D + col + 128) = pack8(v1);
    }
};
struct PFftA {
    static constexpr bool PAIRED = true; static constexpr int EB = 4;
    int G, c; const bf16 *fa, *ut4; bf16* zt;
    __device__ __forceinline__ bool next(int i, Unit& u) const {
        const int idx = i * G + c; if (idx >= 512) return false;
        u.pm = 0; u.pn = idx; u.A = fa; u.lda = 128; u.B = ut4 + (size_t)idx * 256 * 128; u.ldb = 128; u.K = 128; return true; }
    __device__ __forceinline__ unsigned a_off(const Unit& u, int row) const { return (unsigned)row * 256u; }
    __device__ __forceinline__ void epi2(const Unit& u, int row, int c8, const float* r0, const float* r1, const float* i0, const float* i1) const {
        const int cq = row >> 6, k1 = row & 63;
#pragma unroll
        for (int h = 0; h < 2; ++h) { const float* zr = h ? r1 : r0; const float* zi = h ? i1 : i0; const int n = u.pn * 256 + c8 + h * 128, cp = (n >> 6) & 255, b = n >> 14; int t2 = n & 63;
            asm volatile("" : "+v"(t2));
            float orr[8], oi[8];
#pragma unroll
            for (int j = 0; j < 8; ++j) { const float ph = (float)(k1 * (t2 + j)) * (1.0f / 4096.0f); const float cs = __builtin_amdgcn_cosf(ph), sn = __builtin_amdgcn_sinf(ph);
                orr[j] = zr[j] * cs + zi[j] * sn; oi[j] = zi[j] * cs - zr[j] * sn; }
            bf16* dst = zt + ((((size_t)b * 512 + 2 * cp + cq) * 64 + k1) * 2) * 64 + t2;
            *(GAS v4u*)dst = pack8(orr); *(GAS v4u*)(dst + 64) = pack8(oi); __builtin_amdgcn_sched_barrier(0); }
    }
};
struct PFftC {
    static constexpr bool PAIRED = false; static constexpr int EB = 4;
    int G, c; const bf16 *fc, *zt; bf16* g;
    __device__ __forceinline__ bool next(int i, Unit& u) const {
        const int idx = i * G + c; if (idx >= 512) return false;
        const int b = idx >> 6, k1p = (idx >> 1) & 31, ct = idx & 1; u.x0 = b; u.x2 = k1p; u.pm = 0; u.pn = ct;
        u.A = fc; u.lda = 256; u.K = 256; u.B = zt + (((size_t)b * 512 + ct * 256) * 64 + 2 * k1p) * 128; u.ldb = 64 * 128; return true; }
    __device__ __forceinline__ unsigned a_off(const Unit& u, int row) const { return (unsigned)row * 512u; }
    typedef NoPre Pre; typedef NoPre UPre;
    __device__ __forceinline__ NoPre pre(const Unit&, int, int) const { return NoPre{}; }
    __device__ __forceinline__ NoPre upre(const Unit&, int) const { return NoPre{}; }
    __device__ __forceinline__ void epi(const Unit& u, int row, int c8, const float* v0, const float* v1, const NoPre&, const NoPre&) const {
        const int k1 = 2 * u.x2 + (row >> 7), ty = (row >> 6) & 1, k2 = row & 63; const size_t r = (size_t)u.x0 * 4096 + k1 + 64 * k2; const int col = ty * 512 + u.pn * 256 + c8;
        *(GAS v4u*)(g + r * D + col) = pack8(v0); *(GAS v4u*)(g + r * D + col + 128) = pack8(v1);
    }
};
struct PMerge {
    static constexpr bool PAIRED = false; static constexpr int EB = 2;
    int G, c, npan; const bf16 *gm, *y, *wf, *wr, *sgr, *sgf; bf16 *t1, *mg;
    __device__ __forceinline__ bool next(int i, Unit& u) const {
        const int tile = (i >> 1) * G + c; if (tile >= npan * 4) return false;
        order2d(tile, npan, 4, u.pm, u.pn); u.x0 = i & 1; u.lda = D; u.ldb = D; u.K = D;
        u.A = (u.x0 ? y : gm) + (size_t)u.pm * 256 * D; u.B = (u.x0 ? wr : wf) + (size_t)u.pn * 256 * D; return true; }
    __device__ __forceinline__ unsigned a_off(const Unit& u, int row) const { return (unsigned)row * (D * 2); }
    struct Pre { v4u a0, a1, b0, b1; }; typedef NoPre UPre;
    __device__ __forceinline__ NoPre upre(const Unit&, int) const { return NoPre{}; }
    __device__ __forceinline__ Pre pre(const Unit& u, int row, int c8) const {
        const size_t o = ((size_t)u.pm * 256 + row) * D + u.pn * 256 + c8; Pre r; const bf16* s = u.x0 ? sgr : sgf;
        r.a0 = *(const GAS v4u*)(s + o); r.a1 = *(const GAS v4u*)(s + o + 128); r.b0 = r.a0; r.b1 = r.a1;
        if (u.x0) { r.b0 = *(const GAS v4u*)(t1 + o); r.b1 = *(const GAS v4u*)(t1 + o + 128); }
        return r; }
    __device__ __forceinline__ void epi(const Unit& u, int row, int c8, const float* v0, const float* v1, const Pre& pr, const NoPre&) const {
        const size_t o = ((size_t)u.pm * 256 + row) * D + u.pn * 256 + c8;
#pragma unroll
        for (int h = 0; h < 2; ++h) { const float* v = h ? v1 : v0; const size_t oo = o + h * 128; float s[8], r[8], t[8];
            unpack8(h ? pr.a1 : pr.a0, s); unpack8(h ? pr.b1 : pr.b0, t);
            if (u.x0 == 0) {
#pragma unroll
                for (int j = 0; j < 8; ++j) r[j] = s[j] * v[j];
                *(GAS v4u*)(t1 + oo) = pack8(r); }
            else {
#pragma unroll
                for (int j = 0; j < 8; ++j) r[j] = s[j] * v[j] + t[j];
                *(GAS v4u*)(mg + oo) = pack8(r); } }
    }
};
struct PWout {
    static constexpr bool PAIRED = false; static constexpr int EB = 4;
    int G, c, npan; const bf16 *mg, *wo; const float *xold_l, *xold_c; float *xnew_l, *xnew_c; const float* g1;
    __device__ __forceinline__ bool next(int i, Unit& u) const {
        const int idx = i * G + c; if (idx >= npan * 4) return false;
        order2d(idx, npan, 4, u.pm, u.pn); u.lda = D; u.ldb = D; u.K = D; u.A = mg + (size_t)u.pm * 256 * D; u.B = wo + (size_t)u.pn * 256 * D; return true; }
    __device__ __forceinline__ unsigned a_off(const Unit& u, int row) const { return (unsigned)row * (D * 2); }
    struct Pre { f32x4 x[4]; }; struct UPre { f32x4 g[4]; };
    __device__ __forceinline__ UPre upre(const Unit& u, int c8) const { const float* gg = g1 + (size_t)mb_of(u.pm * 256) * NMOD * D + u.pn * 256 + c8; UPre r;
        r.g[0] = *(const GAS f32x4*)gg; r.g[1] = *(const GAS f32x4*)(gg + 4); r.g[2] = *(const GAS f32x4*)(gg + 128); r.g[3] = *(const GAS f32x4*)(gg + 132); return r; }
    __device__ __forceinline__ Pre pre(const Unit& u, int row, int c8) const { const int r = u.pm * 256 + row;
        const float* xo = (r < NL ? xold_l + (size_t)r * D : xold_c + (size_t)(r - NL) * D) + u.pn * 256 + c8; Pre p;
        p.x[0] = *(const GAS f32x4*)xo; p.x[1] = *(const GAS f32x4*)(xo + 4); p.x[2] = *(const GAS f32x4*)(xo + 128); p.x[3] = *(const GAS f32x4*)(xo + 132); return p; }
    __device__ __forceinline__ void epi(const Unit& u, int row, int c8, const float* v0, const float* v1, const Pre& pr, const UPre& up) const {
        const int r = u.pm * 256 + row;
        float* xn = (r < NL ? xnew_l + (size_t)r * D : xnew_c + (size_t)(r - NL) * D) + u.pn * 256 + c8;
#pragma unroll
        for (int q = 0; q < 4; ++q) { const float* v = (q < 2 ? v0 : v1) + 4 * (q & 1); f32x4 o;
            o[0] = pr.x[q][0] + up.g[q][0] * v[0]; o[1] = pr.x[q][1] + up.g[q][1] * v[1]; o[2] = pr.x[q][2] + up.g[q][2] * v[2]; o[3] = pr.x[q][3] + up.g[q][3] * v[3];
            *(GAS f32x4*)(xn + (q >> 1) * 128 + (q & 1) * 4) = o; }
    }
};
struct PMoe1 {
    static constexpr bool PAIRED = false; static constexpr int EB = 4;
    int G, c; const bf16* hx2; const bf16* w; const int2* list; bf16* he; const LAS int* ts; const LAS int* cn;
    __device__ __forceinline__ bool next(int i, Unit& u) const {
        const int ntl = __builtin_amdgcn_readfirstlane(ts[16]); const int idx = i * G + c; if (idx >= ntl * 8) return false;
        int tile; order2d(idx, ntl, 8, tile, u.pn); u.pm = tile; int e = 0;
#pragma unroll
        for (int j = 1; j < 16; ++j) e += (tile >= ts[j]) ? 1 : 0;
        e = __builtin_amdgcn_readfirstlane(e);
        u.x0 = e; u.x1 = (tile - __builtin_amdgcn_readfirstlane(ts[e])) * 256; u.x2 = __builtin_amdgcn_readfirstlane(cn[e]);
        u.A = hx2; u.lda = D; u.B = w + (size_t)e * 3 * D * D + (size_t)u.pn * 256 * D; u.ldb = D; u.K = D; return true; }
    __device__ __forceinline__ unsigned a_off(const Unit& u, int row) const {
        int p = u.x1 + row; p = p < u.x2 ? p : u.x2 - 1; const int r = ((const GAS int*)list)[2 * ((size_t)u.x0 * NT + p)] & 0x7fffffff; return (unsigned)r * (D * 2); }
    typedef NoPre Pre; typedef NoPre UPre;
    __device__ __forceinline__ NoPre pre(const Unit&, int, int) const { return NoPre{}; }
    __device__ __forceinline__ NoPre upre(const Unit&, int) const { return NoPre{}; }
    __device__ __forceinline__ void epi(const Unit& u, int row, int c8, const float* v0, const float* v1, const NoPre&, const NoPre&) const {
        float r[8];
#pragma unroll
        for (int j = 0; j < 8; ++j) r[j] = siluf_(v0[j]) * v1[j];
        *(GAS v4u*)(he + ((size_t)u.pm * 256 + row) * D + u.pn * 128 + c8) = pack8(r);
    }
};
struct PMoe2 {
    static constexpr bool PAIRED = false; static constexpr int EB = 4;
    int G, c; const bf16* he; const bf16* w; const int2* list; bf16* c01; const LAS int* ts; const LAS int* cn;
    __device__ __forceinline__ bool next(int i, Unit& u) const {
        const int ntl = __builtin_amdgcn_readfirstlane(ts[16]); const int idx = i * G + c; if (idx >= ntl * 4) return false;
        int tile; order2d(idx, ntl, 4, tile, u.pn); u.pm = tile; int e = 0;
#pragma unroll
        for (int j = 1; j < 16; ++j) e += (tile >= ts[j]) ? 1 : 0;
        e = __builtin_amdgcn_readfirstlane(e);
        u.x0 = e; u.x1 = (tile - __builtin_amdgcn_readfirstlane(ts[e])) * 256; u.x2 = __builtin_amdgcn_readfirstlane(cn[e]);
        u.A = he + (size_t)tile * 256 * D; u.lda = D; u.B = w + (size_t)e * 3 * D * D + (size_t)2 * D * D + (size_t)u.pn * 256 * D; u.ldb = D; u.K = D; return true; }
    __device__ __forceinline__ unsigned a_off(const Unit& u, int row) const { return (unsigned)row * (D * 2); }
    struct Pre { int2 en; }; typedef NoPre UPre;
    __device__ __forceinline__ NoPre upre(const Unit&, int) const { return NoPre{}; }
    __device__ __forceinline__ Pre pre(const Unit& u, int row, int) const { int p = u.x1 + row; p = p < u.x2 ? p : u.x2 - 1; Pre r; const v2u e2 = *(const GAS v2u*)(list + (size_t)u.x0 * NT + p); r.en.x = (int)e2.x; r.en.y = (int)e2.y; return r; }
    __device__ __forceinline__ void epi(const Unit& u, int row, int c8, const float* v0, const float* v1, const Pre& pr, const NoPre&) const {
        const int p = u.x1 + row; if (p >= u.x2) return;
        const int2 en = pr.en; const int r = en.x & 0x7fffffff, s = (en.x >> 31) & 1; const float w8 = __builtin_bit_cast(float, en.y);
        bf16* dst = c01 + ((size_t)s * NT + r) * D + u.pn * 256 + c8; float a[8], b[8];
#pragma unroll
        for (int j = 0; j < 8; ++j) { a[j] = w8 * v0[j]; b[j] = w8 * v1[j]; }
        *(GAS v4u*)dst = pack8(a); *(GAS v4u*)(dst + 128) = pack8(b);
    }
};

__device__ __forceinline__ void transpose_item(const float* W, int K, int N, bf16* WT, int k0, int n0, int drow0, LAS float* scr, int lane) {
    const int kr = lane >> 3, n4 = (lane & 7) * 4; f32x4 v[8];
#pragma unroll
    for (int i = 0; i < 8; ++i) v[i] = *(const GAS f32x4*)(W + (size_t)(k0 + 8 * i + kr) * N + n0 + n4);
#pragma unroll
    for (int i = 0; i < 8; ++i) { LAS float* d = scr + (8 * i + kr) * 33 + n4; d[0] = v[i][0]; d[1] = v[i][1]; d[2] = v[i][2]; d[3] = v[i][3]; }
    LDS_WAIT(); asm volatile("" ::: "memory");
    const int c = lane & 7;
#pragma unroll
    for (int j = 0; j < 4; ++j) { const int n = (lane >> 3) + 8 * j; const LAS float* s = scr + (8 * c) * 33 + n;
        v4u o; o.x = pk2(s[0 * 33], s[1 * 33]); o.y = pk2(s[2 * 33], s[3 * 33]); o.z = pk2(s[4 * 33], s[5 * 33]); o.w = pk2(s[6 * 33], s[7 * 33]);
        *(GAS v4u*)(WT + (size_t)(drow0 + n) * K + k0 + 8 * c) = o; }
    LDS_WAIT(); asm volatile("" ::: "memory");
}
__device__ __forceinline__ void p_prologue(Frame& F) {
    const int gw = F.bid * NWAVES + F.wave, NGW = F.G * NWAVES;
    LAS float* scr = (LAS float*)(F.lds + F.wave * 16384);
    constexpr int I_IN = 16 * 144, I_SQ = 16 * 32;
    constexpr int NIT = 2 * (I_IN + 2 * I_SQ);
    for (int it = gw; it < NIT; it += NGW) {
        int r = it; const int l = r / (I_IN + 2 * I_SQ); r -= l * (I_IN + 2 * I_SQ);
        if (r < I_IN) { const int kb = r / 144, nb = r % 144; transpose_item(F.kin[7] + (size_t)l * D * INW, D, INW, (bf16*)(F.ws + WS_WIN) + (size_t)l * INW * D, kb * 64, nb * 32, nb * 32, scr, F.lane); continue; }
        r -= I_IN;
        const int which = r / I_SQ; r -= which * I_SQ; const int kb = r / 32, nb = r % 32;
        transpose_item(F.kin[which ? 17 : 15] + (size_t)l * D * D, D, D, (bf16*)(F.ws + (which ? WS_WO : WS_WR)) + (size_t)l * D * D, kb * 64, nb * 32, nb * 32, scr, F.lane);
    }
    __syncthreads();
    LAS float* T4 = (LAS float*)(F.lds + 65536);
    for (int o = F.tid; o < 4096; o += NTHR) T4[o] = cospif((float)o * (2.0f / 4096.0f));
    __syncthreads();
    for (int o = F.bid * NTHR + F.tid; o < 2 * D * D; o += F.G * NTHR) {
        const int l = o >> 20, rem = o & (D * D - 1), kk = rem >> 10, n = rem & 1023;
        const int ch = kk & 511, g = ch >> 7, cc = ch & 127; const bool sn = kk >= 512;
        const float* wf = F.kin[16] + (size_t)l * 512 * D + (size_t)(g * 128) * D + n; float s = 0.f;
#pragma unroll 8
        for (int m = 0; m < 128; ++m) { const int ph = (cc * m) & 127;
            s += T4[(32 * ph + (sn ? 1024 : 0)) & 4095] * wf[(size_t)m * D]; }
        ((bf16*)(F.ws + WS_WF))[(size_t)l * D * D + (size_t)n * D + kk] = (bf16)f2bf(s);
    }
    { const float scl = 1.0f / sqrtf(4096.f * 128.f), scc = 1.0f / sqrtf(256.f * 128.f);
      bf16* fa = (bf16*)(F.ws + WS_CSC + 256 * 1024); bf16* fc = (bf16*)(F.ws + WS_CSC + 512 * 1024);
      for (int o = F.bid * NTHR + F.tid; o < 256 * 128; o += F.G * NTHR) {
          const int m = o >> 7, k = o & 127, ri = m >> 7, cqm = (m >> 6) & 1, k1 = m & 63, cqk = k >> 6, t1 = k & 63;
          const float v = cqm == cqk ? T4[(64 * ((k1 * t1) & 63) + (ri ? 1024 : 0)) & 4095] : 0.f; fa[o] = (bf16)f2bf(v); }
      for (int o = F.bid * NTHR + F.tid; o < 256 * 256; o += F.G * NTHR) {
          const int m = o >> 8, k = o & 255, qm = m >> 7, ty = (m >> 6) & 1, k2 = m & 63, qk = k >> 7, ri = (k >> 6) & 1, t2 = k & 63;
          const int sh = ty == 0 ? (ri == 0 ? 0 : 3072) : (ri == 0 ? 3072 : 2048);
          const float v = qm == qk ? T4[(64 * ((k2 * t2) & 63) + sh) & 4095] * scl : 0.f; fc[o] = (bf16)f2bf(v); }
      for (int o = F.bid * NTHR + F.tid; o < 512 * 32; o += F.G * NTHR) {
          const int r = o >> 5, t0 = (o & 31) * 8, rr = r & 255, sh = r < 256 ? 0 : 3072; float v[8];
#pragma unroll
          for (int j = 0; j < 8; ++j) v[j] = T4[(16 * ((rr * (t0 + j)) & 255) + sh) & 4095] * scc;
          *(GAS v4u*)((bf16*)(F.ws + WS_CSC) + (size_t)r * 256 + t0) = pack8(v); } }
    for (int o = F.bid * NTHR + F.tid; o < 2 * 2 * 1024; o += F.G * NTHR) { const float lam = F.kin[14][o]; const float sp = (-lam > 20.f) ? -lam : log1pf(__expf(-lam));
        ((float*)(F.ws + WS_MODS + 512 * 1024))[o] = -8.0f * sp; }
    __syncthreads();
    { LAS float* sc = (LAS float*)(F.lds + 131072 - 9 * 1024 * 4);
      LAS float* red = (LAS float*)F.lds;
      for (int o = F.tid; o < 9 * 1024; o += NTHR) { const float cv = o < 8192 ? F.kin[1][o] : F.kin[3][o - 8192]; sc[o] = siluf_(cv); }
      __syncthreads();
      for (int it = F.bid; it < 2 * (NMOD * D / 64); it += F.G) {
          const int l = it / (NMOD * D / 64), n = (it % (NMOD * D / 64)) * 64 + F.lane; const float* w = F.kin[4] + (size_t)l * D * NMOD * D + n; float acc[9];
#pragma unroll
          for (int q = 0; q < 9; ++q) acc[q] = 0.f;
#pragma unroll 16
          for (int k = F.wave * 128; k < F.wave * 128 + 128; ++k) { const float wv = w[(size_t)k * NMOD * D];
#pragma unroll
              for (int q = 0; q < 9; ++q) acc[q] += sc[q * 1024 + k] * wv; }
#pragma unroll
          for (int q = 0; q < 9; ++q) red[(F.wave * 9 + q) * 64 + F.lane] = acc[q];
          __syncthreads();
          for (int o = F.tid; o < 9 * 64; o += NTHR) { const int q = o >> 6, ln = o & 63; float s = 0.f;
#pragma unroll
              for (int wv = 0; wv < 8; ++wv) s += red[(wv * 9 + q) * 64 + ln];
              const int nn = (it % (NMOD * D / 64)) * 64 + ln;
              ((float*)(F.ws + WS_MODS))[((size_t)(l * 9 + q)) * NMOD * D + nn] = s + F.kin[5][(size_t)l * NMOD * D + nn]; }
          __syncthreads();
      } }
}

template <int MODE> __device__ __forceinline__ void p_rows(Frame& F, int l, int dummy = 0) {
    const int NR = (MODE == 2 || (MODE == 1 && l == 1)) ? NL : NT;
    const bool comb = (MODE == 0 && l == 1) || MODE == 2;
    const int lane = F.lane;
    LAS float* RW = (LAS float*)F.lds;
    LAS int* lcnt = (LAS int*)(F.lds + 65536);
    LAS int* rinfo = lcnt + 64;
    const int rpb = (NR + F.G - 1) / F.G, r0 = F.bid * rpb, r1 = (r0 + rpb < NR) ? r0 + rpb : NR;
    const int rpw = (rpb + NWAVES - 1) / NWAVES, w0 = r0 + F.wave * rpw, w1 = (w0 + rpw < r1) ? w0 + rpw : r1;
    if (MODE == 1) {
#pragma unroll
        for (int i = 0; i < 8; ++i) { const int f = F.tid + NTHR * i, k = f >> 2, e4 = f & 3; const f32x4 wv = *(const GAS f32x4*)(F.kin[19] + (size_t)f * 4);
            *(LAS f32x4*)(RW + ((((k >> 8) * 4 + (k & 3)) * 4 + e4) * 64 + ((k & 255) >> 2)) * 4) = wv; }
        if (F.tid < 32) lcnt[F.tid] = 0; __syncthreads(); }
    const float* gn = MODE == 0 ? F.kin[6] + (size_t)l * D : MODE == 1 ? F.kin[18] + (size_t)l * D : F.kin[24];
    bf16* hx = (bf16*)(F.ws + WS_RA); const bf16* c01 = (const bf16*)(F.ws + WS_C01);
    const float* xin_l = (MODE == 0 && l == 0) ? F.kin[0] : F.out; const float* xin_c = (MODE == 0 && l == 0) ? F.kin[2] : (const float*)(F.ws + WS_HCTX);
    float cA[16], cB[16], g2v[16]; int cur_mb = -1;
#pragma unroll
    for (int q = 0; q < 16; ++q) { cA[q] = 0.f; cB[q] = 0.f; g2v[q] = 0.f; }
    f32x4 nv[4]; v2u nc0[4], nc1[4];
#pragma unroll
    for (int j = 0; j < 4; ++j) { nv[j] = (f32x4){0.f, 0.f, 0.f, 0.f}; nc0[j] = (v2u){0u, 0u}; nc1[j] = (v2u){0u, 0u}; }
#define PR_LOAD(R) do { const int r_ = (R); const float* s_ = r_ < NL ? xin_l + (size_t)r_ * D : xin_c + (size_t)(r_ - NL) * D; \
        _Pragma("unroll") for (int j = 0; j < 4; ++j) { nv[j] = *(const GAS f32x4*)(s_ + lane * 4 + 256 * j); \
            if (comb) { nc0[j] = *(const GAS v2u*)(c01 + (size_t)r_ * D + lane * 4 + 256 * j); nc1[j] = *(const GAS v2u*)(c01 + ((size_t)NT + r_) * D + lane * 4 + 256 * j); } } } while (0)
    if (w0 < w1) PR_LOAD(w0);
    for (int r = w0; r < w1; ++r) {
        f32x4 v[4]; v2u c0[4], c1[4];
#pragma unroll
        for (int j = 0; j < 4; ++j) { v[j] = nv[j]; c0[j] = nc0[j]; c1[j] = nc1[j]; }
        if (r + 1 < w1) PR_LOAD(r + 1);
        const int mb = mb_of(r);
        if (mb != cur_mb) { cur_mb = mb;
            const float *sh = modp(F, l, mb, MODE == 1 ? 3 : 0), *sc = modp(F, l, mb, MODE == 1 ? 4 : 1), *g2 = modp(F, MODE == 2 ? 1 : 0, mb, 5);
#pragma unroll
            for (int j = 0; j < 4; ++j) { const int k = lane * 4 + 256 * j; const f32x4 g = *(const GAS f32x4*)(gn + k);
                if (MODE != 2) { const f32x4 s1 = *(const GAS f32x4*)(sc + k), s0 = *(const GAS f32x4*)(sh + k);
#pragma unroll
                    for (int q = 0; q < 4; ++q) { cA[4 * j + q] = g[q] * (1.f + s1[q]); cB[4 * j + q] = s0[q]; } }
                else {
#pragma unroll
                    for (int q = 0; q < 4; ++q) cA[4 * j + q] = g[q]; }
                if (comb) { const f32x4 gv = *(const GAS f32x4*)(g2 + k);
#pragma unroll
                    for (int q = 0; q < 4; ++q) g2v[4 * j + q] = gv[q]; } } }
        float* xrow = r < NL ? F.out + (size_t)r * D : (float*)(F.ws + WS_HCTX) + (size_t)(r - NL) * D;
        float ss = 0.f;
#pragma unroll
        for (int j = 0; j < 4; ++j) {
            if (comb) { v[j][0] += g2v[4 * j] * (bflo(c0[j].x) + bflo(c1[j].x)); v[j][1] += g2v[4 * j + 1] * (bfhi(c0[j].x) + bfhi(c1[j].x));
                        v[j][2] += g2v[4 * j + 2] * (bflo(c0[j].y) + bflo(c1[j].y)); v[j][3] += g2v[4 * j + 3] * (bfhi(c0[j].y) + bfhi(c1[j].y));
                        if (MODE == 0) *(GAS f32x4*)(xrow + lane * 4 + 256 * j) = v[j]; }
            ss += (v[j][0] * v[j][0] + v[j][1] * v[j][1]) + (v[j][2] * v[j][2] + v[j][3] * v[j][3]); }
        const float rstd = rsqrtf(wave_sum(ss, lane) * (1.f / D) + RMS_EPS);
        float lg[16];
#pragma unroll
        for (int e = 0; e < 16; ++e) lg[e] = 0.f;
#pragma unroll
        for (int j = 0; j < 4; ++j) { const int k = lane * 4 + 256 * j; float o[4];
#pragma unroll
            for (int q = 0; q < 4; ++q) { o[q] = v[j][q] * rstd * cA[4 * j + q] + cB[4 * j + q];
                if (MODE == 1) { const LAS f32x4* rw = (const LAS f32x4*)RW + ((j * 4 + q) * 4) * 64 + lane;
#pragma unroll
                    for (int e4 = 0; e4 < 4; ++e4) { const f32x4 w = rw[e4 * 64]; lg[4 * e4] += o[q] * w[0]; lg[4 * e4 + 1] += o[q] * w[1]; lg[4 * e4 + 2] += o[q] * w[2]; lg[4 * e4 + 3] += o[q] * w[3]; } } }
            if (MODE == 2) *(GAS f32x4*)(xrow + k) = (f32x4){o[0], o[1], o[2], o[3]};
            else { v2u w; w.x = pk2(o[0], o[1]); w.y = pk2(o[2], o[3]); *(GAS v2u*)(hx + (size_t)r * D + k) = w; } }
        if (MODE == 1) {
#define PR_BP(x, m) __builtin_bit_cast(float, __builtin_amdgcn_ds_bpermute((lane ^ (m)) << 2, __builtin_bit_cast(int, (x))))
            float t8[8], t4[4], t2[2]; const bool b3 = lane & 8, b2 = lane & 4, b1 = lane & 2, b0 = lane & 1;
#pragma unroll
            for (int i = 0; i < 8; ++i) { const float snd = b3 ? lg[i] : lg[i + 8]; t8[i] = (b3 ? lg[i + 8] : lg[i]) + PR_BP(snd, 8); }
#pragma unroll
            for (int i = 0; i < 4; ++i) { const float snd = b2 ? t8[i] : t8[i + 4]; t4[i] = (b2 ? t8[i + 4] : t8[i]) + PR_BP(snd, 4); }
#pragma unroll
            for (int i = 0; i < 2; ++i) { const float snd = b1 ? t4[i] : t4[i + 2]; t2[i] = (b1 ? t4[i + 2] : t4[i]) + PR_BP(snd, 2); }
            float val; { const float snd = b0 ? t2[0] : t2[1]; val = (b0 ? t2[1] : t2[0]) + PR_BP(snd, 1); }
            val += PR_BP(val, 16); val += PR_BP(val, 32);
#undef PR_BP
            float aff[16], sel[16];
#pragma unroll
            for (int e = 0; e < 16; ++e) { const float lgt = __builtin_bit_cast(float, __builtin_amdgcn_readlane(__builtin_bit_cast(int, val), e)); aff[e] = sigmoidf_(lgt); sel[e] = aff[e] + F.kin[20][e]; }
            int grp = 0; float best = -1e30f;
#pragma unroll
            for (int g = 0; g < 4; ++g) { const float a = sel[4 * g], b = sel[4 * g + 1], c = sel[4 * g + 2], dd = sel[4 * g + 3];
                const float s = fmaxf(fmaxf(fmaxf(a + b, a + c), fmaxf(a + dd, b + c)), fmaxf(b + dd, c + dd));
                if (s > best) { best = s; grp = g; } }
            float s4[4], a4[4];
#pragma unroll
            for (int q = 0; q < 4; ++q) { s4[q] = grp == 0 ? sel[q] : grp == 1 ? sel[4 + q] : grp == 2 ? sel[8 + q] : sel[12 + q]; a4[q] = grp == 0 ? aff[q] : grp == 1 ? aff[4 + q] : grp == 2 ? aff[8 + q] : aff[12 + q]; }
            int i0 = 0; float m0 = s4[0], af0 = a4[0];
#pragma unroll
            for (int q = 1; q < 4; ++q) if (s4[q] > m0) { m0 = s4[q]; i0 = q; af0 = a4[q]; }
            int i1 = -1; float m1 = -1e30f, af1 = 0.f;
#pragma unroll
            for (int q = 0; q < 4; ++q) if (q != i0 && s4[q] > m1) { m1 = s4[q]; i1 = q; af1 = a4[q]; }
            const int e0 = grp * 4 + i0, e1 = grp * 4 + i1; const float inv = 1.f / (af0 + af1);
            if (lane == 0) { const int lr0 = __hip_atomic_fetch_add(lcnt + e0, 1, __ATOMIC_RELAXED, __HIP_MEMORY_SCOPE_WORKGROUP), lr1 = __hip_atomic_fetch_add(lcnt + e1, 1, __ATOMIC_RELAXED, __HIP_MEMORY_SCOPE_WORKGROUP);
                LAS int* ri = rinfo + (r - r0) * 5; ri[0] = e0 | (e1 << 8); ri[1] = lr0; ri[2] = lr1; ri[3] = __builtin_bit_cast(int, af0 * inv); ri[4] = __builtin_bit_cast(int, af1 * inv); }
        }
    }
#undef PR_LOAD
    if (MODE == 1) {
        __syncthreads();
        if (F.tid < 16) lcnt[16 + F.tid] = (int)__hip_atomic_fetch_add(F.ctl + CW_CNT + 64 * l + 128 * dummy + F.tid, (unsigned)lcnt[F.tid], __ATOMIC_RELAXED, __HIP_MEMORY_SCOPE_AGENT);
        __syncthreads();
        int2* list = (int2*)(F.ws + (dummy ? WS_SUM : WS_LIST));
        for (int rl = F.tid; rl < r1 - r0; rl += NTHR) { const LAS int* ri = rinfo + rl * 5; const int e0 = ri[0] & 255, e1 = ri[0] >> 8, r = r0 + rl;
            list[(size_t)e0 * NT + lcnt[16 + e0] + ri[1]] = make_int2(r, ri[3]);
            list[(size_t)e1 * NT + lcnt[16 + e1] + ri[2]] = make_int2(r | (int)0x80000000, ri[4]); }
    }
}
__device__ __forceinline__ void p_transpose(Frame& F, int l) {
    const bf16* uf = (const bf16*)(F.ws + WS_RF); bf16* ut4 = (bf16*)(F.ws + WS_RG); bf16* utc = ut4 + (size_t)8 * 512 * 4096;
    LAS bf16* tile = (LAS bf16*)F.lds;
    for (int it = F.bid; it < 512; it += F.G) {
        const int b = it >> 6, t2b = (it >> 3) & 7, cb = it & 7;
        __syncthreads();
#pragma unroll
        for (int i = 0; i < 8; ++i) { const int p = F.tid + NTHR * i, rr = p >> 3, c8 = (p & 7) * 8, t1 = rr >> 3, t2l = rr & 7;
            const v4u w = *(const GAS v4u*)(uf + ((size_t)b * 4096 + 64 * t1 + 8 * t2b + t2l) * 512 + cb * 64 + c8);
            LAS unsigned* d = (LAS unsigned*)(tile + (t2l * 64 + t1) * 66 + c8); d[0] = w.x; d[1] = w.y; d[2] = w.z; d[3] = w.w; }
        __syncthreads();
#pragma unroll
        for (int i = 0; i < 8; ++i) { const int q = F.tid + NTHR * i, t1b = q & 7, cq = (q >> 3) & 1, cpl = (q >> 4) & 31, t2l = q >> 9; unsigned h[8];
#pragma unroll
            for (int j = 0; j < 8; ++j) h[j] = tile[(t2l * 64 + t1b * 8 + j) * 66 + 2 * cpl + cq];
            v4u o; o.x = h[0] | (h[1] << 16); o.y = h[2] | (h[3] << 16); o.z = h[4] | (h[5] << 16); o.w = h[6] | (h[7] << 16);
            *(GAS v4u*)(ut4 + ((((size_t)b * 256 + cb * 32 + cpl) * 64 + t2b * 8 + t2l) * 2 + cq) * 64 + t1b * 8) = o; }
    }
    if (l == 0) {
        LAS bf16* tl = (LAS bf16*)F.lds;
        for (int j = F.bid; j < 256; j += F.G) {
            const int b = j >> 5, tb = (j >> 3) & 3, cb = j & 7; const size_t rowbase = (size_t)NL + b * 256 + tb * 64; bf16* dst = utc + (size_t)b * 512 * 256;
            __syncthreads();
            { const int t = F.tid >> 3, c8 = (F.tid & 7) * 8; const v4u w = *(const GAS v4u*)(uf + (rowbase + t) * 512 + cb * 64 + c8);
              LAS unsigned* p = (LAS unsigned*)(tl + t * 72 + c8); p[0] = w.x; p[1] = w.y; p[2] = w.z; p[3] = w.w; }
            __syncthreads();
            { const int c = F.tid >> 3, t8 = (F.tid & 7) * 8; v4u o; unsigned h[8];
#pragma unroll
              for (int q = 0; q < 8; ++q) h[q] = tl[(t8 + q) * 72 + c];
              o.x = h[0] | (h[1] << 16); o.y = h[2] | (h[3] << 16); o.z = h[4] | (h[5] << 16); o.w = h[6] | (h[7] << 16);
              *(GAS v4u*)(dst + (size_t)(cb * 64 + c) * 256 + tb * 64 + t8) = o; }
        }
    }
    __syncthreads();
}
__device__ __forceinline__ void p_scan_simple(Frame& F, int l) {
    if (F.bid >= 128) return;
    const int b = F.bid >> 4, h = (F.bid >> 1) & 7, d = F.bid & 1;
    LAS float* U = (LAS float*)F.lds;
    LAS float* RAg = U + 64 * 128;
    LAS float* XIg = RAg + 64 * 128;
    const bf16* urnn = (const bf16*)(F.ws + WS_RB);
    bf16* hout = (bf16*)(F.ws + (d ? WS_RF : WS_RA));
    const float* cw = F.kin[8] + (size_t)l * 4 * D + h * 128; const float* cb = F.kin[9] + (size_t)l * D + h * 128;
    const float* Wa = F.kin[10] + ((size_t)(l * 2 + d) * 8 + h) * 128 * 128; const float* Wx = F.kin[12] + ((size_t)(l * 2 + d) * 8 + h) * 128 * 128;
    const float* ba = F.kin[11] + ((size_t)(l * 2 + d) * 8 + h) * 128; const float* bx = F.kin[13] + ((size_t)(l * 2 + d) * 8 + h) * 128;
    const float* n8 = (const float*)(F.ws + WS_MODS + 512 * 1024) + (size_t)(l * 2 + d) * 1024 + h * 128;
    const int ch = F.tid & 127, tq = F.tid >> 7;
    float hstate = 0.f;
    for (int step = 0; step < 68; ++step) {
        const int j = d == 0 ? step : (step < 4 ? 3 - step : 71 - step);
        const bool isctx = j < 4; const size_t row0 = isctx ? (size_t)NL + b * 256 + j * 64 : (size_t)b * 4096 + (size_t)(j - 4) * 64;
        __syncthreads();
        for (int o = F.tid; o < 64 * 128; o += NTHR) { const int t = o >> 7, c = o & 127; float s = cb[c];
#pragma unroll
            for (int k = 0; k < 4; ++k) { const int tt = t + k - 2; bool ok; if (isctx) { const int g = j * 64 + tt; ok = g >= 0 && g < 256; } else ok = tt >= 0 && tt < 64;
                if (ok) s += cw[(size_t)k * D + c] * bf2f(urnn[(row0 + tt) * D + h * 128 + c]); }
            U[o] = s; }
        __syncthreads();
        { float ar[16], ax[16];
#pragma unroll
          for (int q = 0; q < 16; ++q) { ar[q] = 0.f; ax[q] = 0.f; }
          for (int k = 0; k < 128; ++k) { const float wa = Wa[(size_t)k * 128 + ch], wx = Wx[(size_t)k * 128 + ch];
#pragma unroll
              for (int q = 0; q < 16; ++q) { const float uv = U[(tq * 16 + q) * 128 + k]; ar[q] += uv * wa; ax[q] += uv * wx; } }
          const float bav = ba[ch], bxv = bx[ch], n8v = n8[ch];
#pragma unroll
          for (int q = 0; q < 16; ++q) { const int t = tq * 16 + q; const float r = sigmoidf_(ar[q] + bav), ig = sigmoidf_(ax[q] + bxv);
              const float la = n8v * r, a = __expf(la), y2 = 2.f * la;
              const float om = (y2 > -0.02f) ? -(y2 * (1.f + y2 * (0.5f + y2 * (1.f / 6.f)))) : 1.f - __expf(y2);
              RAg[t * 128 + ch] = a; XIg[t * 128 + ch] = sqrtf(om) * ig * U[t * 128 + ch]; } }
        __syncthreads();
        if (F.tid < 128) {
            for (int q = 0; q < 64; ++q) { const int t = d == 0 ? q : 63 - q; hstate = RAg[t * 128 + ch] * hstate + XIg[t * 128 + ch]; RAg[t * 128 + ch] = hstate; } }
        __syncthreads();
        for (int o = F.tid; o < 64 * 16; o += NTHR) { const int t = o >> 4, c8 = (o & 15) * 8; float v[8];
#pragma unroll
            for (int q = 0; q < 8; ++q) v[q] = RAg[t * 128 + c8 + q];
            *(GAS v4u*)(hout + (row0 + t) * D + h * 128 + c8) = pack8(v); }
    }
}
constexpr int SC_XRAW = 0, SC_U32 = 17408, SC_UBF = SC_U32 + 32768, SC_YT = SC_UBF + 16384, SC_CW = SC_YT + 16384;
__device__ __forceinline__ float fast_sigmoid(float x) { return __builtin_amdgcn_rcpf(1.f + __expf(-x)); }
template <int PASS> __device__ __forceinline__ void p_scan_fast(Frame& F, int l) {
    LAS unsigned char* lds = F.lds;
    const int tid = F.tid, lane = F.lane, w = F.wave, fr = lane & 15, fq = lane >> 4;
    const bf16* urnn = (const bf16*)(F.ws + WS_RB); const bf16* gate = (const bf16*)(F.ws + WS_RC); bf16* yout = (bf16*)(F.ws + WS_RA);
    float* SUM = (float*)(F.ws + WS_SUM); const float* CIN = (const float*)(F.ws + WS_CIN);
    const int h = F.bid & 7, qi = F.bid >> 3, nq = (F.G - h + 7) >> 3;
    bf16x8 bw[4][4];
    float bia[4];
    const unsigned wloff = (unsigned)((8 * fq) * 128 + 16 * w + fr) * 4u;
#pragma unroll
    for (int ty = 0; ty < 4; ++ty) { const int d = ty >> 1; const char* Wh = (const char*)(F.kin[(ty & 1) ? 12 : 10] + ((size_t)(l * 2 + d) * 8 + h) * 128 * 128);
#pragma unroll
        for (int ks = 0; ks < 4; ++ks) { float t8[8];
#pragma unroll
            for (int q = 0; q < 8; ++q) t8[q] = *(const GAS float*)(Wh + (size_t)(32 * ks + q) * 512 + wloff);
            const v4u pk = pack8(t8); bw[ty][ks] = __builtin_bit_cast(bf16x8, pk); }
        bia[ty] = F.kin[(ty & 1) ? 13 : 11][((size_t)(l * 2 + d) * 8 + h) * 128 + 16 * w + fr]; }
    const float n8f = ((const float*)(F.ws + WS_MODS + 512 * 1024))[(size_t)(l * 2 + 0) * 1024 + h * 128 + 16 * w + fr];
    const float n8b = ((const float*)(F.ws + WS_MODS + 512 * 1024))[(size_t)(l * 2 + 1) * 1024 + h * 128 + 16 * w + fr];
    { LAS float* CW = (LAS float*)(lds + SC_CW);
      for (int o = tid; o < 5 * 128; o += NTHR) CW[o] = o < 512 ? F.kin[8][(size_t)l * 4 * D + (size_t)(o >> 7) * D + h * 128 + (o & 127)] : F.kin[9][(size_t)l * D + h * 128 + (o & 127)]; }
    v4u raw[3];
#define SC_LOAD_RAW(PI) do { const int b_ = skipctx ? ((PI) >> 6) : (PI) / 68, j_ = skipctx ? 4 + ((PI) & 63) : (PI) % 68; const bool ic_ = j_ < 4; const size_t r0_ = ic_ ? (size_t)NL + b_ * 256 + j_ * 64 : (size_t)b_ * 4096 + (size_t)(j_ - 4) * 64; \
        _Pragma("unroll") for (int q3 = 0; q3 < 3; ++q3) { const int p_ = tid + q3 * 512, rr_ = p_ >> 4, c16_ = p_ & 15, tt_ = rr_ - 2; bool ok_ = p_ < 68 * 16; \
            if (ic_) { const int g_ = j_ * 64 + tt_; ok_ = ok_ && g_ >= 0 && g_ < 256; } else ok_ = ok_ && tt_ >= 0 && tt_ < 64; \
            const v4u v_ = *(const GAS v4u*)(urnn + (r0_ + (ok_ ? tt_ : 0)) * D + h * 128 + c16_ * 8);     \
            raw[q3].x = ok_ ? v_.x : 0u; raw[q3].y = ok_ ? v_.y : 0u; raw[q3].z = ok_ ? v_.z : 0u; raw[q3].w = ok_ ? v_.w : 0u; } } while (0)
    const bool skipctx = PASS == 2 && l == 1;
    const int npair = skipctx ? 512 : 544;
    if (qi < npair) SC_LOAD_RAW(qi);
    for (int pi = qi; pi < npair; pi += nq) {
        const int b = skipctx ? (pi >> 6) : pi / 68, j = skipctx ? 4 + (pi & 63) : pi % 68;
        const bool isctx = j < 4; const size_t row0 = isctx ? (size_t)NL + b * 256 + j * 64 : (size_t)b * 4096 + (size_t)(j - 4) * 64;
        __syncthreads();
#pragma unroll
        for (int q3 = 0; q3 < 3; ++q3) { const int p = tid + q3 * 512; if (p < 68 * 16) *(LAS v4u*)(lds + SC_XRAW + (p >> 4) * 256 + (p & 15) * 16) = raw[q3]; }
        __syncthreads();
        if (pi + nq < npair) SC_LOAD_RAW(pi + nq);
        v4u gt0 = (v4u){0u, 0u, 0u, 0u}, gt1 = gt0; float cinf = 0.f, cinb = 0.f;
        if (PASS == 2) { const bf16* gp = gate + (row0 + (tid >> 3)) * D + h * 128 + (tid & 7) * 16; gt0 = *(const GAS v4u*)gp; gt1 = *(const GAS v4u*)(gp + 8);
            cinf = CIN[(((size_t)b * 2 + 0) * 68 + j) * 1024 + h * 128 + 16 * w + fr]; cinb = CIN[(((size_t)b * 2 + 1) * 68 + j) * 1024 + h * 128 + 16 * w + fr]; }
        { const int t = tid >> 3, cg = tid & 7; const LAS float* CW = (const LAS float*)(lds + SC_CW); float u[16];
#pragma unroll
          for (int q = 0; q < 16; ++q) u[q] = CW[512 + cg * 16 + q];
#pragma unroll
          for (int k = 0; k < 4; ++k) { float x[16]; unpack8(*(const LAS v4u*)(lds + SC_XRAW + (t + k) * 256 + cg * 32), x); unpack8(*(const LAS v4u*)(lds + SC_XRAW + (t + k) * 256 + cg * 32 + 16), x + 8);
#pragma unroll
              for (int q = 0; q < 16; ++q) u[q] += CW[k * 128 + cg * 16 + q] * x[q]; }
#pragma unroll
          for (int q = 0; q < 4; ++q) *(LAS f32x4*)(lds + SC_U32 + t * 512 + cg * 64 + q * 16) = (f32x4){u[4 * q], u[4 * q + 1], u[4 * q + 2], u[4 * q + 3]};
          const int ft = (t & 3) | (((t >> 4) & 3) << 2);
          *(LAS v4u*)(lds + SC_UBF + t * 256 + (((cg * 2) ^ ft) << 4)) = pack8(u); *(LAS v4u*)(lds + SC_UBF + t * 256 + (((cg * 2 + 1) ^ ft) << 4)) = pack8(u + 8); }
        __syncthreads();
        const int c = 16 * w + fr;
        float hs[16];
#pragma unroll
        for (int d = 0; d < 2; ++d) {
            f32x4 acc[2][4];
#pragma unroll
            for (int ty = 0; ty < 2; ++ty)
#pragma unroll
                for (int m = 0; m < 4; ++m) acc[ty][m] = (f32x4){0.f, 0.f, 0.f, 0.f};
#pragma unroll
            for (int m = 0; m < 4; ++m) { const int tau = 16 * (fr >> 2) + 4 * m + (fr & 3);
#pragma unroll
                for (int ks = 0; ks < 4; ++ks) { const bf16x8 af = *(const LAS bf16x8*)(lds + SC_UBF + tau * 256 + (((4 * ks + fq) ^ fr) << 4));
                    acc[0][m] = __builtin_amdgcn_mfma_f32_16x16x32_bf16(af, bw[2 * d][ks], acc[0][m], 0, 0, 0); acc[1][m] = __builtin_amdgcn_mfma_f32_16x16x32_bf16(af, bw[2 * d + 1][ks], acc[1][m], 0, 0, 0); } }
            float av[16], bv[16]; const float n8 = d ? n8b : n8f, b_a = bia[2 * d], b_x = bia[2 * d + 1];
#pragma unroll
            for (int q = 0; q < 16; ++q) { const float r = fast_sigmoid(acc[0][q >> 2][q & 3] + b_a), ig = fast_sigmoid(acc[1][q >> 2][q & 3] + b_x);
                const float la = n8 * r, a = __expf(la), y2 = 2.f * la;
                const float ser = -(y2 * (1.f + y2 * (0.5f + y2 * (1.f / 6.f)))), dif = 1.f - a * a;
                const float om = (y2 > -0.02f) ? ser : dif;
                av[q] = a; bv[q] = __builtin_amdgcn_sqrtf(om) * ig * *(const LAS float*)(lds + SC_U32 + (16 * fq + q) * 512 + c * 4);
                if ((q & 3) == 3) __builtin_amdgcn_sched_barrier(0); }
            float P = 1.f, H = 0.f;
#pragma unroll
            for (int q = 0; q < 16; ++q) { const int t = d ? 15 - q : q; H = av[t] * H + bv[t]; P *= av[t]; }
            float Ps[4], Hs[4];
#pragma unroll
            for (int sgi = 0; sgi < 4; ++sgi) { Ps[sgi] = __builtin_bit_cast(float, __builtin_amdgcn_ds_bpermute(((sgi << 4) | fr) << 2, __builtin_bit_cast(int, P)));
                                              Hs[sgi] = __builtin_bit_cast(float, __builtin_amdgcn_ds_bpermute(((sgi << 4) | fr) << 2, __builtin_bit_cast(int, H))); }
            if (PASS == 1) {
                float Pt = 1.f, Ht = 0.f;
#pragma unroll
                for (int q = 0; q < 4; ++q) { const int sgi = d ? 3 - q : q; Ht = Ps[sgi] * Ht + Hs[sgi]; Pt *= Ps[sgi]; }
                if (fq == 0) { float* dst = SUM + ((((size_t)b * 2 + d) * 68 + j) * 2) * 1024 + h * 128 + c; dst[0] = Pt; dst[1024] = Ht; }
            } else {
                float cin = d ? cinb : cinf;
#pragma unroll
                for (int q = 0; q < 3; ++q) { const int sgi = d ? 3 - q : q; const bool before = d ? (sgi > fq) : (sgi < fq); if (before) cin = Ps[sgi] * cin + Hs[sgi]; }
                float hh = cin;
#pragma unroll
                for (int q = 0; q < 16; ++q) { const int t = d ? 15 - q : q; hh = av[t] * hh + bv[t]; if (d == 0) hs[t] = hh; else hs[t] += hh; }
            }
        }
        if (PASS == 2) {
#pragma unroll
            for (int q = 0; q < 16; ++q) *(LAS bf16*)(lds + SC_YT + (16 * fq + q) * 256 + c * 2) = (bf16)f2bf(hs[q]);
            __syncthreads();
            { const int t = tid >> 3, cg = tid & 7; float yv[16], gv[16];
              unpack8(*(const LAS v4u*)(lds + SC_YT + t * 256 + cg * 32), yv); unpack8(*(const LAS v4u*)(lds + SC_YT + t * 256 + cg * 32 + 16), yv + 8);
              unpack8(gt0, gv); unpack8(gt1, gv + 8);
#pragma unroll
              for (int q = 0; q < 16; ++q) yv[q] *= gv[q];
              bf16* yp = yout + (row0 + t) * D + h * 128 + cg * 16; *(GAS v4u*)yp = pack8(yv); *(GAS v4u*)(yp + 8) = pack8(yv + 8); }
        }
    }
#undef SC_LOAD_RAW
    __syncthreads();
}
__device__ __forceinline__ void p_scan_carry(Frame& F) {
    const float* SUM = (const float*)(F.ws + WS_SUM); float* CIN = (float*)(F.ws + WS_CIN);
    for (int g = F.bid * NTHR + F.tid; g < 8 * 2 * 1024; g += F.G * NTHR) {
        const int b = g >> 11, d = (g >> 10) & 1, ch = g & 1023; float cst = 0.f;
        const float* sp = SUM + (((size_t)b * 2 + d) * 68) * 2 * 1024 + ch; float* cp = CIN + (((size_t)b * 2 + d) * 68) * 1024 + ch;
#pragma unroll 4
        for (int step = 0; step < 68; ++step) { const int j = d == 0 ? step : (step < 4 ? 3 - step : 71 - step);
            const float P = sp[(size_t)j * 2048], H = sp[(size_t)j * 2048 + 1024]; cp[(size_t)j * 1024] = cst; cst = P * cst + H; }
    }
}

__device__ __forceinline__ void p_ycombine(Frame& F) {
    bf16* hf = (bf16*)(F.ws + WS_RA); const bf16* hb = (const bf16*)(F.ws + WS_RF); const bf16* gt = (const bf16*)(F.ws + WS_RC);
    for (size_t o = ((size_t)F.bid * NTHR + F.tid) * 8; o < (size_t)NT * D; o += (size_t)F.G * NTHR * 8) {
        float a[8], b[8], g[8]; unpack8(*(const GAS v4u*)(hf + o), a); unpack8(*(const GAS v4u*)(hb + o), b); unpack8(*(const GAS v4u*)(gt + o), g);
#pragma unroll
        for (int j = 0; j < 8; ++j) a[j] = (a[j] + b[j]) * g[j];
        *(GAS v4u*)(hf + o) = pack8(a); }
}
__device__ __forceinline__ void p_moe_wconv(Frame& F, int l) {
    __syncthreads();
    { const int gw = F.bid * NWAVES + F.wave, NGW = F.G * NWAVES; LAS float* scr = (LAS float*)(F.lds + F.wave * 16384);
      bf16* mw = (bf16*)(F.ws + WS_MOEW);
      for (int it = gw; it < 16 * 3 * 512; it += NGW) { const int e = it / 1536, rem = it % 1536, m = rem / 512, q = rem % 512, kb = q >> 5, nb = q & 31;
          const float* W = F.kin[m == 0 ? 21 : m == 1 ? 22 : 23] + ((size_t)l * 16 + e) * D * D; bf16* dst = mw + (size_t)e * 3 * D * D + (m == 2 ? (size_t)2 * D * D : 0);
          const int n0 = nb * 32; const int drow = m == 2 ? n0 : ((n0 >> 7) * 256 + (m == 1 ? 128 : 0) + (n0 & 127));
          transpose_item(W, D, D, dst, kb * 64, n0, drow, scr, F.lane); } }
}
__device__ __forceinline__ void moe_table(Frame& F, int l, LAS int* ts, LAS int* cn) {
    __syncthreads();
    if (F.tid == 0) { int acc = 0;
        for (int e = 0; e < 16; ++e) { const int c = (int)__hip_atomic_load(F.ctl + CW_CNT + 64 * l + e, __ATOMIC_RELAXED, __HIP_MEMORY_SCOPE_AGENT); cn[e] = c; ts[e] = acc; acc += (c + 255) >> 8; }
        ts[16] = acc; }
    __syncthreads();
}

constexpr int NPH = 24;
struct Args { const float* in[25]; float* out; unsigned char* ws; int ph_lo, ph_hi; };
__global__ void __launch_bounds__(NTHR, 2) fwd_kernel(Args args) {
    extern __shared__ __attribute__((aligned(16))) unsigned char lds[];
    Frame F;
    F.lds = (LAS unsigned char*)lds; F.tid = threadIdx.x; F.lane = F.tid & 63; F.wave = __builtin_amdgcn_readfirstlane(F.tid >> 6);
    F.G = gridDim.x; F.bid = blockIdx.x; F.ws = args.ws; F.out = args.out; F.ctl = (unsigned*)(args.ws + WS_CTL);
    F.kin = (const float* const __attribute__((address_space(4)))*)__builtin_amdgcn_kernarg_segment_ptr();
    volatile LAS unsigned* MISC = (volatile LAS unsigned*)(F.lds + MISC_OFF);
    if (F.tid < 32) MISC[F.tid] = 0u;
    __syncthreads();
    XcdBarrier bar; bar.bar = F.ctl + CW_BAR; bar.x = 0; bar.st = nullptr;
    if (MK_N_LAUNCHES == 1) bar = xcd_barrier_post(F.ctl + CW_BAR, MISC + 8);
    LAS int* ts = (LAS int*)(F.lds + MISC_OFF + 256); LAS int* cn = ts + 32;
    const int lo = args.ph_lo, hi = args.ph_hi;
#ifndef SITE_MASK
#define SITE_MASK 0xfffffu
#endif
#define SITE(j) (((SITE_MASK) >> (j)) & 1u)
#ifndef REP_MASK
#define REP_MASK 0u
#endif
#define IN(k) (lo <= (k) && (k) < hi)
#define LAUNDER() do { asm volatile("v_mbcnt_lo_u32_b32 %0, -1, 0\n\tv_mbcnt_hi_u32_b32 %0, -1, %0" : "=v"(F.lane)); asm volatile("" : "+s"(F.ws), "+s"(F.out), "+s"(F.kin), "+s"(F.ctl), "+s"(F.lds), "+s"(F.wave), "+s"(F.bid), "+s"(F.G), "+v"(F.lane)); F.tid = F.wave * 64 + F.lane; } while (0)
#define TWICE(j, stmt) do { stmt; if (((REP_MASK) >> (j)) & 1u) { __syncthreads(); LAUNDER(); stmt; } } while (0)
#define SEAM(k) do { if (MK_N_LAUNCHES == 1 && IN((k) + 1)) xcd_barrier(bar); } while (0)

    if (SITE(0) && IN(0)) { LAUNDER(); TWICE(0, p_prologue(F)); SEAM(0); }
    for (int l = 0; l < 2; ++l) {
        const int pb = 1 + 11 * l;
        if (SITE(1) && IN(pb + 0)) { LAUNDER(); p_rows<0>(F, l); if (((REP_MASK >> 1) & 1u) && l == 0) { __syncthreads(); LAUNDER(); p_rows<0>(F, 0); } SEAM(pb + 0); }
        if (SITE(2) && IN(pb + 1)) { LAUNDER();
            PInproj p; p.G = F.G; p.c = F.bid; p.l = l; p.hx = (const bf16*)(F.ws + WS_RA); p.wt = (const bf16*)(F.ws + WS_WIN) + (size_t)l * INW * D;
            p.urnn = (bf16*)(F.ws + WS_RB); p.gate = (bf16*)(F.ws + WS_RC); p.ufour = (bf16*)(F.ws + WS_RF); p.sgr = (bf16*)(F.ws + WS_RD); p.sgf = (bf16*)(F.ws + WS_RE);
            TWICE(2, fast_gemm_phase(F, p)); SEAM(pb + 1); }
        if (SITE(3) && IN(pb + 2)) { LAUNDER(); TWICE(3, p_scan_fast<1>(F, l); p_transpose(F, l)); SEAM(pb + 2); }
        if (SITE(4) && IN(pb + 3)) { LAUNDER(); TWICE(4, p_scan_carry(F)); LAUNDER();
            PFftA p; p.G = F.G; p.c = F.bid; p.fa = (const bf16*)(F.ws + WS_CSC + 256 * 1024); p.ut4 = (const bf16*)(F.ws + WS_RG); p.zt = (bf16*)(F.ws + WS_CSL);
            fast_gemm_phase(F, p); SEAM(pb + 3); }
        if (SITE(5) && IN(pb + 4)) { LAUNDER();
            { PFftC p; p.G = F.G; p.c = F.bid; p.fc = (const bf16*)(F.ws + WS_CSC + 512 * 1024); p.zt = (const bf16*)(F.ws + WS_CSL); p.g = (bf16*)(F.ws + WS_RH);
              TWICE(5, fast_gemm_phase(F, p)); }
            if (l == 0) { LAUNDER();
              PDft p; p.G = F.G; p.c = F.bid; p.csc = (const bf16*)(F.ws + WS_CSC); p.ut = (const bf16*)(F.ws + WS_RG) + (size_t)8 * 512 * 4096; p.g = (bf16*)(F.ws + WS_RH);
              fast_gemm_phase(F, p); }
            SEAM(pb + 4); }
        if (SITE(6) && IN(pb + 5)) { LAUNDER(); TWICE(6, p_scan_fast<2>(F, l)); SEAM(pb + 5); }
        if (SITE(7) && IN(pb + 6)) { LAUNDER();
            PMerge p; p.G = F.G; p.c = F.bid; p.npan = l == 1 ? NL / 256 : NPAN;     p.gm = (const bf16*)(F.ws + WS_RH); p.y = (const bf16*)(F.ws + WS_RA); p.wf = (const bf16*)(F.ws + WS_WF) + (size_t)l * D * D; p.wr = (const bf16*)(F.ws + WS_WR) + (size_t)l * D * D;
            p.sgr = (const bf16*)(F.ws + WS_RD); p.sgf = (const bf16*)(F.ws + WS_RE); p.t1 = (bf16*)(F.ws + WS_RB); p.mg = (bf16*)(F.ws + WS_RC);
            TWICE(7, fast_gemm_phase(F, p)); SEAM(pb + 6); }
        if (SITE(8) && IN(pb + 7)) { LAUNDER();
            PWout p; p.G = F.G; p.c = F.bid; p.npan = l == 1 ? NL / 256 : NPAN; p.mg = (const bf16*)(F.ws + WS_RC); p.wo = (const bf16*)(F.ws + WS_WO) + (size_t)l * D * D;
            p.xold_l = l == 0 ? F.kin[0] : F.out; p.xold_c = l == 0 ? F.kin[2] : (const float*)(F.ws + WS_HCTX); p.xnew_l = F.out; p.xnew_c = (float*)(F.ws + WS_HCTX); p.g1 = modp(F, l, 0, 2);
            TWICE(8, fast_gemm_phase(F, p)); SEAM(pb + 7); }
        if (SITE(9) && IN(pb + 8)) { LAUNDER(); p_rows<1>(F, l); if ((REP_MASK >> 13) & 1u) { __syncthreads(); LAUNDER(); p_rows<1>(F, l, 1); } TWICE(9, p_moe_wconv(F, l)); SEAM(pb + 8); }
        if (SITE(10) && IN(pb + 9)) { LAUNDER();
            moe_table(F, l, ts, cn);
            PMoe1 p; p.G = F.G; p.c = F.bid; p.hx2 = (const bf16*)(F.ws + WS_RA); p.w = (const bf16*)(F.ws + WS_MOEW); p.list = (const int2*)(F.ws + WS_LIST); p.he = (bf16*)(F.ws + WS_HE); p.ts = ts; p.cn = cn;
            TWICE(10, fast_gemm_phase(F, p)); SEAM(pb + 9); }
        if (SITE(11) && IN(pb + 10)) { LAUNDER();
            moe_table(F, l, ts, cn);
            PMoe2 p; p.G = F.G; p.c = F.bid; p.he = (const bf16*)(F.ws + WS_HE); p.w = (const bf16*)(F.ws + WS_MOEW); p.list = (const int2*)(F.ws + WS_LIST); p.c01 = (bf16*)(F.ws + WS_C01); p.ts = ts; p.cn = cn;
            TWICE(11, fast_gemm_phase(F, p)); SEAM(pb + 10); }
    }
    if (SITE(12) && IN(23)) { LAUNDER(); p_rows<2>(F, 1); }
#undef IN
#undef SEAM
}

extern "C" void kernel_launch(void* const* d_in, const int* in_sizes, int n_in, void* d_out, int out_size, void* d_ws, size_t ws_size, hipStream_t stream) {
    static int grid = 0;
    if (grid == 0) {
        if (n_in != 25 || out_size != NL * D || ws_size < WS_END2) { fprintf(stderr, "kernel_launch: unexpected shapes (n_in %d, out %d, ws %zu)\n", n_in, out_size, ws_size); grid = -1; return; }
        int dev = 0, cus = 0, per_cu = 0;
        if (hipGetDevice(&dev) != hipSuccess || hipDeviceGetAttribute(&cus, hipDeviceAttributeMultiprocessorCount, dev) != hipSuccess) { grid = -1; return; }
        if (hipFuncSetAttribute((const void*)fwd_kernel, hipFuncAttributeMaxDynamicSharedMemorySize, LDS_BYTES) != hipSuccess) { fprintf(stderr, "kernel_launch: hipFuncSetAttribute failed\n"); grid = -1; return; }
        if (hipOccupancyMaxActiveBlocksPerMultiprocessor(&per_cu, (const void*)fwd_kernel, NTHR, LDS_BYTES) != hipSuccess || per_cu < 1) { fprintf(stderr, "kernel_launch: occupancy query says %d\n", per_cu); }
        (void)hipGetLastError();
        grid = cus;
    }
    if (grid < 0) return;
    (void)hipMemsetAsync((char*)d_ws + WS_CTL, 0, CTL_ZERO_BYTES, stream);
    Args a{};
    for (int i = 0; i < 25; ++i) a.in[i] = (const float*)d_in[i];
    a.out = (float*)d_out; a.ws = (unsigned char*)d_ws;
    if (MK_N_LAUNCHES == 1) { a.ph_lo = 0; a.ph_hi = NPH; hipLaunchKernelGGL(fwd_kernel, dim3(grid), dim3(NTHR), LDS_BYTES, stream, a); }
    else for (int p = 0; p < NPH; ++p) { a.ph_lo = p; a.ph_hi = p + 1; hipLaunchKernelGGL(fwd_kernel, dim3(grid), dim3(NTHR), LDS_BYTES, stream, a); }
}
```

```cpp
#include <hip/hip_runtime.h>
#include <cstdio>
#include <cstdint>

#ifndef SC_CONV_BATCH
#define SC_CONV_BATCH 1
#endif
#ifndef REP6_DIAG
#define REP6_DIAG 0
#endif
#ifndef MK_N_LAUNCHES
#define MK_N_LAUNCHES 1
#endif

#define GAS __attribute__((address_space(1)))
#define LAS __attribute__((address_space(3)))
typedef unsigned short bf16;
typedef unsigned v4u __attribute__((ext_vector_type(4)));
typedef unsigned v2u __attribute__((ext_vector_type(2)));
typedef float f32x4 __attribute__((ext_vector_type(4)));
typedef short bf16x8 __attribute__((ext_vector_type(8)));

constexpr int D = 1024, NB = 8, SEQ = 4096, CTX = 256, NL = NB * SEQ, NC = NB * CTX, NT = NL + NC;
constexpr int NPAN = NT / 256;
constexpr int INW = 4608, NE = 16, NMOD = 6;
constexpr float RMS_EPS = 1e-6f;
constexpr int NWAVES = 8, NTHR = 512;

constexpr size_t MiB = 1u << 20;
constexpr size_t WS_CTL = 0, CTL_ZERO_BYTES = 32768;
constexpr size_t WS_MODS = 1 * MiB;
constexpr size_t WS_WIN = 2 * MiB;
constexpr size_t WS_WR = 20 * MiB, WS_WF = 24 * MiB, WS_WO = 28 * MiB;
constexpr size_t WS_LRU = 32 * MiB;
constexpr size_t WS_CSC = 34 * MiB;
constexpr size_t WS_UTC = 35 * MiB;
constexpr size_t WS_LIST = 43 * MiB;
constexpr size_t WS_CSL = 48 * MiB;
constexpr size_t WS_RA = 112 * MiB;
constexpr size_t WS_RB = 180 * MiB;
constexpr size_t WS_RC = 248 * MiB;
constexpr size_t WS_RD = 316 * MiB;
constexpr size_t WS_RE = 384 * MiB;
constexpr size_t WS_RF = 452 * MiB;
constexpr size_t WS_RG = 486 * MiB;
constexpr size_t WS_RH = 452 * MiB;
constexpr size_t WS_XS = 520 * MiB;
constexpr size_t WS_END = 588 * MiB;
constexpr size_t WS_MOEW = 180 * MiB;
constexpr size_t WS_HE = 276 * MiB;
constexpr size_t WS_C01 = 384 * MiB;
constexpr size_t WS_SUM = 588 * MiB;
constexpr size_t WS_CIN = 597 * MiB;
constexpr size_t WS_END2 = 602 * MiB;
static_assert(WS_C01 + (size_t)2 * NT * D * 2 <= WS_XS && WS_XS + (size_t)NT * D * 2 <= WS_END, "map");
static_assert(WS_RA + (size_t)NT * D * 2 <= WS_RB && WS_RH + (size_t)NT * D * 2 <= WS_XS, "map");

constexpr int CW_TMO = 0;
constexpr int CW_CNT = 64;
constexpr int CW_BAR = 4096;

constexpr int LDS_BYTES = 147456;
constexpr int MISC_OFF = 131072 + 8192;

__device__ __forceinline__ unsigned f2bf(float f) { unsigned u = __builtin_bit_cast(unsigned, f); return (u + 0x7fffu + ((u >> 16) & 1u)) >> 16; }
__device__ __forceinline__ unsigned pk2(float lo, float hi) { return f2bf(lo) | (f2bf(hi) << 16); }
__device__ __forceinline__ float bflo(unsigned w) { return __builtin_bit_cast(float, w << 16); }
__device__ __forceinline__ float bfhi(unsigned w) { return __builtin_bit_cast(float, w & 0xffff0000u); }
__device__ __forceinline__ float bf2f(bf16 h) { return __builtin_bit_cast(float, ((unsigned)h) << 16); }
__device__ __forceinline__ v4u pack8(const float* v) { v4u o; o.x = pk2(v[0], v[1]); o.y = pk2(v[2], v[3]); o.z = pk2(v[4], v[5]); o.w = pk2(v[6], v[7]); return o; }
__device__ __forceinline__ void unpack8(v4u w, float* v) { v[0] = bflo(w.x); v[1] = bfhi(w.x); v[2] = bflo(w.y); v[3] = bfhi(w.y); v[4] = bflo(w.z); v[5] = bfhi(w.z); v[6] = bflo(w.w); v[7] = bfhi(w.w); }
__device__ __forceinline__ float sigmoidf_(float x) { return __builtin_amdgcn_rcpf(1.f + __expf(-x)); }
__device__ __forceinline__ float siluf_(float x) { return x * __builtin_amdgcn_rcpf(1.f + __expf(-x)); }
typedef float f32x2 __attribute__((ext_vector_type(2)));
__device__ __forceinline__ f32x2 sigmoid_pk(f32x2 x) {
    f32x2 t = x * (-1.4426950408889634f); t.x = fminf(t.x, 40.f); t.y = fminf(t.y, 40.f);
    const f32x2 d = (f32x2){__builtin_amdgcn_exp2f(t.x), __builtin_amdgcn_exp2f(t.y)} + 1.f;
    const float inv = __builtin_amdgcn_rcpf(d.x * d.y);
    return (f32x2){d.y * inv, d.x * inv};
}
__device__ __forceinline__ f32x2 gelu_pk(f32x2 x) { return x * sigmoid_pk(x * (x * x * (0.044715f * 1.5957691216057308f) + 1.5957691216057308f)); }
__device__ __forceinline__ f32x2 silu_pk(f32x2 x) { return x * sigmoid_pk(x); }
typedef int v8i __attribute__((ext_vector_type(8)));
typedef int v4i __attribute__((ext_vector_type(4)));
__device__ __forceinline__ float sat8(float x) { return __builtin_amdgcn_fmed3f(x, -448.f, 448.f); }
__device__ __forceinline__ unsigned pk4_fp8(float a, float b, float c, float d) { const int p = __builtin_amdgcn_cvt_pk_fp8_f32(sat8(a), sat8(b), 0, false); return (unsigned)__builtin_amdgcn_cvt_pk_fp8_f32(sat8(c), sat8(d), p, true); }
__device__ __forceinline__ v8i cat8(bf16x8 a, bf16x8 b) { return __builtin_shufflevector(__builtin_bit_cast(v4i, a), __builtin_bit_cast(v4i, b), 0, 1, 2, 3, 4, 5, 6, 7); }
constexpr float MOE_WS = 32.f, MOE_HS = 8.f, MOE_CS = 32.f;
__device__ __forceinline__ float gelu_tanh(float x) { const float u = 0.7978845608028654f * (x + 0.044715f * x * x * x); const float e = __expf(2.f * u); const float t = 1.f - 2.f * __builtin_amdgcn_rcpf(e + 1.f); return 0.5f * x * (1.f + t); }
__device__ __forceinline__ float wave_sum(float v, int  ) {
#define WS_DPP(x, ctrl) __builtin_bit_cast(float, __builtin_amdgcn_update_dpp(0, __builtin_bit_cast(int, (x)), (ctrl), 0xF, 0xF, true))
    v += WS_DPP(v, 0xB1); v += WS_DPP(v, 0x4E); v += WS_DPP(v, 0x141); v += WS_DPP(v, 0x140);
#undef WS_DPP
    const int vi = __builtin_bit_cast(int, v);
    return (__builtin_bit_cast(float, __builtin_amdgcn_readlane(vi, 0)) + __builtin_bit_cast(float, __builtin_amdgcn_readlane(vi, 16))) +
           (__builtin_bit_cast(float, __builtin_amdgcn_readlane(vi, 32)) + __builtin_bit_cast(float, __builtin_amdgcn_readlane(vi, 48)));
}
#define LDS_WAIT() asm volatile("s_waitcnt lgkmcnt(0)" ::: "memory")
#define VM_WAIT() asm volatile("s_waitcnt vmcnt(0)" ::: "memory")

#define XB_TMO      128
#define XB_XCNT(j)  (256  + 64 * (j))
#define XB_XSUB(j)  (1280 + 64 * (j))
#define XB_XGEN(j)  (2304 + 64 * (j))
#define XB_TOP      3328
#define XB_TOPGEN   3392
#define XCD_BAR_WORDS 3456
#define XB_SPIN_CAP (1u << 18)
__device__ __forceinline__ unsigned xb_ld(unsigned* p)              { return __hip_atomic_load(p, __ATOMIC_RELAXED, __HIP_MEMORY_SCOPE_AGENT); }
__device__ __forceinline__ unsigned xb_add(unsigned* p, unsigned v) { return __hip_atomic_fetch_add(p, v, __ATOMIC_RELAXED, __HIP_MEMORY_SCOPE_AGENT); }
__device__ __forceinline__ unsigned xb_xcc_id() { return (unsigned)__builtin_amdgcn_s_getreg((3 << 11) | 20) & 0xFu; }
#define XB_SPIN(cond, bar) do { unsigned _sp = 0; while (cond) { __builtin_amdgcn_s_sleep(1); \
    if ((++_sp & 255u) == 0u) { if (xb_ld(&(bar)[XB_TMO])) break; if (_sp > XB_SPIN_CAP) { atomicAdd(&(bar)[XB_TMO], 1u); break; } } } } while (0)
struct XcdBarrier { unsigned* bar; unsigned x; volatile LAS unsigned* st; };
__device__ __forceinline__ XcdBarrier xcd_barrier_post(unsigned* bar, volatile LAS unsigned* st) {
    XcdBarrier b; b.bar = bar; b.x = xb_xcc_id(); b.st = st;
    if (threadIdx.x == 0) (void)xb_add(&bar[XB_XCNT(b.x)], 1u);
    return b;
}
__device__ __forceinline__ void xcd_barrier_complete(unsigned* bar, unsigned x, unsigned& nloc, unsigned& nx) {
    const unsigned G = gridDim.x * gridDim.y * gridDim.z;
    unsigned sum, cnt, mine, sp = 0u;
    for (;;) {
        sum = 0u; cnt = 0u; mine = 0u;
#pragma unroll
        for (unsigned j = 0; j < 16; ++j) { const unsigned c = xb_ld(&bar[XB_XCNT(j)]); sum += c; cnt += (c > 0u) ? 1u : 0u; mine = (j == x) ? c : mine; }
        if (sum == G) break;
        __builtin_amdgcn_s_sleep(1);
        if ((++sp & 255u) == 0u) { if (xb_ld(&bar[XB_TMO])) break; if (sp > XB_SPIN_CAP) { atomicAdd(&bar[XB_TMO], 1u); break; } }
    }
    nloc = mine > 0u ? mine : 1u; nx = cnt > 0u ? cnt : 1u;
}
__device__ __forceinline__ void xcd_barrier(const XcdBarrier& b) {
    asm volatile("s_waitcnt vmcnt(0)" ::: "memory");
    __syncthreads();
    if (threadIdx.x == 0) {
        unsigned* bar = b.bar;
        __builtin_amdgcn_s_waitcnt(0);
        unsigned nloc = b.st[0], nx = b.st[1];
        if (nloc == 0u) { xcd_barrier_complete(bar, b.x, nloc, nx); b.st[0] = nloc; b.st[1] = nx; }
        const unsigned old = xb_add(&bar[XB_XSUB(b.x)], 1u);
        const unsigned gen = old / nloc;
        if (old + 1u == (gen + 1u) * nloc) {
            __builtin_amdgcn_fence(__ATOMIC_RELEASE, "agent");
            asm volatile("s_waitcnt vmcnt(0)" ::: "memory");
            const unsigned og = xb_add(&bar[XB_TOP], 1u);
            const unsigned tg = og / nx;
            if (og + 1u == (tg + 1u) * nx) xb_add(&bar[XB_TOPGEN], 1u);
            else XB_SPIN(xb_ld(&bar[XB_TOPGEN]) == tg, bar);
            __builtin_amdgcn_fence(__ATOMIC_ACQUIRE, "agent");
            xb_add(&bar[XB_XGEN(b.x)], 1u);
            asm volatile("s_waitcnt vmcnt(0)" ::: "memory");
        } else {
            XB_SPIN(xb_ld(&bar[XB_XGEN(b.x)]) == gen, bar);
            __builtin_amdgcn_fence(__ATOMIC_ACQUIRE, "agent");
            asm volatile("s_waitcnt vmcnt(0)" ::: "memory");
        }
    }
    __syncthreads();
}

struct Frame {
    LAS unsigned char* lds;
    int tid, lane, wave, G, bid;
    unsigned* ctl;
    const float* const __attribute__((address_space(4)))* kin;
    float* out;
    unsigned char* ws;
};
__device__ __forceinline__ const float* modp(const Frame& F, int l, int mb, int which) { return (const float*)(F.ws + WS_MODS) + ((size_t)(l * 9 + mb) * NMOD + which) * D; }
__device__ __forceinline__ int mb_of(int r) { return r < NL ? (r >> 12) : 8; }

struct Unit { const bf16* A; const bf16* B; int lda, ldb, K; int pm, pn, x0, x1, x2; };

constexpr int HTB = 128 * 64 * 2;
__device__ __forceinline__ int lds_byte(int r, int c) { const int st = (r >> 4) * 2 + (c >> 5), rr = r & 15, cc = c & 31, ob = rr * 64 + cc * 2; return st * 1024 + (ob ^ (((ob >> 9) & 1) << 5)); }
__device__ __forceinline__ void stage_rc(int b, int& R, int& C) { const int st = b / 1024, sb = b % 1024, swz = sb ^ (((sb >> 9) & 1) << 5); R = (st >> 1) * 16 + swz / 64; C = (st & 1) * 32 + (swz % 64) / 2; }
__device__ __forceinline__ int perm32(int rho) { const int n = rho >> 4, i = rho & 15; return 8 * (i >> 2) + 4 * n + (i & 3); }
template <class P, class = void> struct chain_p { static constexpr bool v = false; };
template <class P> struct chain_p<P, decltype((void)P::CHAIN)> { static constexpr bool v = P::CHAIN; };
template <class P, class = void> struct bsh_p { static constexpr bool v = false; };
template <class P> struct bsh_p<P, decltype((void)P::BSH)> { static constexpr bool v = P::BSH; };
template <class P, class = void> struct lin_a { static constexpr int v = 0; };
template <class P> struct lin_a<P, decltype((void)P::LINA)> { static constexpr int v = P::LINA; };
template <class P> __device__ __forceinline__ void fast_gemm_phase(Frame& F, const P& p) {
    LAS unsigned char* lds = F.lds;
    const int tid = F.tid, wid = F.wave, lane = F.lane, wr = wid >> 2, wc = wid & 3, fr = lane & 15, fq = lane >> 4;
    int R0, C0, R1, C1; stage_rc(tid * 16, R0, C0); stage_rc(tid * 16 + 8192, R1, C1);
    const int Rb0 = (R0 & ~31) + perm32(R0 & 31);
    const unsigned ldsw = (unsigned)wid * 1024u;
    const int aoffL = lds_byte(wr * 64 + fr, fq * 8), boffL = lds_byte(wc * 32 + fr, fq * 8);
    Unit cur, nxt; int ui = 0;
    if (!p.next(0, cur)) return;
    constexpr int LINA = lin_a<P>::v;
    const char* sA; const char* sB; unsigned sa00, sa01, sa10, sa11, sb0; size_t shB;
#define FG_SET(u) do { sA = (const char*)(u).A; sB = (const char*)(u).B; if constexpr (bsh_p<P>::v) shB = (size_t)(unsigned)(u).x2; else shB = (size_t)128 * (u).ldb * 2;     \
        sa00 = p.a_off((u), R0) + C0 * 2; if constexpr (LINA == 0) { sa01 = p.a_off((u), R1) + C1 * 2; sa10 = p.a_off((u), 128 + R0) + C0 * 2; sa11 = p.a_off((u), 128 + R1) + C1 * 2; } \
        sb0 = (unsigned)(Rb0 * (u).ldb + C0) * 2u; } while (0)
#define FG_SA(b, h) (((b) * 2 + (h)) * HTB)
#define FG_SB(b, h) ((4 + (b) * 2 + (h)) * HTB)
#define FG_GLDS(src, bufoff, i) __builtin_amdgcn_global_load_lds((const unsigned*)(src), (LAS unsigned*)(lds + (bufoff) + ldsw + (i) * 8192), 16, 0, 0)
#define FG_OPQ(ptr) do { if constexpr (P::FP8) asm volatile("" : "+s"(ptr)); } while (0)
#define FG_STAGE_A0(bufoff, kt) do { const char* _pa = sA + (size_t)(kt) * 128; FG_OPQ(_pa); FG_GLDS(_pa + sa00, bufoff, 0); \
        if constexpr (LINA == 0) FG_GLDS(_pa + sa01, bufoff, 1); else { const char* _pa1 = _pa + 64 * LINA; FG_OPQ(_pa1); FG_GLDS(_pa1 + sa00, bufoff, 1); } } while (0)
#define FG_STAGE_A1(bufoff, kt) do { const char* _pa = sA + (size_t)(kt) * 128; FG_OPQ(_pa); \
        if constexpr (LINA == 0) { FG_GLDS(_pa + sa10, bufoff, 0); FG_GLDS(_pa + sa11, bufoff, 1); } \
        else { const char* _pa2 = _pa + 128 * LINA; const char* _pa3 = _pa + 192 * LINA; FG_OPQ(_pa2); FG_OPQ(_pa3); FG_GLDS(_pa2 + sa00, bufoff, 0); FG_GLDS(_pa3 + sa00, bufoff, 1); } } while (0)
#define FG_STAGE_B(bufoff, h, kt) do { const char* _pb = sB + ((size_t)(h) * shB + (size_t)(kt) * 128); const char* _pb1 = _pb + (shB >> 1); FG_OPQ(_pb); FG_OPQ(_pb1); FG_GLDS(_pb + sb0, bufoff, 0); FG_GLDS(_pb1 + sb0, bufoff, 1); } while (0)
#define FG_LDA(dst, b, h) do { _Pragma("unroll") for (int m = 0; m < 4; ++m) _Pragma("unroll") for (int k = 0; k < 2; ++k) dst[m][k] = *(const LAS bf16x8*)(lds + FG_SA(b, h) + aoffL + m * 2048 + k * 1024); } while (0)
#define FG_LDB(dst, b, h) do { _Pragma("unroll") for (int n = 0; n < 2; ++n) _Pragma("unroll") for (int k = 0; k < 2; ++k) dst[n][k] = *(const LAS bf16x8*)(lds + FG_SB(b, h) + boffL + n * 2048 + k * 1024); } while (0)
#define FG_MMA(ai, bj, At, Bt) do { __builtin_amdgcn_s_setprio(1); _Pragma("unroll") for (int m = 0; m < 4; ++m) _Pragma("unroll") for (int n = 0; n < 2; ++n) { \
        if constexpr (P::FP8) acc[ai][bj][m][n] = __builtin_amdgcn_mfma_scale_f32_16x16x128_f8f6f4(cat8(Bt[n][0], Bt[n][1]), cat8(At[m][0], At[m][1]), acc[ai][bj][m][n], 0, 0, 0, 0, 0, 0); \
        else { _Pragma("unroll") for (int k = 0; k < 2; ++k) acc[ai][bj][m][n] = __builtin_amdgcn_mfma_f32_16x16x32_bf16(Bt[n][k], At[m][k], acc[ai][bj][m][n], 0, 0, 0); } } __builtin_amdgcn_s_setprio(0); } while (0)
#define FG_WAIT_V(n) asm volatile("s_waitcnt vmcnt(" #n ")" ::: "memory")
#define FG_WAIT_L(n) asm volatile("s_waitcnt lgkmcnt(" #n ")" ::: "memory")
#define FG_BAR __builtin_amdgcn_s_barrier()
#define FG_SCHED __builtin_amdgcn_sched_barrier(0)
    f32x4 acc[2][2][4][2];
#pragma unroll
    for (int a = 0; a < 2; ++a)
#pragma unroll
        for (int b = 0; b < 2; ++b)
#pragma unroll
            for (int m = 0; m < 4; ++m)
#pragma unroll
                for (int n = 0; n < 2; ++n) acc[a][b][m][n] = (f32x4){0.f, 0.f, 0.f, 0.f};
    bf16x8 At[4][2], B0[2][2], B1[2][2];
    FG_SET(cur);
    FG_STAGE_B(FG_SB(0, 0), 0, 0); FG_STAGE_B(FG_SB(0, 1), 1, 0); FG_STAGE_A0(FG_SA(0, 0), 0); FG_STAGE_A1(FG_SA(0, 1), 0);
    if (wr == 1) FG_BAR;
    FG_WAIT_V(2); FG_BAR;
    FG_STAGE_B(FG_SB(1, 0), 0, 1); FG_STAGE_A0(FG_SA(1, 0), 1); FG_STAGE_B(FG_SB(1, 1), 1, 1);
    FG_WAIT_V(6); FG_BAR;
    for (;;) {
        const bool has_next = p.next(ui + 1, nxt);
        int nt = cur.K >> 6; asm volatile("" : "+s"(nt));
        for (int t = 0; t < nt; t += 2) {
            const bool last = (t == nt - 2);
            const int k2 = last ? 0 : t + 2, k3 = k2 + 1;
            FG_LDB(B0, 0, 0); FG_LDB(B1, 0, 1); FG_SCHED; FG_LDA(At, 0, 0); FG_STAGE_A1(FG_SA(1, 1), t + 1);
            if (last && has_next) FG_SET(nxt);
            FG_WAIT_V(8); FG_WAIT_L(0); FG_BAR; FG_MMA(0, 0, At, B0); FG_MMA(0, 1, At, B1); FG_BAR; FG_SCHED;
            FG_LDA(At, 0, 1); FG_STAGE_B(FG_SB(0, 0), 0, k2); FG_STAGE_B(FG_SB(0, 1), 1, k2); FG_STAGE_A0(FG_SA(0, 0), k2);
            FG_WAIT_V(8); FG_WAIT_L(0); FG_BAR; FG_MMA(1, 0, At, B0); FG_MMA(1, 1, At, B1); FG_BAR; FG_SCHED;
            FG_LDB(B0, 1, 0); FG_LDB(B1, 1, 1); FG_SCHED; FG_LDA(At, 1, 0); FG_STAGE_A1(FG_SA(0, 1), k2);
            FG_WAIT_V(8); FG_WAIT_L(0); FG_BAR; FG_MMA(0, 0, At, B0); FG_MMA(0, 1, At, B1); FG_BAR; FG_SCHED;
            FG_LDA(At, 1, 1); FG_STAGE_B(FG_SB(1, 0), 0, k3); FG_STAGE_B(FG_SB(1, 1), 1, k3); FG_STAGE_A0(FG_SA(1, 0), k3);
            FG_WAIT_V(8); FG_WAIT_L(0); FG_BAR; FG_MMA(1, 0, At, B0); FG_MMA(1, 1, At, B1); FG_BAR; FG_SCHED;
        }
        if (wr == 0) FG_BAR;
        if constexpr (P::PAIRED) {
#pragma unroll
            for (int m = 0; m < 4; ++m) {
                const float r0[8] = {acc[0][0][m][0][0], acc[0][0][m][0][1], acc[0][0][m][0][2], acc[0][0][m][0][3], acc[0][0][m][1][0], acc[0][0][m][1][1], acc[0][0][m][1][2], acc[0][0][m][1][3]};
                const float r1[8] = {acc[0][1][m][0][0], acc[0][1][m][0][1], acc[0][1][m][0][2], acc[0][1][m][0][3], acc[0][1][m][1][0], acc[0][1][m][1][1], acc[0][1][m][1][2], acc[0][1][m][1][3]};
                const float i0[8] = {acc[1][0][m][0][0], acc[1][0][m][0][1], acc[1][0][m][0][2], acc[1][0][m][0][3], acc[1][0][m][1][0], acc[1][0][m][1][1], acc[1][0][m][1][2], acc[1][0][m][1][3]};
                const float i1[8] = {acc[1][1][m][0][0], acc[1][1][m][0][1], acc[1][1][m][0][2], acc[1][1][m][0][3], acc[1][1][m][1][0], acc[1][1][m][1][1], acc[1][1][m][1][2], acc[1][1][m][1][3]};
                p.epi2(cur, wr * 64 + m * 16 + fr, wc * 32 + fq * 8, r0, r1, i0, i1);
                __builtin_amdgcn_sched_barrier(0);
            }
        } else if (chain_p<P>::v && cur.x0 == 0) {
          if constexpr (chain_p<P>::v) {
          constexpr int NBT = 8 / P::EB;
          typename P::Pre pre[2][P::EB];
#pragma unroll
          for (int e = 0; e < P::EB; ++e) pre[0][e] = p.pre(cur, wr * 64 + e * 16 + fr, wc * 32 + fq * 8);
#pragma unroll
          for (int b = 0; b < NBT; ++b) {
            if (b + 1 < NBT) { const int ai1 = ((b + 1) * P::EB) >> 2, mb1 = ((b + 1) * P::EB) & 3;
#pragma unroll
                for (int e = 0; e < P::EB; ++e) pre[(b + 1) & 1][e] = p.pre(cur, ai1 * 128 + wr * 64 + (mb1 + e) * 16 + fr, wc * 32 + fq * 8); }
            const int ai = (b * P::EB) >> 2, mb = (b * P::EB) & 3;
#pragma unroll
            for (int e = 0; e < P::EB; ++e) { const int m = mb + e; f32x4 q[4]; p.scale(pre[b & 1][e], q);
                acc[ai][0][m][0] *= q[0]; acc[ai][0][m][1] *= q[1]; acc[ai][1][m][0] *= q[2]; acc[ai][1][m][1] *= q[3]; __builtin_amdgcn_sched_barrier(0); } } }
        } else
        { const typename P::UPre up = p.upre(cur, wc * 32 + fq * 8);
          constexpr int NBT = 8 / P::EB;
          typename P::Pre pre[2][P::EB];
#pragma unroll
          for (int e = 0; e < P::EB; ++e) pre[0][e] = p.pre(cur, wr * 64 + e * 16 + fr, wc * 32 + fq * 8);
#pragma unroll
          for (int b = 0; b < NBT; ++b) {
            if (b + 1 < NBT) { const int ai1 = ((b + 1) * P::EB) >> 2, mb1 = ((b + 1) * P::EB) & 3;
#pragma unroll
                for (int e = 0; e < P::EB; ++e) pre[(b + 1) & 1][e] = p.pre(cur, ai1 * 128 + wr * 64 + (mb1 + e) * 16 + fr, wc * 32 + fq * 8); }
            const int ai = (b * P::EB) >> 2, mb = (b * P::EB) & 3;
#pragma unroll
            for (int e = 0; e < P::EB; ++e) { const int m = mb + e;
                const float v0[8] = {acc[ai][0][m][0][0], acc[ai][0][m][0][1], acc[ai][0][m][0][2], acc[ai][0][m][0][3], acc[ai][0][m][1][0], acc[ai][0][m][1][1], acc[ai][0][m][1][2], acc[ai][0][m][1][3]};
                const float v1[8] = {acc[ai][1][m][0][0], acc[ai][1][m][0][1], acc[ai][1][m][0][2], acc[ai][1][m][0][3], acc[ai][1][m][1][0], acc[ai][1][m][1][1], acc[ai][1][m][1][2], acc[ai][1][m][1][3]};
                p.epi(cur, ai * 128 + wr * 64 + m * 16 + fr, wc * 32 + fq * 8, v0, v1, pre[b & 1][e], up);
            } } }
        if (!has_next) break;
        if (!(chain_p<P>::v && cur.x0 == 0)) {
#pragma unroll
        for (int a = 0; a < 2; ++a)
#pragma unroll
            for (int b = 0; b < 2; ++b)
#pragma unroll
                for (int m = 0; m < 4; ++m)
#pragma unroll
                    for (int n = 0; n < 2; ++n) acc[a][b][m][n] = (f32x4){0.f, 0.f, 0.f, 0.f}; }
        cur = nxt; ++ui;
        if (wr == 1) FG_BAR;
    }
    FG_WAIT_V(0);
    FG_BAR;
#undef FG_SET
#undef FG_SA
#undef FG_SB
#undef FG_GLDS
#undef FG_OPQ
#undef FG_STAGE_A0
#undef FG_STAGE_A1
#undef FG_STAGE_B
#undef FG_LDA
#undef FG_LDB
#undef FG_MMA
#undef FG_WAIT_V
#undef FG_WAIT_L
#undef FG_BAR
#undef FG_SCHED
}

__device__ __forceinline__ void order2d(int L, int nM, int nN, int& pm, int& pn) {
    const int nwg = nM * nN; int wgid = L; { const int q = nwg >> 3, r = nwg & 7, xcd = wgid & 7, off = wgid >> 3; wgid = (xcd < r ? xcd * (q + 1) : r * (q + 1) + (xcd - r) * q) + off; }
    const int nig = 8 * nN, gid = wgid / nig, fm = gid * 8, gsz = (nM - fm) < 8 ? (nM - fm) : 8;
    pm = fm + ((wgid % nig) % gsz); pn = (wgid % nig) / gsz;
}
struct NoPre {};
struct PInproj {
    static constexpr bool PAIRED = false, FP8 = false; static constexpr int EB = 4;
    int G, c, l; const bf16* hx; const bf16* wt; bf16 *urnn, *gate;
    __device__ __forceinline__ int count() const { return 1024 + 8 * (l == 1 ? 4 : 8); }
    __device__ __forceinline__ bool next(int i, Unit& u) const {
        const int idx = i * G + c; if (idx >= count()) return false;
        if (idx < 1024) order2d(idx, 128, 8, u.pm, u.pn); else { const int j = idx - 1024; u.pm = 128 + (j & 7); u.pn = j >> 3; }
        u.A = hx + (size_t)u.pm * 256 * D; u.lda = D; u.B = wt + (size_t)u.pn * 256 * D; u.ldb = D; u.K = D; return true; }
    __device__ __forceinline__ unsigned a_off(const Unit& u, int row) const { return (unsigned)row * (D * 2); }
    typedef NoPre Pre; typedef NoPre UPre;
    __device__ __forceinline__ NoPre pre(const Unit&, int, int) const { return NoPre{}; }
    __device__ __forceinline__ NoPre upre(const Unit&, int) const { return NoPre{}; }
    __device__ __forceinline__ void epi(const Unit& u, int row, int c8, const float* v0, const float* v1, const NoPre&, const NoPre&) const {
        const size_t r = (size_t)u.pm * 256 + row; const int col = u.pn * 256 + c8;
        float a[8], b[8];
        if (col < 1024) { *(GAS v4u*)(urnn + r * D + col) = pack8(v0); *(GAS v4u*)(urnn + r * D + col + 128) = pack8(v1); }
        else {
#pragma unroll
            for (int j = 0; j < 8; j += 2) { const f32x2 ga = gelu_pk((f32x2){v0[j], v0[j + 1]}), gb = gelu_pk((f32x2){v1[j], v1[j + 1]}); a[j] = ga.x; a[j + 1] = ga.y; b[j] = gb.x; b[j + 1] = gb.y; }
            *(GAS v4u*)(gate + r * D + col - 1024) = pack8(a); *(GAS v4u*)(gate + r * D + col - 1024 + 128) = pack8(b); }
    }
};
struct PFourT {
    static constexpr bool PAIRED = false, FP8 = false, BSH = true; static constexpr int EB = 4, LINA = 2 * D;
    int G, c, l, rot; const bf16* hx; const bf16* wt; bf16 *ut4, *utc;
    __device__ __forceinline__ int count() const { return 256 + (l == 0 ? 16 : 0); }
    __device__ __forceinline__ bool next(int i, Unit& u) const {
        int cr = c - rot; cr += cr < 0 ? G : 0; const int idx = i * G + cr; if (idx >= count()) return false;
        if (idx < 256) { const int ct = idx & 1, rest = idx >> 1, b = rest >> 4, tg = rest & 15; u.x0 = b; u.x1 = tg; u.pm = ct; u.pn = 0;
            u.B = hx + ((size_t)b * 4096 + tg * 4) * D; u.ldb = 64 * D; u.x2 = 2 * D * 2; }
        else { const int j = idx - 256, ct = j & 1, b = j >> 1; u.x0 = b; u.x1 = 0; u.pm = ct; u.pn = 1; u.B = hx + ((size_t)NL + b * 256) * D; u.ldb = D; u.x2 = 128 * D * 2; }
        u.A = wt + (size_t)(2048 + u.pm * 256) * D; u.lda = D; u.K = D; return true; }
    __device__ __forceinline__ unsigned a_off(const Unit& u, int row) const { return (unsigned)row * (D * 2); }
    typedef NoPre Pre; typedef NoPre UPre;
    __device__ __forceinline__ NoPre pre(const Unit&, int, int) const { return NoPre{}; }
    __device__ __forceinline__ NoPre upre(const Unit&, int) const { return NoPre{}; }
    __device__ __forceinline__ void epi(const Unit& u, int row, int c8, const float* v0, const float* v1, const NoPre&, const NoPre&) const {
        const int ch = u.pm * 256 + row;
        if (u.pn == 0) { const int cp = ch >> 1, cq = ch & 1, t2 = u.x1 * 4 + (c8 >> 6), t1 = c8 & 63;
            bf16* dst = ut4 + ((((size_t)u.x0 * 256 + cp) * 64 + t2) * 2 + cq) * 64 + t1; *(GAS v4u*)dst = pack8(v0); *(GAS v4u*)(dst + 256) = pack8(v1); }
        else { bf16* dst = utc + ((size_t)u.x0 * 512 + ch) * 256 + c8; *(GAS v4u*)dst = pack8(v0); *(GAS v4u*)(dst + 128) = pack8(v1); }
    }
};
struct PInproj8 {
    static constexpr bool PAIRED = false, FP8 = true; static constexpr int EB = 4, LINA = D;
    int G, c, npan, rot; const unsigned char* hx8; const unsigned char* wt8; bf16 *sgr, *sgf;
    __device__ __forceinline__ bool next(int i, Unit& u) const {
        int cr = c - rot; cr += cr < 0 ? G : 0; const int cnt = npan * 8, n2 = cnt / G, r2 = cnt - n2 * G; int idx = i * G + cr;
        if (r2 + 2 * rot <= G && n2 >= 2) {
            if (cr >= G - rot) { if (i >= n2 - 1) return false; }
            else if (i == n2 && cr >= r2 && cr < r2 + rot) idx = (n2 - 1) * G + (G - rot) + (cr - r2);
        }
        if (idx >= cnt) return false;
        order2d(idx, npan, 8, u.pm, u.pn); u.A = (const bf16*)(hx8 + (size_t)u.pm * 256 * D); u.lda = D / 2; u.B = (const bf16*)(wt8 + (size_t)u.pn * 256 * D); u.ldb = D / 2; u.K = D / 2; return true; }
    __device__ __forceinline__ unsigned a_off(const Unit& u, int row) const { return (unsigned)row * D; }
    typedef NoPre Pre; typedef NoPre UPre;
    __device__ __forceinline__ NoPre pre(const Unit&, int, int) const { return NoPre{}; }
    __device__ __forceinline__ NoPre upre(const Unit&, int) const { return NoPre{}; }
    __device__ __forceinline__ void epi(const Unit& u, int row, int c8, const float* v0, const float* v1, const NoPre&, const NoPre&) const {
        const size_t r = (size_t)u.pm * 256 + row; const int col = u.pn * 256 + c8; float a[8], b[8];
#pragma unroll
        for (int j = 0; j < 8; j += 2) { const f32x2 ga = sigmoid_pk((f32x2){v0[j], v0[j + 1]} * (1.f / MOE_WS)), gb = sigmoid_pk((f32x2){v1[j], v1[j + 1]} * (1.f / MOE_WS)); a[j] = ga.x; a[j + 1] = ga.y; b[j] = gb.x; b[j + 1] = gb.y; }
        bf16* dst = col < 1024 ? sgr + r * D + col : sgf + r * D + (col - 1024);
        *(GAS v4u*)dst = pack8(a); *(GAS v4u*)(dst + 128) = pack8(b);
    }
};
struct PDft {
    static constexpr bool PAIRED = false, FP8 = false; static constexpr int EB = 4;
    int G, c; const bf16 *csc, *ut; bf16* g;
    __device__ __forceinline__ bool next(int i, Unit& u) const {
        const int j = i * G + c; if (j >= 32) return false;
        const int b = j >> 2, rem = j & 3; u.pm = rem >> 1; u.pn = rem & 1; u.x0 = b;
        u.A = csc + (size_t)u.pm * 256 * 256; u.lda = 256; u.B = ut + ((size_t)b * 512 + u.pn * 256) * 256; u.ldb = 256; u.K = 256; return true; }
    __device__ __forceinline__ unsigned a_off(const Unit& u, int row) const { return (unsigned)row * 512u; }
    typedef NoPre Pre; typedef NoPre UPre;
    __device__ __forceinline__ NoPre pre(const Unit&, int, int) const { return NoPre{}; }
    __device__ __forceinline__ NoPre upre(const Unit&, int) const { return NoPre{}; }
    __device__ __forceinline__ void epi(const Unit& u, int row, int c8, const float* v0, const float* v1, const NoPre&, const NoPre&) const {
        const size_t r = (size_t)NL + u.x0 * 256 + row; const int col = u.pm * 512 + u.pn * 256 + c8;
        *(GAS v4u*)(g + r * D + col) = pack8(v0); *(GAS v4u*)(g + r * D + col + 128) = pack8(v1);
    }
};
struct PFftA {
    static constexpr bool PAIRED = true, FP8 = false; static constexpr int EB = 4;
    int G, c; const bf16 *fa, *ut4; bf16* zt;
    __device__ __forceinline__ bool next(int i, Unit& u) const {
        const int idx = i * G + c; if (idx >= 512) return false;
        u.pm = 0; u.pn = idx; u.A = fa; u.lda = 128; u.B = ut4 + (size_t)idx * 256 * 128; u.ldb = 128; u.K = 128; return true; }
    __device__ __forceinline__ unsigned a_off(const Unit& u, int row) const { return (unsigned)row * 256u; }
    __device__ __forceinline__ void epi2(const Unit& u, int row, int c8, const float* r0, const float* r1, const float* i0, const float* i1) const {
        const int cq = row >> 6, k1 = row & 63;
#pragma unroll
        for (int h = 0; h < 2; ++h) { const float* zr = h ? r1 : r0; const float* zi = h ? i1 : i0; const int n = u.pn * 256 + c8 + h * 128, cp = (n >> 6) & 255, b = n >> 14; int t2 = n & 63;
            asm volatile("" : "+v"(t2));
            float orr[8], oi[8];
#pragma unroll
            for (int j = 0; j < 8; ++j) { const float ph = (float)(k1 * (t2 + j)) * (1.0f / 4096.0f); const float cs = __builtin_amdgcn_cosf(ph), sn = __builtin_amdgcn_sinf(ph);
                orr[j] = zr[j] * cs + zi[j] * sn; oi[j] = zi[j] * cs - zr[j] * sn; }
            bf16* dst = zt + ((((size_t)b * 512 + 2 * cp + cq) * 64 + k1) * 2) * 64 + t2;
            *(GAS v4u*)dst = pack8(orr); *(GAS v4u*)(dst + 64) = pack8(oi); __builtin_amdgcn_sched_barrier(0); }
    }
};
struct PFftC {
    static constexpr bool PAIRED = false, FP8 = false; static constexpr int EB = 4;
    int G, c; const bf16 *fc, *zt; bf16* g;
    __device__ __forceinline__ bool next(int i, Unit& u) const {
        const int idx = i * G + c; if (idx >= 512) return false;
        const int b = idx >> 6, k1p = (idx >> 1) & 31, ct = idx & 1; u.x0 = b; u.x2 = k1p; u.pm = 0; u.pn = ct;
        u.A = fc; u.lda = 256; u.K = 256; u.B = zt + (((size_t)b * 512 + ct * 256) * 64 + 2 * k1p) * 128; u.ldb = 64 * 128; return true; }
    __device__ __forceinline__ unsigned a_off(const Unit& u, int row) const { return (unsigned)row * 512u; }
    typedef NoPre Pre; typedef NoPre UPre;
    __device__ __forceinline__ NoPre pre(const Unit&, int, int) const { return NoPre{}; }
    __device__ __forceinline__ NoPre upre(const Unit&, int) const { return NoPre{}; }
    __device__ __forceinline__ void epi(const Unit& u, int row, int c8, const float* v0, const float* v1, const NoPre&, const NoPre&) const {
        const int k1 = 2 * u.x2 + (row >> 7), ty = (row >> 6) & 1, k2 = row & 63; const size_t r = (size_t)u.x0 * 4096 + k1 + 64 * k2; const int col = ty * 512 + u.pn * 256 + c8;
        *(GAS v4u*)(g + r * D + col) = pack8(v0); *(GAS v4u*)(g + r * D + col + 128) = pack8(v1);
    }
};
struct PFold {
    static constexpr bool PAIRED = false, FP8 = false; static constexpr int EB = 4, LINA = 1024;
    int first, c; const bf16 *wft, *fb; bf16* wf;
    __device__ __forceinline__ bool next(int i, Unit& u) const {
        const int idx = c - first; if (i != 0 || idx < 0 || idx >= 32) return false;
        const int l = idx >> 4, g = (idx >> 2) & 3, nt = idx & 3; u.x0 = l; u.x1 = g; u.pm = nt; u.pn = 0;
        u.A = wft + ((size_t)l * D + nt * 256) * 512 + g * 128; u.lda = 512; u.B = fb; u.ldb = 128; u.K = 128; return true; }
    __device__ __forceinline__ unsigned a_off(const Unit& u, int row) const { return (unsigned)row * 1024u; }
    typedef NoPre Pre; typedef NoPre UPre;
    __device__ __forceinline__ NoPre pre(const Unit&, int, int) const { return NoPre{}; }
    __device__ __forceinline__ NoPre upre(const Unit&, int) const { return NoPre{}; }
    __device__ __forceinline__ void epi(const Unit& u, int row, int c8, const float* v0, const float* v1, const NoPre&, const NoPre&) const {
        bf16* dst = wf + (size_t)u.x0 * D * D + (size_t)(u.pm * 256 + row) * D + u.x1 * 128 + c8;
        *(GAS v4u*)dst = pack8(v0); *(GAS v4u*)(dst + 512) = pack8(v1);
    }
};
struct PMerge {
    static constexpr bool PAIRED = false, FP8 = false, CHAIN = true; static constexpr int EB = 2, LINA = 2 * D;
    int G, c, npan; const bf16 *gm, *y, *wf, *wr, *sgr, *sgf; bf16 *mg;
    __device__ __forceinline__ bool next(int i, Unit& u) const {
        const int tile = (i >> 1) * G + c; if (tile >= npan * 4) return false;
        order2d(tile, npan, 4, u.pm, u.pn); u.x0 = i & 1; u.lda = D; u.ldb = D; u.K = D;
        u.A = (u.x0 ? y : gm) + (size_t)u.pm * 256 * D; u.B = (u.x0 ? wr : wf) + (size_t)u.pn * 256 * D; return true; }
    __device__ __forceinline__ unsigned a_off(const Unit& u, int row) const { return (unsigned)row * (D * 2); }
    struct Pre { v4u a0, a1, b0, b1; }; typedef NoPre UPre;
    __device__ __forceinline__ NoPre upre(const Unit&, int) const { return NoPre{}; }
    __device__ __forceinline__ Pre pre(const Unit& u, int row, int c8) const {
        const unsigned o = (unsigned)(((size_t)u.pm * 256 + row) * D + u.pn * 256 + c8) * 2u; Pre r; const bf16* s = u.x0 ? sgr : sgf;
        const __amdgpu_buffer_rsrc_t ra = __builtin_amdgcn_make_buffer_rsrc((void*)s, 0, (int)((size_t)NT * D * 2), 0x00020000), rb = __builtin_amdgcn_make_buffer_rsrc((void*)sgr, 0, (int)((size_t)NT * D * 2), 0x00020000);
        r.a0 = __builtin_amdgcn_raw_buffer_load_b128(ra, (int)o, 0, 0); r.a1 = __builtin_amdgcn_raw_buffer_load_b128(ra, (int)o + 256, 0, 0);
        r.b0 = __builtin_amdgcn_raw_buffer_load_b128(rb, (int)o, 0, 0); r.b1 = __builtin_amdgcn_raw_buffer_load_b128(rb, (int)o + 256, 0, 0);
        return r; }
    __device__ __forceinline__ void scale(const Pre& pr, f32x4* q) const {
        float s[16], t[16]; unpack8(pr.a0, s); unpack8(pr.a1, s + 8); unpack8(pr.b0, t); unpack8(pr.b1, t + 8);
#pragma unroll
        for (int j = 0; j < 16; ++j) q[j >> 2][j & 3] = s[j] * __builtin_amdgcn_rcpf(fmaxf(t[j], 1e-30f)); }
    __device__ __forceinline__ void epi(const Unit& u, int row, int c8, const float* v0, const float* v1, const Pre& pr, const NoPre&) const {
        const unsigned o = (unsigned)(((size_t)u.pm * 256 + row) * D + u.pn * 256 + c8) * 2u;
        const __amdgpu_buffer_rsrc_t rm = __builtin_amdgcn_make_buffer_rsrc((void*)mg, 0, (int)((size_t)NT * D * 2), 0x00020000);
#pragma unroll
        for (int h = 0; h < 2; ++h) { const float* v = h ? v1 : v0; float s[8], r[8];
            unpack8(h ? pr.a1 : pr.a0, s);
#pragma unroll
            for (int j = 0; j < 8; ++j) r[j] = s[j] * v[j];
            __builtin_amdgcn_raw_buffer_store_b128(pack8(r), rm, (int)o + h * 256, 0, 0); }
    }
};
struct PWout {
    static constexpr bool PAIRED = false, FP8 = false; static constexpr int EB = 2, LINA = 2 * D;
    int G, c, npan, l; const bf16 *mg, *wo; const float *xold_l, *xold_c; bf16* xs; const float* g1;
    __device__ __forceinline__ bool next(int i, Unit& u) const {
        const int idx = i * G + c; if (idx >= npan * 4) return false;
        order2d(idx, npan, 4, u.pm, u.pn); u.lda = D; u.ldb = D; u.K = D; u.A = mg + (size_t)u.pm * 256 * D; u.B = wo + (size_t)u.pn * 256 * D; return true; }
    __device__ __forceinline__ unsigned a_off(const Unit& u, int row) const { return (unsigned)row * (D * 2); }
    struct Pre { f32x4 x[4]; }; struct UPre { f32x4 g[4]; };
    __device__ __forceinline__ UPre upre(const Unit& u, int c8) const { const float* gg = g1 + (size_t)mb_of(u.pm * 256) * NMOD * D + u.pn * 256 + c8; UPre r;
        r.g[0] = *(const GAS f32x4*)gg; r.g[1] = *(const GAS f32x4*)(gg + 4); r.g[2] = *(const GAS f32x4*)(gg + 128); r.g[3] = *(const GAS f32x4*)(gg + 132); return r; }
    __device__ __forceinline__ Pre pre(const Unit& u, int row, int c8) const { const int r = u.pm * 256 + row;
        Pre p;
        const bool lat = u.pm < NL / 256;
        const char* base = l ? (const char*)xs : lat ? (const char*)xold_l : (const char*)(xold_c - (size_t)NL * D); const int esz = l ? 2 : 4;
        const char* xo = base + ((size_t)r * D + u.pn * 256 + c8) * esz; const int o1 = l ? 256 : 16, o2 = l ? 0 : 512, o3 = l ? 256 : 528;
        p.x[0] = *(const GAS f32x4*)xo; p.x[1] = *(const GAS f32x4*)(xo + o1); p.x[2] = *(const GAS f32x4*)(xo + o2); p.x[3] = *(const GAS f32x4*)(xo + o3);
        return p; }
    __device__ __forceinline__ void epi(const Unit& u, int row, int c8, const float* v0, const float* v1, const Pre& pr, const UPre& up) const {
        const int r = u.pm * 256 + row;
        bf16* xn = xs + (size_t)r * D + u.pn * 256 + c8; float xo[16], o[16];
        float xb[16]; unpack8(__builtin_bit_cast(v4u, pr.x[0]), xb); unpack8(__builtin_bit_cast(v4u, pr.x[1]), xb + 8);
#pragma unroll
        for (int q = 0; q < 4; ++q) { xo[4 * q] = l ? xb[4 * q] : pr.x[q][0]; xo[4 * q + 1] = l ? xb[4 * q + 1] : pr.x[q][1]; xo[4 * q + 2] = l ? xb[4 * q + 2] : pr.x[q][2]; xo[4 * q + 3] = l ? xb[4 * q + 3] : pr.x[q][3]; }
#pragma unroll
        for (int q = 0; q < 4; ++q) { const float* v = (q < 2 ? v0 : v1) + 4 * (q & 1);
            o[4 * q] = xo[4 * q] + up.g[q][0] * v[0]; o[4 * q + 1] = xo[4 * q + 1] + up.g[q][1] * v[1]; o[4 * q + 2] = xo[4 * q + 2] + up.g[q][2] * v[2]; o[4 * q + 3] = xo[4 * q + 3] + up.g[q][3] * v[3]; }
        *(GAS v4u*)xn = pack8(o); *(GAS v4u*)(xn + 128) = pack8(o + 8);
    }
};
struct PMoe1 {
    static constexpr bool PAIRED = false, FP8 = true; static constexpr int EB = 4;
    int G, c; const unsigned char* hx2; const unsigned char* w; const int2* list; unsigned char* he; const LAS int* ts; const LAS int* cn;
    __device__ __forceinline__ bool next(int i, Unit& u) const {
        const int ntl = __builtin_amdgcn_readfirstlane(ts[16]); const int idx = i * G + c; if (idx >= ntl * 8) return false;
        int tile; order2d(idx, ntl, 8, tile, u.pn); u.pm = tile; int e = 0;
#pragma unroll
        for (int j = 1; j < 16; ++j) e += (tile >= ts[j]) ? 1 : 0;
        e = __builtin_amdgcn_readfirstlane(e);
        u.x0 = e; u.x1 = (tile - __builtin_amdgcn_readfirstlane(ts[e])) * 256; u.x2 = __builtin_amdgcn_readfirstlane(cn[e]);
        u.A = (const bf16*)hx2; u.lda = D / 2; u.B = (const bf16*)(w + (size_t)e * 3 * D * D + (size_t)u.pn * 256 * D); u.ldb = D / 2; u.K = D / 2; return true; }
    __device__ __forceinline__ unsigned a_off(const Unit& u, int row) const {
        int p = u.x1 + row; p = p < u.x2 ? p : u.x2 - 1; const int r = ((const GAS int*)list)[2 * ((size_t)u.x0 * NT + p)] & 0x7fffffff; return (unsigned)r * D; }
    typedef NoPre Pre; typedef NoPre UPre;
    __device__ __forceinline__ NoPre pre(const Unit&, int, int) const { return NoPre{}; }
    __device__ __forceinline__ NoPre upre(const Unit&, int) const { return NoPre{}; }
    __device__ __forceinline__ void epi(const Unit& u, int row, int c8, const float* v0, const float* v1, const NoPre&, const NoPre&) const {
        float r[8];
#pragma unroll
        for (int j = 0; j < 8; j += 2) { const f32x2 g = silu_pk((f32x2){v0[j], v0[j + 1]} * (1.f / MOE_WS)) * ((f32x2){v1[j], v1[j + 1]} * (MOE_HS / MOE_WS)); r[j] = g.x; r[j + 1] = g.y; }
        *(GAS v2u*)(he + ((size_t)u.pm * 256 + row) * D + u.pn * 128 + c8) = (v2u){pk4_fp8(r[0], r[1], r[2], r[3]), pk4_fp8(r[4], r[5], r[6], r[7])};
    }
};
struct PMoe2 {
    static constexpr bool PAIRED = false, FP8 = true; static constexpr int EB = 4, LINA = D;
    int G, c; const unsigned char* he; const unsigned char* w; const int2* list; unsigned char* c01; const LAS int* ts; const LAS int* cn;
    __device__ __forceinline__ bool next(int i, Unit& u) const {
        const int ntl = __builtin_amdgcn_readfirstlane(ts[16]); const int idx = i * G + c; if (idx >= ntl * 4) return false;
        int tile; order2d(idx, ntl, 4, tile, u.pn); u.pm = tile; int e = 0;
#pragma unroll
        for (int j = 1; j < 16; ++j) e += (tile >= ts[j]) ? 1 : 0;
        e = __builtin_amdgcn_readfirstlane(e);
        u.x0 = e; u.x1 = (tile - __builtin_amdgcn_readfirstlane(ts[e])) * 256; u.x2 = __builtin_amdgcn_readfirstlane(cn[e]);
        u.A = (const bf16*)(he + (size_t)tile * 256 * D); u.lda = D / 2; u.B = (const bf16*)(w + (size_t)e * 3 * D * D + (size_t)2 * D * D + (size_t)u.pn * 256 * D); u.ldb = D / 2; u.K = D / 2; return true; }
    __device__ __forceinline__ unsigned a_off(const Unit& u, int row) const { return (unsigned)row * D; }
    struct Pre { int2 en; }; typedef NoPre UPre;
    __device__ __forceinline__ NoPre upre(const Unit&, int) const { return NoPre{}; }
    __device__ __forceinline__ Pre pre(const Unit& u, int row, int) const { int p = u.x1 + row; p = p < u.x2 ? p : u.x2 - 1; Pre r; const v2u e2 = *(const GAS v2u*)(list + (size_t)u.x0 * NT + p); r.en.x = (int)e2.x; r.en.y = (int)e2.y; return r; }
    __device__ __forceinline__ void epi(const Unit& u, int row, int c8, const float* v0, const float* v1, const Pre& pr, const NoPre&) const {
        const int p = u.x1 + row; if (p >= u.x2) return;
        const int2 en = pr.en; const int r = en.x & 0x7fffffff, s = (en.x >> 31) & 1; const float w8 = __builtin_bit_cast(float, en.y) * (MOE_CS / (MOE_WS * MOE_HS));
        unsigned char* dst = c01 + ((size_t)s * NT + r) * D + u.pn * 256 + c8; float a[8], b[8];
#pragma unroll
        for (int j = 0; j < 8; ++j) { a[j] = w8 * v0[j]; b[j] = w8 * v1[j]; }
        *(GAS v2u*)dst = (v2u){pk4_fp8(a[0], a[1], a[2], a[3]), pk4_fp8(a[4], a[5], a[6], a[7])}; *(GAS v2u*)(dst + 128) = (v2u){pk4_fp8(b[0], b[1], b[2], b[3]), pk4_fp8(b[4], b[5], b[6], b[7])};
    }
};

template <int F8 = 0> __device__ __forceinline__ void transpose_item(const float* W, int K, int N, bf16* WT, int k0, int n0, int drow0, LAS float* scr, int lane) {
    const int kr = lane >> 3, n4 = (lane & 7) * 4; f32x4 v[8];
#pragma unroll
    for (int i = 0; i < 8; ++i) v[i] = *(const GAS f32x4*)(W + (size_t)(k0 + 8 * i + kr) * N + n0 + n4);
#pragma unroll
    for (int i = 0; i < 8; ++i) { LAS float* d = scr + (8 * i + kr) * 33 + n4; d[0] = v[i][0]; d[1] = v[i][1]; d[2] = v[i][2]; d[3] = v[i][3]; }
    LDS_WAIT(); asm volatile("" ::: "memory");
    const int c = lane & 7;
#pragma unroll
    for (int j = 0; j < 4; ++j) { const int n = (lane >> 3) + 8 * j; const LAS float* s = scr + (8 * c) * 33 + n;
        if constexpr (F8) { *(GAS v2u*)((unsigned char*)WT + (size_t)(drow0 + n) * K + k0 + 8 * c) = (v2u){pk4_fp8(s[0 * 33] * MOE_WS, s[1 * 33] * MOE_WS, s[2 * 33] * MOE_WS, s[3 * 33] * MOE_WS), pk4_fp8(s[4 * 33] * MOE_WS, s[5 * 33] * MOE_WS, s[6 * 33] * MOE_WS, s[7 * 33] * MOE_WS)}; }
        else { v4u o; o.x = pk2(s[0 * 33], s[1 * 33]); o.y = pk2(s[2 * 33], s[3 * 33]); o.z = pk2(s[4 * 33], s[5 * 33]); o.w = pk2(s[6 * 33], s[7 * 33]);
        *(GAS v4u*)(WT + (size_t)(drow0 + n) * K + k0 + 8 * c) = o; } }
    LDS_WAIT(); asm volatile("" ::: "memory");
}
__device__ __forceinline__ void p_prologue(Frame& F) {
    const int gw = F.bid * NWAVES + F.wave, NGW = F.G * NWAVES;
    LAS float* scr = (LAS float*)(F.lds + F.wave * 16384);
    constexpr int I_IN = 16 * 144, I_SQ = 16 * 32, I_WF = 8 * 32;
    constexpr int NIT = 2 * (I_IN + 2 * I_SQ + I_WF);
    const int tw0 = F.G > 192 + 32 ? 192 : 0, gwt = (F.bid - tw0) * NWAVES + F.wave, NGWT = (F.G - tw0) * NWAVES;
    if (F.bid >= tw0)
    for (int it = gwt; it < NIT; it += NGWT) {
        int r = it; const int l = r / (I_IN + 2 * I_SQ + I_WF); r -= l * (I_IN + 2 * I_SQ + I_WF);
        if (r >= I_IN + 2 * I_SQ) { r -= I_IN + 2 * I_SQ; const int kb = r / 32, nb = r % 32;
            transpose_item(F.kin[16] + (size_t)l * 512 * D, 512, D, (bf16*)(F.ws + WS_LRU) + (size_t)l * D * 512, kb * 64, nb * 32, nb * 32, scr, F.lane); continue; }
        if (r < I_IN) { const int kb = r / 144, nb = r % 144;
            if (nb < 80) transpose_item(F.kin[7] + (size_t)l * D * INW, D, INW, (bf16*)(F.ws + WS_WIN) + (size_t)l * INW * D, kb * 64, nb * 32, nb * 32, scr, F.lane);
            else transpose_item<1>(F.kin[7] + (size_t)l * D * INW, D, INW, (bf16*)(F.ws + WS_WIN) + (size_t)l * INW * D + (size_t)2560 * D, kb * 64, nb * 32, nb * 32 - 2560, scr, F.lane);
            continue; }
        r -= I_IN;
        const int which = r / I_SQ; r -= which * I_SQ; const int kb = r / 32, nb = r % 32;
        transpose_item(F.kin[which ? 17 : 15] + (size_t)l * D * D, D, D, (bf16*)(F.ws + (which ? WS_WO : WS_WR)) + (size_t)l * D * D, kb * 64, nb * 32, nb * 32, scr, F.lane);
    }
    __syncthreads();
    LAS float* T4 = (LAS float*)(F.lds + 65536);
    for (int o = F.tid; o < 4096; o += NTHR) T4[o] = cospif((float)o * (2.0f / 4096.0f));
    __syncthreads();
    { const float scl = 1.0f / sqrtf(4096.f * 128.f), scc = 1.0f / sqrtf(256.f * 128.f);
      bf16* fa = (bf16*)(F.ws + WS_CSC + 256 * 1024); bf16* fc = (bf16*)(F.ws + WS_CSC + 512 * 1024);
      for (int o = F.bid * NTHR + F.tid; o < 256 * 128; o += F.G * NTHR) {
          const int m = o >> 7, k = o & 127, ri = m >> 7, cqm = (m >> 6) & 1, k1 = m & 63, cqk = k >> 6, t1 = k & 63;
          const float v = cqm == cqk ? T4[(64 * ((k1 * t1) & 63) + (ri ? 1024 : 0)) & 4095] : 0.f; fa[o] = (bf16)f2bf(v); }
      for (int o = F.bid * NTHR + F.tid; o < 256 * 256; o += F.G * NTHR) {
          const int m = o >> 8, k = o & 255, qm = m >> 7, ty = (m >> 6) & 1, k2 = m & 63, qk = k >> 7, ri = (k >> 6) & 1, t2 = k & 63;
          const int sh = ty == 0 ? (ri == 0 ? 0 : 3072) : (ri == 0 ? 3072 : 2048);
          const float v = qm == qk ? T4[(64 * ((k2 * t2) & 63) + sh) & 4095] * scl : 0.f; fc[o] = (bf16)f2bf(v); }
      for (int o = F.bid * NTHR + F.tid; o < 256 * 128; o += F.G * NTHR) {
          const int cp = o >> 7, m = o & 127, ph = ((cp & 127) * m) & 127; ((bf16*)(F.ws + WS_CSC + 768 * 1024))[o] = (bf16)f2bf(T4[(32 * ph + (cp < 128 ? 0 : 1024)) & 4095]); }
      for (int o = F.bid * NTHR + F.tid; o < 512 * 32; o += F.G * NTHR) {
          const int r = o >> 5, t0 = (o & 31) * 8, rr = r & 255, sh = r < 256 ? 0 : 3072; float v[8];
#pragma unroll
          for (int j = 0; j < 8; ++j) v[j] = T4[(16 * ((rr * (t0 + j)) & 255) + sh) & 4095] * scc;
          *(GAS v4u*)((bf16*)(F.ws + WS_CSC) + (size_t)r * 256 + t0) = pack8(v); } }
    for (int o = F.bid * NTHR + F.tid; o < 2 * 2 * 1024; o += F.G * NTHR) { const float lam = F.kin[14][o]; const float sp = (-lam > 20.f) ? -lam : log1pf(__expf(-lam));
        ((float*)(F.ws + WS_MODS + 512 * 1024))[o] = -8.0f * sp; }
    __syncthreads();
    { LAS float* sc = (LAS float*)(F.lds + 131072 - 9 * 1024 * 4);
      LAS float* red = (LAS float*)F.lds;
      for (int o = F.tid; o < 9 * 1024; o += NTHR) { const float cv = o < 8192 ? F.kin[1][o] : F.kin[3][o - 8192]; sc[o] = siluf_(cv); }
      __syncthreads();
      for (int it = F.bid; it < 2 * (NMOD * D / 64); it += F.G) {
          const int l = it / (NMOD * D / 64), nb = it % (NMOD * D / 64), lq = F.lane & 15, lg = F.lane >> 4;
          const float* w = F.kin[4] + (size_t)l * D * NMOD * D + nb * 64 + lq * 4; f32x4 acc[9];
#pragma unroll
          for (int q = 0; q < 9; ++q) acc[q] = (f32x4){0.f, 0.f, 0.f, 0.f};
          const int kb = F.wave * 128 + lg;
#pragma unroll 8
          for (int i = 0; i < 32; ++i) { const int k = kb + 4 * i; const f32x4 wv = *(const GAS f32x4*)(w + (size_t)k * NMOD * D);
#pragma unroll
              for (int q = 0; q < 9; ++q) acc[q] += sc[q * 1024 + k] * wv; }
#pragma unroll
          for (int q = 0; q < 9; ++q) *(LAS f32x4*)(red + ((F.wave * 4 + lg) * 9 + q) * 64 + lq * 4) = acc[q];
          __syncthreads();
          for (int o = F.tid; o < 9 * 64; o += NTHR) { const int q = o >> 6, ln = o & 63; float s = 0.f;
#pragma unroll
              for (int pp = 0; pp < 32; ++pp) s += red[(pp * 9 + q) * 64 + ln];
              const int nn = nb * 64 + ln;
              ((float*)(F.ws + WS_MODS))[((size_t)(l * 9 + q)) * NMOD * D + nn] = s + F.kin[5][(size_t)l * NMOD * D + nn]; }
          __syncthreads();
      } }
}

template <int MODE> __device__ __forceinline__ void p_rows(Frame& F, int l, int dummy = 0) {
    const int NR = (MODE == 2 || (MODE == 1 && l == 1)) ? NL : NT;
    const bool comb = (MODE == 0 && l == 1) || MODE == 2;
    const int lane = F.lane;
    LAS float* RW = (LAS float*)F.lds;
    LAS int* lcnt = (LAS int*)(F.lds + 65536);
    LAS int* rinfo = lcnt + 64;
    LAS float* lgs = (LAS float*)(F.lds + 69632);
    const int rpb = (NR + F.G - 1) / F.G, r0 = F.bid * rpb, r1 = (r0 + rpb < NR) ? r0 + rpb : NR;
    const int rpw = (rpb + NWAVES - 1) / NWAVES, w0 = r0 + F.wave * rpw, w1 = (w0 + rpw < r1) ? w0 + rpw : r1;
    if (MODE == 1) {
#pragma unroll
        for (int i = 0; i < 8; ++i) { const int f = F.tid + NTHR * i, k = f >> 2, e4 = f & 3; const f32x4 wv = *(const GAS f32x4*)(F.kin[19] + (size_t)f * 4);
            *(LAS f32x4*)(RW + ((((k >> 8) * 4 + (k & 3)) * 4 + e4) * 64 + ((k & 255) >> 2)) * 4) = wv; }
        if (F.tid < 32) lcnt[F.tid] = 0; __syncthreads(); }
    const float* gn = MODE == 0 ? F.kin[6] + (size_t)l * D : MODE == 1 ? F.kin[18] + (size_t)l * D : F.kin[24];
    bf16* hx = (bf16*)(F.ws + WS_RA); const unsigned char* c01 = F.ws + WS_C01;
    const bool f32in = MODE == 0 && l == 0;
    const float* xin_l = F.kin[0]; const float* xin_c = F.kin[2]; bf16* xs = (bf16*)(F.ws + WS_XS);
    float cA[16], cB[16], g2v[16]; int cur_mb = -1;
#pragma unroll
    for (int q = 0; q < 16; ++q) { cA[q] = 0.f; cB[q] = 0.f; g2v[q] = 0.f; }
    f32x4 nv[4]; v2u nb[4]; unsigned nc0[4], nc1[4];
#pragma unroll
    for (int j = 0; j < 4; ++j) { nv[j] = (f32x4){0.f, 0.f, 0.f, 0.f}; nb[j] = (v2u){0u, 0u}; nc0[j] = 0u; nc1[j] = 0u; }
#define PR_LOAD(R) do { const int r_ = (R); const float* s_ = r_ < NL ? xin_l + (size_t)r_ * D : xin_c + (size_t)(r_ - NL) * D; \
        _Pragma("unroll") for (int j = 0; j < 4; ++j) { if (MODE == 0 && f32in) nv[j] = *(const GAS f32x4*)(s_ + lane * 4 + 256 * j); else nb[j] = *(const GAS v2u*)(xs + (size_t)r_ * D + lane * 4 + 256 * j); \
            if (comb) { nc0[j] = *(const GAS unsigned*)(c01 + (size_t)r_ * D + lane * 4 + 256 * j); nc1[j] = *(const GAS unsigned*)(c01 + ((size_t)NT + r_) * D + lane * 4 + 256 * j); } } } while (0)
    v2u p_x[4], p_h[4]; unsigned p_8[4]; f32x4 p_o[4]; int p_row = -1;
#pragma unroll
    for (int j = 0; j < 4; ++j) { p_x[j] = (v2u){0u, 0u}; p_h[j] = (v2u){0u, 0u}; p_8[j] = 0u; p_o[j] = (f32x4){0.f, 0.f, 0.f, 0.f}; }
#define PR_FLUSH() do { if (p_row >= 0) { _Pragma("unroll") for (int j = 0; j < 4; ++j) { const int k_ = lane * 4 + 256 * j; \
        if (MODE == 0 && comb) *(GAS v2u*)(xs + (size_t)p_row * D + k_) = p_x[j]; \
        if (MODE == 0) { *(GAS v2u*)(hx + (size_t)p_row * D + k_) = p_h[j]; *(GAS unsigned*)(F.ws + WS_CSL + (size_t)p_row * D + k_) = p_8[j]; } \
        if (MODE == 1) *(GAS unsigned*)((unsigned char*)hx + (size_t)p_row * D + k_) = p_8[j]; \
        if (MODE == 2) *(GAS f32x4*)(F.out + (size_t)p_row * D + k_) = p_o[j]; } } } while (0)
    if (w0 < w1) PR_LOAD(w0);
    float oprev[16]; bool havep = false; int rprev = 0;
#pragma unroll
    for (int i = 0; i < 16; ++i) oprev[i] = 0.f;
    for (int r = w0; r < w1; ++r) {
        if (MODE == 0 && f32in) asm volatile("" :: "v"(nv[0]), "v"(nv[1]), "v"(nv[2]), "v"(nv[3])); else asm volatile("" :: "v"(nb[0]), "v"(nb[1]), "v"(nb[2]), "v"(nb[3]));
        if (comb) asm volatile("" :: "v"(nc0[0]), "v"(nc0[1]), "v"(nc0[2]), "v"(nc0[3]), "v"(nc1[0]), "v"(nc1[1]), "v"(nc1[2]), "v"(nc1[3]));
        __builtin_amdgcn_sched_barrier(0);
        PR_FLUSH();
        __builtin_amdgcn_sched_barrier(0);
        f32x4 v[4]; unsigned c0[4], c1[4];
#pragma unroll
        for (int j = 0; j < 4; ++j) { v[j] = (MODE == 0 && f32in) ? nv[j] : (f32x4){bflo(nb[j].x), bfhi(nb[j].x), bflo(nb[j].y), bfhi(nb[j].y)}; c0[j] = nc0[j]; c1[j] = nc1[j]; }
        if (r + 1 < w1) PR_LOAD(r + 1);
        const int mb = mb_of(r);
        if (mb != cur_mb) { cur_mb = mb;
            const float *sh = modp(F, l, mb, MODE == 1 ? 3 : 0), *sc = modp(F, l, mb, MODE == 1 ? 4 : 1), *g2 = modp(F, MODE == 2 ? 1 : 0, mb, 5);
#pragma unroll
            for (int j = 0; j < 4; ++j) { const int k = lane * 4 + 256 * j; const f32x4 g = *(const GAS f32x4*)(gn + k);
                if (MODE != 2) { const f32x4 s1 = *(const GAS f32x4*)(sc + k), s0 = *(const GAS f32x4*)(sh + k);
#pragma unroll
                    for (int q = 0; q < 4; ++q) { cA[4 * j + q] = g[q] * (1.f + s1[q]); cB[4 * j + q] = s0[q]; } }
                else {
#pragma unroll
                    for (int q = 0; q < 4; ++q) cA[4 * j + q] = g[q]; }
                if (comb) { const f32x4 gv = *(const GAS f32x4*)(g2 + k);
#pragma unroll
                    for (int q = 0; q < 4; ++q) g2v[4 * j + q] = gv[q] * (1.f / MOE_CS); } } }
        float ss = 0.f;
#pragma unroll
        for (int j = 0; j < 4; ++j) {
            if (comb) { const f32x2 a01 = __builtin_amdgcn_cvt_pk_f32_fp8((int)c0[j], false), a23 = __builtin_amdgcn_cvt_pk_f32_fp8((int)c0[j], true), b01 = __builtin_amdgcn_cvt_pk_f32_fp8((int)c1[j], false), b23 = __builtin_amdgcn_cvt_pk_f32_fp8((int)c1[j], true);
                        v[j][0] += g2v[4 * j] * (a01.x + b01.x); v[j][1] += g2v[4 * j + 1] * (a01.y + b01.y);
                        v[j][2] += g2v[4 * j + 2] * (a23.x + b23.x); v[j][3] += g2v[4 * j + 3] * (a23.y + b23.y);
                        if (MODE == 0) { p_x[j].x = pk2(v[j][0], v[j][1]); p_x[j].y = pk2(v[j][2], v[j][3]); } }
            ss += (v[j][0] * v[j][0] + v[j][1] * v[j][1]) + (v[j][2] * v[j][2] + v[j][3] * v[j][3]); }
        const float rstd = rsqrtf(wave_sum(ss, lane) * (1.f / D) + RMS_EPS);
        float oall[16];
#pragma unroll
        for (int j = 0; j < 4; ++j) { const int k = lane * 4 + 256 * j; float o[4];
#pragma unroll
            for (int q = 0; q < 4; ++q) { o[q] = v[j][q] * rstd * cA[4 * j + q] + cB[4 * j + q]; oall[4 * j + q] = o[q]; }
            if (MODE == 2) p_o[j] = (f32x4){o[0], o[1], o[2], o[3]};
            else if (MODE == 1) p_8[j] = pk4_fp8(o[0], o[1], o[2], o[3]);
            else { p_h[j].x = pk2(o[0], o[1]); p_h[j].y = pk2(o[2], o[3]); p_8[j] = pk4_fp8(o[0], o[1], o[2], o[3]); } }
        p_row = r;
        if (MODE == 1) {
          if (!havep && r + 1 < w1) {
#pragma unroll
              for (int i = 0; i < 16; ++i) oprev[i] = oall[i];
              havep = true; rprev = r; continue; }
          f32x2 lgA[8], lgB[8];
#pragma unroll
          for (int e = 0; e < 8; ++e) { lgA[e] = (f32x2){0.f, 0.f}; lgB[e] = (f32x2){0.f, 0.f}; }
#pragma unroll
          for (int i = 0; i < 16; ++i) { const LAS f32x4* rw = (const LAS f32x4*)RW + (i * 4) * 64 + lane; const f32x2 oa = (f32x2){oprev[i], oprev[i]}, ob = (f32x2){oall[i], oall[i]};
#pragma unroll
              for (int e4 = 0; e4 < 4; ++e4) { const f32x4 w = rw[e4 * 64]; const f32x2 wl = (f32x2){w[0], w[1]}, wh = (f32x2){w[2], w[3]};
                  lgA[2 * e4] += oa * wl; lgA[2 * e4 + 1] += oa * wh; lgB[2 * e4] += ob * wl; lgB[2 * e4 + 1] += ob * wh; } }
          const int npass = havep ? 2 : 1;
          for (int ps = 0; ps < npass; ++ps) {
            const bool first = havep && ps == 0; const int rr = first ? rprev : r; float lg[16];
#pragma unroll
            for (int e = 0; e < 8; ++e) { lg[2 * e] = first ? lgA[e].x : lgB[e].x; lg[2 * e + 1] = first ? lgA[e].y : lgB[e].y; }
#define PR_BP(x, m) __builtin_bit_cast(float, __builtin_amdgcn_ds_bpermute((lane ^ (m)) << 2, __builtin_bit_cast(int, (x))))
            float t8[8], t4[4], t2[2]; const bool b3 = lane & 8, b2 = lane & 4, b1 = lane & 2, b0 = lane & 1;
#pragma unroll
            for (int i = 0; i < 8; ++i) { const float snd = b3 ? lg[i] : lg[i + 8]; t8[i] = (b3 ? lg[i + 8] : lg[i]) + PR_BP(snd, 8); }
#pragma unroll
            for (int i = 0; i < 4; ++i) { const float snd = b2 ? t8[i] : t8[i + 4]; t4[i] = (b2 ? t8[i + 4] : t8[i]) + PR_BP(snd, 4); }
#pragma unroll
            for (int i = 0; i < 2; ++i) { const float snd = b1 ? t4[i] : t4[i + 2]; t2[i] = (b1 ? t4[i + 2] : t4[i]) + PR_BP(snd, 2); }
            float val; { const float snd = b0 ? t2[0] : t2[1]; val = (b0 ? t2[1] : t2[0]) + PR_BP(snd, 1); }
            val += PR_BP(val, 16); val += PR_BP(val, 32);
#undef PR_BP
            if (lane < 16) lgs[(rr - r0) * 16 + lane] = val;
          }
          havep = false;
        }
    }
    PR_FLUSH();
#undef PR_FLUSH
#undef PR_LOAD
    if (MODE == 1) {
        __syncthreads();
        for (int rl = F.tid; rl < r1 - r0; rl += NTHR) {
            float aff[16], sel[16];
#pragma unroll
            for (int e4 = 0; e4 < 4; ++e4) { const f32x4 lv = *(const LAS f32x4*)(lgs + rl * 16 + 4 * e4);
#pragma unroll
                for (int i = 0; i < 4; ++i) { aff[4 * e4 + i] = sigmoidf_(lv[i]); sel[4 * e4 + i] = aff[4 * e4 + i] + F.kin[20][4 * e4 + i]; } }
            int grp = 0; float best = -1e30f;
#pragma unroll
            for (int g = 0; g < 4; ++g) { const float a = sel[4 * g], b = sel[4 * g + 1], c = sel[4 * g + 2], dd = sel[4 * g + 3];
                const float s = fmaxf(fmaxf(fmaxf(a + b, a + c), fmaxf(a + dd, b + c)), fmaxf(b + dd, c + dd));
                if (s > best) { best = s; grp = g; } }
            float s4[4], a4[4];
#pragma unroll
            for (int q = 0; q < 4; ++q) { s4[q] = grp == 0 ? sel[q] : grp == 1 ? sel[4 + q] : grp == 2 ? sel[8 + q] : sel[12 + q]; a4[q] = grp == 0 ? aff[q] : grp == 1 ? aff[4 + q] : grp == 2 ? aff[8 + q] : aff[12 + q]; }
            int i0 = 0; float m0 = s4[0], af0 = a4[0];
#pragma unroll
            for (int q = 1; q < 4; ++q) if (s4[q] > m0) { m0 = s4[q]; i0 = q; af0 = a4[q]; }
            int i1 = -1; float m1 = -1e30f, af1 = 0.f;
#pragma unroll
            for (int q = 0; q < 4; ++q) if (q != i0 && s4[q] > m1) { m1 = s4[q]; i1 = q; af1 = a4[q]; }
            const int e0 = grp * 4 + i0, e1 = grp * 4 + i1; const float inv = 1.f / (af0 + af1);
            { const int lr0 = __hip_atomic_fetch_add(lcnt + e0, 1, __ATOMIC_RELAXED, __HIP_MEMORY_SCOPE_WORKGROUP), lr1 = __hip_atomic_fetch_add(lcnt + e1, 1, __ATOMIC_RELAXED, __HIP_MEMORY_SCOPE_WORKGROUP);
                LAS int* ri = rinfo + rl * 5; ri[0] = e0 | (e1 << 8); ri[1] = lr0; ri[2] = lr1; ri[3] = __builtin_bit_cast(int, af0 * inv); ri[4] = __builtin_bit_cast(int, af1 * inv); }
        }
        __syncthreads();
        if (F.tid < 16) lcnt[16 + F.tid] = (int)__hip_atomic_fetch_add(F.ctl + CW_CNT + 64 * l + 128 * dummy + F.tid, (unsigned)lcnt[F.tid], __ATOMIC_RELAXED, __HIP_MEMORY_SCOPE_AGENT);
        __syncthreads();
        int2* list = (int2*)(F.ws + (dummy ? WS_SUM : WS_LIST));
        for (int rl = F.tid; rl < r1 - r0; rl += NTHR) { const LAS int* ri = rinfo + rl * 5; const int e0 = ri[0] & 255, e1 = ri[0] >> 8, r = r0 + rl;
            list[(size_t)e0 * NT + lcnt[16 + e0] + ri[1]] = make_int2(r, ri[3]);
            list[(size_t)e1 * NT + lcnt[16 + e1] + ri[2]] = make_int2(r | (int)0x80000000, ri[4]); }
    }
}
__device__ __forceinline__ void p_transpose(Frame& F, int l) {
    const bf16* uf = (const bf16*)(F.ws + WS_RF); bf16* ut4 = (bf16*)(F.ws + WS_RG); bf16* utc = (bf16*)(F.ws + WS_UTC);
    LAS bf16* tile = (LAS bf16*)F.lds;
    for (int it = F.bid; it < 512; it += F.G) {
        const int b = it >> 6, t2b = (it >> 3) & 7, cb = it & 7;
        __syncthreads();
#pragma unroll
        for (int i = 0; i < 8; ++i) { const int p = F.tid + NTHR * i, rr = p >> 3, c8 = (p & 7) * 8, t1 = rr >> 3, t2l = rr & 7;
            const v4u w = *(const GAS v4u*)(uf + ((size_t)b * 4096 + 64 * t1 + 8 * t2b + t2l) * 512 + cb * 64 + c8);
            LAS unsigned* d = (LAS unsigned*)(tile + (t2l * 64 + t1) * 66 + c8); d[0] = w.x; d[1] = w.y; d[2] = w.z; d[3] = w.w; }
        __syncthreads();
#pragma unroll
        for (int i = 0; i < 8; ++i) { const int q = F.tid + NTHR * i, t1b = q & 7, cq = (q >> 3) & 1, cpl = (q >> 4) & 31, t2l = q >> 9; unsigned h[8];
#pragma unroll
            for (int j = 0; j < 8; ++j) h[j] = tile[(t2l * 64 + t1b * 8 + j) * 66 + 2 * cpl + cq];
            v4u o; o.x = h[0] | (h[1] << 16); o.y = h[2] | (h[3] << 16); o.z = h[4] | (h[5] << 16); o.w = h[6] | (h[7] << 16);
            *(GAS v4u*)(ut4 + ((((size_t)b * 256 + cb * 32 + cpl) * 64 + t2b * 8 + t2l) * 2 + cq) * 64 + t1b * 8) = o; }
    }
    if (l == 0) {
        LAS bf16* tl = (LAS bf16*)F.lds;
        for (int j = F.bid; j < 256; j += F.G) {
            const int b = j >> 5, tb = (j >> 3) & 3, cb = j & 7; const size_t rowbase = (size_t)NL + b * 256 + tb * 64; bf16* dst = utc + (size_t)b * 512 * 256;
            __syncthreads();
            { const int t = F.tid >> 3, c8 = (F.tid & 7) * 8; const v4u w = *(const GAS v4u*)(uf + (rowbase + t) * 512 + cb * 64 + c8);
              LAS unsigned* p = (LAS unsigned*)(tl + t * 72 + c8); p[0] = w.x; p[1] = w.y; p[2] = w.z; p[3] = w.w; }
            __syncthreads();
            { const int c = F.tid >> 3, t8 = (F.tid & 7) * 8; v4u o; unsigned h[8];
#pragma unroll
              for (int q = 0; q < 8; ++q) h[q] = tl[(t8 + q) * 72 + c];
              o.x = h[0] | (h[1] << 16); o.y = h[2] | (h[3] << 16); o.z = h[4] | (h[5] << 16); o.w = h[6] | (h[7] << 16);
              *(GAS v4u*)(dst + (size_t)(cb * 64 + c) * 256 + tb * 64 + t8) = o; }
        }
    }
    __syncthreads();
}
constexpr int SC_XRAW = 0, SC_U32 = 17408, SC_UBF = SC_U32 + 32768, SC_YT = SC_UBF + 16384, SC_CW = SC_YT + 16384;
__device__ __forceinline__ float fast_sigmoid(float x) { return __builtin_amdgcn_rcpf(1.f + __expf(-x)); }
template <int PASS, int DIAG = 0> __device__ __forceinline__ void p_scan_fast(Frame& F, int l, int cvbase) {
    LAS unsigned char* lds = F.lds;
    const int tid = F.tid, lane = F.lane, w = F.wave, fr = lane & 15, fq = lane >> 4;
    const bf16* urnn = (const bf16*)(F.ws + WS_RB); const bf16* gate = (const bf16*)(F.ws + WS_RC); bf16* yout = (bf16*)(F.ws + WS_RA);
    float* SUM = (float*)(F.ws + WS_SUM); const float* CIN = (const float*)(F.ws + WS_CIN);
    const int h = F.bid & 7, qi = F.bid >> 3, nq = (F.G - h + 7) >> 3;
    bf16x8 bw[4][4];
    float bia[4];
    const unsigned wloff = (unsigned)((8 * fq) * 128 + 16 * w + fr) * 4u;
#pragma unroll
    for (int ty = 0; ty < 4; ++ty) { const int d = ty >> 1; const char* Wh = (const char*)(F.kin[(ty & 1) ? 12 : 10] + ((size_t)(l * 2 + d) * 8 + h) * 128 * 128);
#pragma unroll
        for (int ks = 0; ks < 4; ++ks) { float t8[8];
#pragma unroll
            for (int q = 0; q < 8; ++q) t8[q] = *(const GAS float*)(Wh + (size_t)(32 * ks + q) * 512 + wloff);
            const v4u pk = pack8(t8); bw[ty][ks] = __builtin_bit_cast(bf16x8, pk); }
        bia[ty] = F.kin[(ty & 1) ? 13 : 11][((size_t)(l * 2 + d) * 8 + h) * 128 + 16 * w + fr]; }
    const float n8f = ((const float*)(F.ws + WS_MODS + 512 * 1024))[(size_t)(l * 2 + 0) * 1024 + h * 128 + 16 * w + fr];
    const float n8b = ((const float*)(F.ws + WS_MODS + 512 * 1024))[(size_t)(l * 2 + 1) * 1024 + h * 128 + 16 * w + fr];
    { LAS float* CW = (LAS float*)(lds + SC_CW);
      for (int o = tid; o < 5 * 128; o += NTHR) CW[o] = o < 512 ? F.kin[8][(size_t)l * 4 * D + (size_t)(o >> 7) * D + h * 128 + (o & 127)] : F.kin[9][(size_t)l * D + h * 128 + (o & 127)]; }
    v4u raw[3];
#define SC_RAW_GEOM(PI) const int b_ = skipctx ? ((PI) >> 6) : (PI) / 68, j_ = skipctx ? 4 + ((PI) & 63) : (PI) % 68; const bool ic_ = j_ < 4; \
        const size_t r0_ = ic_ ? (size_t)NL + b_ * 256 + j_ * 64 : (size_t)b_ * 4096 + (size_t)(j_ - 4) * 64
#define SC_RAW_OK(q3) const int p_ = tid + (q3) * 512, rr_ = p_ >> 4, c16_ = p_ & 15, tt_ = rr_ - 2; bool ok_ = p_ < 68 * 16; \
        if (ic_) { const int g_ = j_ * 64 + tt_; ok_ = ok_ && g_ >= 0 && g_ < 256; } else ok_ = ok_ && tt_ >= 0 && tt_ < 64
#define SC_LOAD_RAW(PI) do { SC_RAW_GEOM(PI); _Pragma("unroll") for (int q3 = 0; q3 < 3; ++q3) { SC_RAW_OK(q3); raw[q3] = *(const GAS v4u*)(urnn + (r0_ + (ok_ ? tt_ : 0)) * D + h * 128 + c16_ * 8); } } while (0)
#define SC_WRITE_RAW(PI) do { SC_RAW_GEOM(PI); (void)r0_; _Pragma("unroll") for (int q3 = 0; q3 < 3; ++q3) { SC_RAW_OK(q3); (void)c16_; v4u v_ = raw[q3]; v_.x = ok_ ? v_.x : 0u; v_.y = ok_ ? v_.y : 0u; v_.z = ok_ ? v_.z : 0u; v_.w = ok_ ? v_.w : 0u; \
        if (p_ < 68 * 16) *(LAS v4u*)(lds + SC_XRAW + (p_ >> 4) * 256 + (p_ & 15) * 16) = v_; } } while (0)
    const bool skipctx = PASS == 2 && l == 1;
    const int npair = skipctx ? 512 : 544;
    constexpr int CV_PER_LAYER = 16 * 3 * 1024; LAS unsigned char* cvs = lds + 90112 + w * 4096; int cv_id = -1, cv_iter = 0;
#define CV_GEOM(ID) const int cl_ = (ID) / CV_PER_LAYER, cw_ = (ID) - cl_ * CV_PER_LAYER, ce_ = cw_ / 3072, cr_ = cw_ - ce_ * 3072, cm_ = cr_ >> 10, ckb_ = (cr_ >> 5) & 31, cnb_ = cr_ & 31
#define CV_ISSUE() do { const int id_ = cvbase + (cv_iter * F.G + F.bid) * NWAVES + w; ++cv_iter; cv_id = (cvbase >= 0 && id_ < 2 * CV_PER_LAYER) ? id_ : -1; \
        if (cv_id >= 0) { CV_GEOM(cv_id); const char* src_ = (const char*)(F.kin[21 + cm_] + ((size_t)(cl_ * 16 + ce_) * D + ckb_ * 32) * D + cnb_ * 32); \
            asm volatile("s_waitcnt lgkmcnt(0)" ::: "memory"); \
            _Pragma("unroll") for (int i_ = 0; i_ < 4; ++i_) __builtin_amdgcn_global_load_lds((const unsigned*)(src_ + (size_t)(8 * i_) * D * 4 + (unsigned)((lane >> 3) * D * 4 + (lane & 7) * 16)), (LAS unsigned*)(cvs + i_ * 1024), 16, 0, 0); } } while (0)
#define CV_CONSUME() do { if (cv_id >= 0) { CV_GEOM(cv_id); asm volatile("s_waitcnt vmcnt(0)" ::: "memory"); const int n_ = lane & 31, kq_ = lane >> 5; float t_[16]; \
            _Pragma("unroll") for (int j_ = 0; j_ < 16; ++j_) t_[j_] = *(const LAS float*)(cvs + (kq_ * 16 + j_) * 128 + n_ * 4) * MOE_WS; \
            const int n0_ = cnb_ * 32, drow_ = cm_ == 2 ? n0_ : ((n0_ >> 7) * 256 + (cm_ == 1 ? 128 : 0) + (n0_ & 127)); \
            unsigned char* dst_ = (unsigned char*)F.out + (size_t)cl_ * 16 * 3 * D * D + (size_t)ce_ * 3 * D * D + (cm_ == 2 ? (size_t)2 * D * D : 0) + (size_t)(drow_ + n_) * D + ckb_ * 32 + kq_ * 16; \
            *(GAS v4u*)dst_ = (v4u){pk4_fp8(t_[0], t_[1], t_[2], t_[3]), pk4_fp8(t_[4], t_[5], t_[6], t_[7]), pk4_fp8(t_[8], t_[9], t_[10], t_[11]), pk4_fp8(t_[12], t_[13], t_[14], t_[15])}; cv_id = -1; } } while (0)
    if (qi < npair) { SC_LOAD_RAW(qi); SC_WRITE_RAW(qi); { const int n1_ = qi + nq < npair ? qi + nq : qi; SC_LOAD_RAW(n1_); } }
    for (int pi = qi; pi < npair; pi += nq) {
        const int b = skipctx ? (pi >> 6) : pi / 68, j = skipctx ? 4 + (pi & 63) : pi % 68;
        const bool isctx = j < 4; const size_t row0 = isctx ? (size_t)NL + b * 256 + j * 64 : (size_t)b * 4096 + (size_t)(j - 4) * 64;
        __syncthreads();
        v4u gt0 = (v4u){0u, 0u, 0u, 0u}, gt1 = gt0; float cinf = 0.f, cinb = 0.f;
        if (PASS == 2) {
            cinf = CIN[(((size_t)b * 2 + 0) * 68 + j) * 1024 + h * 128 + 16 * w + fr]; cinb = CIN[(((size_t)b * 2 + 1) * 68 + j) * 1024 + h * 128 + 16 * w + fr]; }
        if constexpr (!(DIAG & 8))
        { const int t = tid >> 3, cg = tid & 7; const LAS float* CW = (const LAS float*)(lds + SC_CW); float u[16];
#if SC_CONV_BATCH
#pragma unroll
          for (int hh = 0; hh < 2; ++hh) { v4u xr[4]; f32x4 cwv[5][2];
#pragma unroll
              for (int k = 0; k < 4; ++k) xr[k] = *(const LAS v4u*)(lds + SC_XRAW + (t + k) * 256 + cg * 32 + hh * 16);
#pragma unroll
              for (int k = 0; k < 5; ++k) { cwv[k][0] = *(const LAS f32x4*)(CW + k * 128 + cg * 16 + hh * 8); cwv[k][1] = *(const LAS f32x4*)(CW + k * 128 + cg * 16 + hh * 8 + 4); }
              asm volatile("s_waitcnt lgkmcnt(0)" ::: "memory"); __builtin_amdgcn_sched_barrier(0);
#pragma unroll
              for (int q = 0; q < 8; ++q) u[hh * 8 + q] = cwv[4][q >> 2][q & 3];
#pragma unroll
              for (int k = 0; k < 4; ++k) { float x[8]; unpack8(xr[k], x);
#pragma unroll
                  for (int q = 0; q < 8; ++q) u[hh * 8 + q] += cwv[k][q >> 2][q & 3] * x[q]; }
              __builtin_amdgcn_sched_barrier(0); }
#else
#pragma unroll
          for (int q = 0; q < 16; ++q) u[q] = CW[512 + cg * 16 + q];
#pragma unroll
          for (int k = 0; k < 4; ++k) { float x[16]; unpack8(*(const LAS v4u*)(lds + SC_XRAW + (t + k) * 256 + cg * 32), x); unpack8(*(const LAS v4u*)(lds + SC_XRAW + (t + k) * 256 + cg * 32 + 16), x + 8);
#pragma unroll
              for (int q = 0; q < 16; ++q) u[q] += CW[k * 128 + cg * 16 + q] * x[q]; }
#endif
#pragma unroll
          for (int q = 0; q < 4; ++q) *(LAS f32x4*)(lds + SC_U32 + t * 512 + cg * 64 + q * 16) = (f32x4){u[4 * q], u[4 * q + 1], u[4 * q + 2], u[4 * q + 3]};
          const int ft = (t & 3) | (((t >> 4) & 3) << 2);
          *(LAS v4u*)(lds + SC_UBF + t * 256 + (((cg * 2) ^ ft) << 4)) = pack8(u); *(LAS v4u*)(lds + SC_UBF + t * 256 + (((cg * 2 + 1) ^ ft) << 4)) = pack8(u + 8); }
        __syncthreads();
        if (PASS == 2) asm volatile("" : "+v"(cinf), "+v"(cinb));
        { const int n1_ = pi + nq < npair ? pi + nq : pi; SC_WRITE_RAW(n1_); }
        CV_CONSUME();
        { const int n2_ = pi + 2 * nq < npair ? pi + 2 * nq : pi; SC_LOAD_RAW(n2_); }
        CV_ISSUE();
        const int c = 16 * w + fr;
        float hs[16], uu[16];
#pragma unroll
        for (int d = 0; d < 2; ++d) {
            f32x4 acc[2][4];
#pragma unroll
            for (int ty = 0; ty < 2; ++ty)
#pragma unroll
                for (int m = 0; m < 4; ++m) acc[ty][m] = (f32x4){0.f, 0.f, 0.f, 0.f};
            if (PASS == 2 && d == 1) { __builtin_amdgcn_sched_barrier(0); const bf16* gp = gate + (row0 + (tid >> 3)) * D + h * 128 + (tid & 7) * 16; gt0 = *(const GAS v4u*)gp; gt1 = *(const GAS v4u*)(gp + 8); }
            if (d == 0) {
#pragma unroll
                for (int q = 0; q < 16; ++q) uu[q] = *(const LAS float*)(lds + SC_U32 + (16 * fq + q) * 512 + c * 4); }
            if constexpr (!(DIAG & 4))
            { bf16x8 af[4][4];
#pragma unroll
              for (int m = 0; m < 4; ++m) { const int tau = 16 * (fr >> 2) + 4 * m + (fr & 3);
#pragma unroll
                  for (int ks = 0; ks < 4; ++ks) af[m][ks] = *(const LAS bf16x8*)(lds + SC_UBF + tau * 256 + (((4 * ks + fq) ^ fr) << 4)); }
              asm volatile("s_waitcnt lgkmcnt(0)" ::: "memory"); __builtin_amdgcn_sched_barrier(0);
#pragma unroll
              for (int m = 0; m < 4; ++m)
#pragma unroll
                  for (int ks = 0; ks < 4; ++ks) { acc[0][m] = __builtin_amdgcn_mfma_f32_16x16x32_bf16(af[m][ks], bw[2 * d][ks], acc[0][m], 0, 0, 0); acc[1][m] = __builtin_amdgcn_mfma_f32_16x16x32_bf16(af[m][ks], bw[2 * d + 1][ks], acc[1][m], 0, 0, 0); }
              __builtin_amdgcn_sched_barrier(0); }
            float av[16], bv[16]; const float n8 = d ? n8b : n8f, b_a = bia[2 * d], b_x = bia[2 * d + 1];
            typedef float f32x2 __attribute__((ext_vector_type(2)));
            const float nl2 = -1.4426950408889634f, n8l2 = n8 * 1.4426950408889634f, n82 = 2.f * n8;
            if constexpr (DIAG & 2) {
#pragma unroll
                for (int q = 0; q < 16; ++q) { av[q] = acc[0][q >> 2][q & 3] * n8l2 + nl2; bv[q] = acc[1][q >> 2][q & 3] * uu[q] + n82; }
            } else {
#pragma unroll
            for (int p2 = 0; p2 < 8; ++p2) { const int q0 = 2 * p2, q1 = q0 + 1;
                f32x2 ta = ((f32x2){acc[0][q0 >> 2][q0 & 3], acc[0][q1 >> 2][q1 & 3]} + b_a) * nl2, tx = ((f32x2){acc[1][q0 >> 2][q0 & 3], acc[1][q1 >> 2][q1 & 3]} + b_x) * nl2;
                ta.x = fminf(ta.x, 40.f); ta.y = fminf(ta.y, 40.f); tx.x = fminf(tx.x, 40.f); tx.y = fminf(tx.y, 40.f);
                const f32x2 da = (f32x2){__builtin_amdgcn_exp2f(ta.x), __builtin_amdgcn_exp2f(ta.y)} + 1.f, dx = (f32x2){__builtin_amdgcn_exp2f(tx.x), __builtin_amdgcn_exp2f(tx.y)} + 1.f;
                const f32x2 pr = da * dx; const f32x2 inv = (f32x2){__builtin_amdgcn_rcpf(pr.x), __builtin_amdgcn_rcpf(pr.y)};
                const f32x2 r = dx * inv, ig = da * inv;
                const f32x2 l2 = r * n8l2; const f32x2 a = (f32x2){__builtin_amdgcn_exp2f(l2.x), __builtin_amdgcn_exp2f(l2.y)};
                const f32x2 y2 = r * n82;
                const f32x2 ser = -(y2 * (y2 * (y2 * (1.f / 6.f) + 0.5f) + 1.f)), dif = 1.f - a * a;
                f32x2 om; om.x = y2.x > -0.02f ? ser.x : dif.x; om.y = y2.y > -0.02f ? ser.y : dif.y;
                const f32x2 bb = (f32x2){__builtin_amdgcn_sqrtf(om.x), __builtin_amdgcn_sqrtf(om.y)} * ig * (f32x2){uu[q0], uu[q1]};
                av[q0] = a.x; av[q1] = a.y; bv[q0] = bb.x; bv[q1] = bb.y;
                if (p2 & 1) __builtin_amdgcn_sched_barrier(0); }
            }
            float P = 1.f, H = 0.f;
#pragma unroll
            for (int q = 0; q < 16; ++q) { const int t = d ? 15 - q : q; H = av[t] * H + bv[t]; P *= av[t]; }
            float Ps[4], Hs[4];
#pragma unroll
            for (int sgi = 0; sgi < 4; ++sgi) { Ps[sgi] = __builtin_bit_cast(float, __builtin_amdgcn_ds_bpermute(((sgi << 4) | fr) << 2, __builtin_bit_cast(int, P)));
                                              Hs[sgi] = __builtin_bit_cast(float, __builtin_amdgcn_ds_bpermute(((sgi << 4) | fr) << 2, __builtin_bit_cast(int, H))); }
            if (PASS == 1) {
                float Pt = 1.f, Ht = 0.f;
#pragma unroll
                for (int q = 0; q < 4; ++q) { const int sgi = d ? 3 - q : q; Ht = Ps[sgi] * Ht + Hs[sgi]; Pt *= Ps[sgi]; }
                if (fq == 0) { float* dst = SUM + ((((size_t)b * 2 + d) * 68 + j) * 2) * 1024 + h * 128 + c; dst[0] = Pt; dst[1024] = Ht; }
            } else {
                float cin = d ? cinb : cinf;
#pragma unroll
                for (int q = 0; q < 3; ++q) { const int sgi = d ? 3 - q : q; const bool before = d ? (sgi > fq) : (sgi < fq); if (before) cin = Ps[sgi] * cin + Hs[sgi]; }
                float hh = cin;
#pragma unroll
                for (int q = 0; q < 16; ++q) { const int t = d ? 15 - q : q; hh = av[t] * hh + bv[t]; if (d == 0) hs[t] = hh; else hs[t] += hh; }
            }
        }
        if constexpr (PASS == 2 && (DIAG & 1)) {
#pragma unroll
            for (int q = 0; q < 16; ++q) asm volatile("" :: "v"(hs[q]));
            asm volatile("" :: "v"(gt0), "v"(gt1));
        } else
        if (PASS == 2) {
#pragma unroll
            for (int q = 0; q < 16; ++q) *(LAS bf16*)(lds + SC_YT + (16 * fq + q) * 256 + c * 2) = (bf16)f2bf(hs[q]);
            __syncthreads();
            { const int t = tid >> 3, cg = tid & 7; float yv[16], gv[16];
              unpack8(*(const LAS v4u*)(lds + SC_YT + t * 256 + cg * 32), yv); unpack8(*(const LAS v4u*)(lds + SC_YT + t * 256 + cg * 32 + 16), yv + 8);
              unpack8(gt0, gv); unpack8(gt1, gv + 8);
#pragma unroll
              for (int q = 0; q < 16; ++q) yv[q] *= gv[q];
              bf16* yp = yout + (row0 + t) * D + h * 128 + cg * 16; *(GAS v4u*)yp = pack8(yv); *(GAS v4u*)(yp + 8) = pack8(yv + 8); }
        }
    }
    CV_CONSUME();
#undef CV_GEOM
#undef CV_ISSUE
#undef CV_CONSUME
#undef SC_LOAD_RAW
#undef SC_WRITE_RAW
#undef SC_RAW_GEOM
#undef SC_RAW_OK
    __syncthreads();
}
__device__ __forceinline__ void p_scan_carry(Frame& F) {
    const float* SUM = (const float*)(F.ws + WS_SUM); float* CIN = (float*)(F.ws + WS_CIN);
    for (int g = F.bid * NTHR + F.tid; g < 8 * 2 * 1024; g += F.G * NTHR) {
        const int b = g >> 11, d = (g >> 10) & 1, ch = g & 1023; float cst = 0.f;
        const float* sp = SUM + (((size_t)b * 2 + d) * 68) * 2 * 1024 + ch; float* cp = CIN + (((size_t)b * 2 + d) * 68) * 1024 + ch;
#pragma unroll 4
        for (int step = 0; step < 68; ++step) { const int j = d == 0 ? step : (step < 4 ? 3 - step : 71 - step);
            const float P = sp[(size_t)j * 2048], H = sp[(size_t)j * 2048 + 1024]; cp[(size_t)j * 1024] = cst; cst = P * cst + H; }
    }
}

__device__ __forceinline__ size_t moe_w_off(int l) { return l == 0 ? WS_CSL : WS_MOEW; }
__device__ __forceinline__ void p_moe_wconv(Frame& F, int l, int wg0) {
    __syncthreads();
    if (F.bid >= wg0)
    { const int gw = (F.bid - wg0) * NWAVES + F.wave, NGW = (F.G - wg0) * NWAVES; LAS float* scr = (LAS float*)(F.lds + F.wave * 16384);
      unsigned char* mw = F.ws + moe_w_off(l);
      for (int it = gw; it < 16 * 3 * 512; it += NGW) { const int e = it / 1536, rem = it % 1536, m = rem / 512, q = rem % 512, kb = q >> 5, nb = q & 31;
          const float* W = F.kin[m == 0 ? 21 : m == 1 ? 22 : 23] + ((size_t)l * 16 + e) * D * D; unsigned char* dst = mw + (size_t)e * 3 * D * D + (m == 2 ? (size_t)2 * D * D : 0);
          const int n0 = nb * 32; const int drow = m == 2 ? n0 : ((n0 >> 7) * 256 + (m == 1 ? 128 : 0) + (n0 & 127));
          transpose_item<1>(W, D, D, (bf16*)dst, kb * 64, n0, drow, scr, F.lane); } }
}
__device__ __forceinline__ void moe_table(Frame& F, int l, LAS int* ts, LAS int* cn) {
    __syncthreads();
    if (F.tid < 16) cn[F.tid] = (int)__hip_atomic_load(F.ctl + CW_CNT + 64 * l + F.tid, __ATOMIC_RELAXED, __HIP_MEMORY_SCOPE_AGENT);
    __syncthreads();
    if (F.tid == 0) { int acc = 0;
        for (int e = 0; e < 16; ++e) { ts[e] = acc; acc += (cn[e] + 255) >> 8; }
        ts[16] = acc; }
    __syncthreads();
}

constexpr int NPH = 24;
struct Args { const float* in[25]; float* out; unsigned char* ws; int ph_lo, ph_hi; };
__global__ void __launch_bounds__(NTHR, 2) fwd_kernel(Args args) {
    extern __shared__ __attribute__((aligned(16))) unsigned char lds[];
    Frame F;
    F.lds = (LAS unsigned char*)lds; F.tid = threadIdx.x; F.lane = F.tid & 63; F.wave = __builtin_amdgcn_readfirstlane(F.tid >> 6);
    F.G = gridDim.x; F.bid = blockIdx.x; F.ws = args.ws; F.out = args.out; F.ctl = (unsigned*)(args.ws + WS_CTL);
    F.kin = (const float* const __attribute__((address_space(4)))*)__builtin_amdgcn_kernarg_segment_ptr();
    volatile LAS unsigned* MISC = (volatile LAS unsigned*)(F.lds + MISC_OFF);
    if (F.tid < 32) MISC[F.tid] = 0u;
    __syncthreads();
    XcdBarrier bar; bar.bar = F.ctl + CW_BAR; bar.x = 0; bar.st = nullptr;
    if (MK_N_LAUNCHES == 1) bar = xcd_barrier_post(F.ctl + CW_BAR, MISC + 8);
    LAS int* ts = (LAS int*)(F.lds + MISC_OFF + 256); LAS int* cn = ts + 32;
    const int lo = args.ph_lo, hi = args.ph_hi;
#ifndef SITE_MASK
#define SITE_MASK 0xfffffu
#endif
#define SITE(j) (((SITE_MASK) >> (j)) & 1u)
#ifndef REP_MASK
#define REP_MASK 0u
#endif
#define IN(k) (lo <= (k) && (k) < hi)
#define LAUNDER() do { asm volatile("v_mbcnt_lo_u32_b32 %0, -1, 0\n\tv_mbcnt_hi_u32_b32 %0, -1, %0" : "=v"(F.lane)); asm volatile("" : "+s"(F.ws), "+s"(F.out), "+s"(F.kin), "+s"(F.ctl), "+s"(F.lds), "+s"(F.wave), "+s"(F.bid), "+s"(F.G), "+v"(F.lane)); F.tid = F.wave * 64 + F.lane; } while (0)
#define TWICE(j, stmt) do { stmt; if (((REP_MASK) >> (j)) & 1u) { __syncthreads(); LAUNDER(); stmt; } } while (0)
#define SEAM(k) do { if (MK_N_LAUNCHES == 1 && IN((k) + 1)) xcd_barrier(bar); } while (0)

    if (SITE(0) && IN(0)) { LAUNDER(); TWICE(0, p_prologue(F)); SEAM(0); }
    for (int l = 0; l < 2; ++l) {
        const int pb = 1 + 11 * l;
        if (SITE(1) && IN(pb + 0)) { LAUNDER(); p_rows<0>(F, l); if (((REP_MASK >> 1) & 1u) && l == 0) { __syncthreads(); LAUNDER(); p_rows<0>(F, 0); } SEAM(pb + 0); }
        if (SITE(2) && IN(pb + 1)) { LAUNDER();
            PInproj p; p.G = F.G; p.c = F.bid; p.l = l; p.hx = (const bf16*)(F.ws + WS_RA); p.wt = (const bf16*)(F.ws + WS_WIN) + (size_t)l * INW * D;
            p.urnn = (bf16*)(F.ws + WS_RB); p.gate = (bf16*)(F.ws + WS_RC);
#ifdef STAGGER_US
            { const unsigned long long t0 = __builtin_amdgcn_s_memrealtime(); const unsigned dl = (unsigned)(F.bid & 3) * (STAGGER_US * 100u); while (__builtin_amdgcn_s_memrealtime() - t0 < dl) __builtin_amdgcn_s_sleep(8); }
#endif
            TWICE(2, fast_gemm_phase(F, p));
            LAUNDER();
            PFourT ft; ft.G = F.G; ft.c = F.bid; ft.l = l; ft.rot = p.count() % F.G; ft.hx = p.hx; ft.wt = p.wt; ft.ut4 = (bf16*)(F.ws + WS_RG); ft.utc = (bf16*)(F.ws + WS_UTC);
            fast_gemm_phase(F, ft);
            LAUNDER();
            PInproj8 q; q.G = F.G; q.c = F.bid; q.npan = l == 1 ? NL / 256 : NPAN; q.rot = (p.count() + ft.count()) % F.G; q.hx8 = F.ws + WS_CSL; q.wt8 = F.ws + WS_WIN + ((size_t)l * INW * D + (size_t)2560 * D) * 2;
            q.sgr = (bf16*)(F.ws + WS_RD); q.sgf = (bf16*)(F.ws + WS_RE);
            TWICE(2, fast_gemm_phase(F, q));
            if (l == 0) { LAUNDER(); PFold f; f.first = F.G - 32; f.c = F.bid; f.wft = (const bf16*)(F.ws + WS_LRU); f.fb = (const bf16*)(F.ws + WS_CSC + 768 * 1024); f.wf = (bf16*)(F.ws + WS_WF); fast_gemm_phase(F, f); }
            SEAM(pb + 1); }
        if (SITE(3) && IN(pb + 2)) { LAUNDER(); TWICE(3, p_scan_fast<1>(F, l, (2 * l) * 34816)); SEAM(pb + 2); }
        if (SITE(4) && IN(pb + 3)) { LAUNDER(); TWICE(4, p_scan_carry(F)); LAUNDER();
            PFftA p; p.G = F.G; p.c = F.bid; p.fa = (const bf16*)(F.ws + WS_CSC + 256 * 1024); p.ut4 = (const bf16*)(F.ws + WS_RG); p.zt = (bf16*)(F.ws + WS_CSL);
            fast_gemm_phase(F, p); SEAM(pb + 3); }
        if (SITE(5) && IN(pb + 4)) { LAUNDER();
#ifndef ONLY_SCAN2
            { PFftC p; p.G = F.G; p.c = F.bid; p.fc = (const bf16*)(F.ws + WS_CSC + 512 * 1024); p.zt = (const bf16*)(F.ws + WS_CSL); p.g = (bf16*)(F.ws + WS_RH);
              TWICE(5, fast_gemm_phase(F, p)); }
            if (l == 0) { LAUNDER();
              PDft p; p.G = F.G; p.c = F.bid; p.csc = (const bf16*)(F.ws + WS_CSC); p.ut = (const bf16*)(F.ws + WS_UTC); p.g = (bf16*)(F.ws + WS_RH);
              fast_gemm_phase(F, p); }
#endif
            LAUNDER(); TWICE(6, p_scan_fast<2>(F, l, (2 * l + 1) * 34816));
#ifdef REP6_N
            for (int rep_ = 0; rep_ < REP6_N; ++rep_) { __syncthreads(); LAUNDER(); p_scan_fast<2, REP6_DIAG>(F, l, -1); }
#endif
            SEAM(pb + 5); }
        if (SITE(7) && IN(pb + 6)) { LAUNDER();
            PMerge p; p.G = F.G; p.c = F.bid; p.npan = l == 1 ? NL / 256 : NPAN;     p.gm = (const bf16*)(F.ws + WS_RH); p.y = (const bf16*)(F.ws + WS_RA); p.wf = (const bf16*)(F.ws + WS_WF) + (size_t)l * D * D; p.wr = (const bf16*)(F.ws + WS_WR) + (size_t)l * D * D;
            p.sgr = (const bf16*)(F.ws + WS_RD); p.sgf = (const bf16*)(F.ws + WS_RE); p.mg = (bf16*)(F.ws + WS_RC);
            TWICE(7, fast_gemm_phase(F, p));
            SEAM(pb + 6); }
        if (SITE(8) && IN(pb + 7)) { LAUNDER();
            PWout p; p.G = F.G; p.c = F.bid; p.npan = l == 1 ? NL / 256 : NPAN; p.mg = (const bf16*)(F.ws + WS_RC); p.wo = (const bf16*)(F.ws + WS_WO) + (size_t)l * D * D;
            p.l = l; p.xold_l = F.kin[0]; p.xold_c = F.kin[2]; p.xs = (bf16*)(F.ws + WS_XS); p.g1 = modp(F, l, 0, 2);
            TWICE(8, fast_gemm_phase(F, p)); SEAM(pb + 7); }
        if (SITE(9) && IN(pb + 8)) { LAUNDER(); p_rows<1>(F, l); if ((REP_MASK >> 13) & 1u) { __syncthreads(); LAUNDER(); p_rows<1>(F, l, 1); } SEAM(pb + 8); }
        if (SITE(10) && IN(pb + 9)) { LAUNDER();
            moe_table(F, l, ts, cn);
            PMoe1 p; p.G = F.G; p.c = F.bid; p.hx2 = F.ws + WS_RA; p.w = (const unsigned char*)F.out + (size_t)l * 16 * 3 * D * D; p.list = (const int2*)(F.ws + WS_LIST); p.he = F.ws + WS_HE; p.ts = ts; p.cn = cn;
            TWICE(10, fast_gemm_phase(F, p)); SEAM(pb + 9); }
        if (SITE(11) && IN(pb + 10)) { LAUNDER();
            moe_table(F, l, ts, cn);
            PMoe2 p; p.G = F.G; p.c = F.bid; p.he = F.ws + WS_HE; p.w = (const unsigned char*)F.out + (size_t)l * 16 * 3 * D * D; p.list = (const int2*)(F.ws + WS_LIST); p.c01 = F.ws + WS_C01; p.ts = ts; p.cn = cn;
            TWICE(11, fast_gemm_phase(F, p)); SEAM(pb + 10); }
    }
    if (SITE(12) && IN(23)) { LAUNDER(); p_rows<2>(F, 1); }
#undef IN
#undef SEAM
}

extern "C" void kernel_launch(void* const* d_in, const int* in_sizes, int n_in, void* d_out, int out_size, void* d_ws, size_t ws_size, hipStream_t stream) {
    static int grid = 0;
    if (grid == 0) {
        if (n_in != 25 || out_size != NL * D || ws_size < WS_END2) { fprintf(stderr, "kernel_launch: unexpected shapes (n_in %d, out %d, ws %zu)\n", n_in, out_size, ws_size); grid = -1; return; }
        int dev = 0, cus = 0, per_cu = 0;
        if (hipGetDevice(&dev) != hipSuccess || hipDeviceGetAttribute(&cus, hipDeviceAttributeMultiprocessorCount, dev) != hipSuccess) { grid = -1; return; }
        if (hipFuncSetAttribute((const void*)fwd_kernel, hipFuncAttributeMaxDynamicSharedMemorySize, LDS_BYTES) != hipSuccess) { fprintf(stderr, "kernel_launch: hipFuncSetAttribute failed\n"); grid = -1; return; }
        if (hipOccupancyMaxActiveBlocksPerMultiprocessor(&per_cu, (const void*)fwd_kernel, NTHR, LDS_BYTES) != hipSuccess || per_cu < 1) { fprintf(stderr, "kernel_launch: occupancy query says %d\n", per_cu); }
        (void)hipGetLastError();
        grid = cus < 256 ? cus : 256;
    }
    if (grid < 0) return;
    (void)hipMemsetAsync((char*)d_ws + WS_CTL, 0, CTL_ZERO_BYTES, stream);
    Args a{};
    for (int i = 0; i < 25; ++i) a.in[i] = (const float*)d_in[i];
    a.out = (float*)d_out; a.ws = (unsigned char*)d_ws;
    if (MK_N_LAUNCHES == 1) { a.ph_lo = 0; a.ph_hi = NPH; hipLaunchKernelGGL(fwd_kernel, dim3(grid), dim3(NTHR), LDS_BYTES, stream, a); }
    else for (int p = 0; p < NPH; ++p) { a.ph_lo = p; a.ph_hi = p + 1; hipLaunchKernelGGL(fwd_kernel, dim3(grid), dim3(NTHR), LDS_BYTES, stream, a); }
}
```

```cpp
#include <hip/hip_runtime.h>
#include <cstdio>
#include <cstdint>

#ifndef SC_CONV_BATCH
#define SC_CONV_BATCH 1
#endif
#ifndef REP6_DIAG
#define REP6_DIAG 0
#endif
#ifndef MK_N_LAUNCHES
#define MK_N_LAUNCHES 1
#endif

#define GAS __attribute__((address_space(1)))
#define LAS __attribute__((address_space(3)))
typedef unsigned short bf16;
typedef unsigned v4u __attribute__((ext_vector_type(4)));
typedef unsigned v2u __attribute__((ext_vector_type(2)));
typedef float f32x4 __attribute__((ext_vector_type(4)));
typedef double f64x2z __attribute__((ext_vector_type(2)));
__device__ __forceinline__ f32x4 zero4() { double a, b; asm volatile("v_mov_b64 %0, 0" : "=v"(a)); asm volatile("v_mov_b64 %0, 0" : "=v"(b)); return __builtin_bit_cast(f32x4, (f64x2z){a, b}); }
typedef short bf16x8 __attribute__((ext_vector_type(8)));

constexpr int D = 1024, NB = 8, SEQ = 4096, CTX = 256, NL = NB * SEQ, NC = NB * CTX, NT = NL + NC;
constexpr int NPAN = NT / 256;
constexpr int INW = 4608, NE = 16, NMOD = 6;
constexpr float RMS_EPS = 1e-6f;
constexpr int NWAVES = 8, NTHR = 512;

constexpr size_t MiB = 1u << 20;
constexpr size_t WS_CTL = 0, CTL_ZERO_BYTES = 32768;
constexpr size_t WS_MODS = 1 * MiB;
constexpr size_t WS_WIN = 2 * MiB;
constexpr size_t WS_WR = 20 * MiB, WS_WF = 24 * MiB, WS_WO = 28 * MiB;
constexpr size_t WS_LRU = 32 * MiB;
constexpr size_t WS_GW = 38 * MiB;
constexpr size_t WS_CSC = 34 * MiB;
constexpr size_t WS_UTC = 35 * MiB;
constexpr size_t WS_LIST = 43 * MiB;
constexpr size_t WS_CSL = 48 * MiB;
constexpr size_t WS_RA = 112 * MiB;
constexpr size_t WS_RB = 180 * MiB;
constexpr size_t WS_RC = 248 * MiB;
constexpr size_t WS_RD = 316 * MiB;
constexpr size_t WS_RE = 384 * MiB;
constexpr size_t WS_RF = 452 * MiB;
constexpr size_t WS_RG = 486 * MiB;
constexpr size_t WS_RH = 452 * MiB;
constexpr size_t WS_XS = 520 * MiB;
constexpr size_t WS_END = 588 * MiB;
constexpr size_t WS_MOEW = 180 * MiB;
constexpr size_t WS_HE = 276 * MiB;
constexpr size_t WS_C01 = 384 * MiB;
constexpr size_t WS_SUM = 588 * MiB;
constexpr size_t WS_CIN = 597 * MiB;
constexpr size_t WS_END2 = 602 * MiB;
static_assert(WS_C01 + (size_t)2 * NT * D * 2 <= WS_XS && WS_XS + (size_t)NT * D * 2 <= WS_END, "map");
static_assert(WS_RA + (size_t)NT * D * 2 <= WS_RB && WS_RH + (size_t)NT * D * 2 <= WS_XS, "map");

constexpr int CW_TMO = 0;
constexpr int CW_CNT = 64;
constexpr int CW_BAR = 4096;

constexpr int LDS_BYTES = 147456;
constexpr int MISC_OFF = 131072 + 8192;

__device__ __forceinline__ unsigned f2bf(float f) { unsigned u = __builtin_bit_cast(unsigned, f); return (u + 0x7fffu + ((u >> 16) & 1u)) >> 16; }
typedef float f32x2c __attribute__((ext_vector_type(2))); typedef __bf16 bf16x2c __attribute__((ext_vector_type(2)));
__device__ __forceinline__ unsigned pk2(float lo, float hi) { const f32x2c v = {lo, hi}; return __builtin_bit_cast(unsigned, __builtin_convertvector(v, bf16x2c)); }
__device__ __forceinline__ float bflo(unsigned w) { return __builtin_bit_cast(float, w << 16); }
__device__ __forceinline__ float bfhi(unsigned w) { return __builtin_bit_cast(float, w & 0xffff0000u); }
__device__ __forceinline__ float bf2f(bf16 h) { return __builtin_bit_cast(float, ((unsigned)h) << 16); }
__device__ __forceinline__ v4u pack8(const float* v) { v4u o; o.x = pk2(v[0], v[1]); o.y = pk2(v[2], v[3]); o.z = pk2(v[4], v[5]); o.w = pk2(v[6], v[7]); return o; }
__device__ __forceinline__ void unpack8(v4u w, float* v) { v[0] = bflo(w.x); v[1] = bfhi(w.x); v[2] = bflo(w.y); v[3] = bfhi(w.y); v[4] = bflo(w.z); v[5] = bfhi(w.z); v[6] = bflo(w.w); v[7] = bfhi(w.w); }
__device__ __forceinline__ float sigmoidf_(float x) { return __builtin_amdgcn_rcpf(1.f + __expf(-x)); }
__device__ __forceinline__ float siluf_(float x) { return x * __builtin_amdgcn_rcpf(1.f + __expf(-x)); }
typedef float f32x2 __attribute__((ext_vector_type(2)));
__device__ __forceinline__ f32x2 sigmoid_pk_t(f32x2 t) {
    const f32x2 d = (f32x2){__builtin_amdgcn_exp2f(t.x), __builtin_amdgcn_exp2f(t.y)} + 1.f;
    return (f32x2){__builtin_amdgcn_rcpf(d.x), __builtin_amdgcn_rcpf(d.y)};
}
__device__ __forceinline__ f32x2 sigmoid_pk(f32x2 x) { return sigmoid_pk_t(x * (-1.4426950408889634f)); }
__device__ __forceinline__ f32x2 sigmoid_pk_s(f32x2 x, float sc, float os) {
    const f32x2 t = x * (-1.4426950408889634f * sc); const float ios = 1.f / os;
    const f32x2 d = (f32x2){__builtin_amdgcn_exp2f(t.x), __builtin_amdgcn_exp2f(t.y)} * ios + ios;
    return (f32x2){__builtin_amdgcn_rcpf(d.x), __builtin_amdgcn_rcpf(d.y)};
}
__device__ __forceinline__ f32x2 gelu_pk(f32x2 x) { return x * sigmoid_pk_t(x * (x * x * (0.044715f * 1.5957691216057308f * -1.4426950408889634f) + 1.5957691216057308f * -1.4426950408889634f)); }
__device__ __forceinline__ f32x2 silu_pk(f32x2 x) { return x * sigmoid_pk(x); }
typedef int v8i __attribute__((ext_vector_type(8)));
typedef int v4i __attribute__((ext_vector_type(4)));
__device__ __forceinline__ float sat8(float x) { return __builtin_amdgcn_fmed3f(x, -448.f, 448.f); }
__device__ __forceinline__ unsigned pk4_fp8(float a, float b, float c, float d) { const int p = __builtin_amdgcn_cvt_pk_fp8_f32(sat8(a), sat8(b), 0, false); return (unsigned)__builtin_amdgcn_cvt_pk_fp8_f32(sat8(c), sat8(d), p, true); }
__device__ __forceinline__ v2u pk8_fp8s(const float* v, float sc) {
    const f32x2 p0 = (f32x2){v[0], v[1]} * sc, p1 = (f32x2){v[2], v[3]} * sc, p2 = (f32x2){v[4], v[5]} * sc, p3 = (f32x2){v[6], v[7]} * sc;
    return (v2u){pk4_fp8(p0.x, p0.y, p1.x, p1.y), pk4_fp8(p2.x, p2.y, p3.x, p3.y)}; }
__device__ __forceinline__ v4u swap8_pair(v2u x, v2u y) {
    const auto r0 = __builtin_amdgcn_permlane16_swap(x.x, y.x, false, false), r1 = __builtin_amdgcn_permlane16_swap(x.y, y.y, false, false);
    return (v4u){r0[0], r1[0], r0[1], r1[1]};
}
__device__ __forceinline__ v2u pk8_u8(const float* v) { unsigned a = 0u, b = 0u;
    a = __builtin_amdgcn_cvt_pk_u8_f32(v[0], 0, a); a = __builtin_amdgcn_cvt_pk_u8_f32(v[1], 1, a); a = __builtin_amdgcn_cvt_pk_u8_f32(v[2], 2, a); a = __builtin_amdgcn_cvt_pk_u8_f32(v[3], 3, a);
    b = __builtin_amdgcn_cvt_pk_u8_f32(v[4], 0, b); b = __builtin_amdgcn_cvt_pk_u8_f32(v[5], 1, b); b = __builtin_amdgcn_cvt_pk_u8_f32(v[6], 2, b); b = __builtin_amdgcn_cvt_pk_u8_f32(v[7], 3, b);
    return (v2u){a, b}; }
__device__ __forceinline__ void unpack8_u8(v2u w, float* f) {
#pragma unroll
    for (int j = 0; j < 4; ++j) { f[j] = (float)((w.x >> (8 * j)) & 255u); f[4 + j] = (float)((w.y >> (8 * j)) & 255u); } }
__device__ __forceinline__ v8i cat8(bf16x8 a, bf16x8 b) { return __builtin_shufflevector(__builtin_bit_cast(v4i, a), __builtin_bit_cast(v4i, b), 0, 1, 2, 3, 4, 5, 6, 7); }
constexpr float MOE_WS = 32.f, MOE_HS = 8.f, MOE_CS = 32.f;
__device__ __forceinline__ float gelu_tanh(float x) { const float u = 0.7978845608028654f * (x + 0.044715f * x * x * x); const float e = __expf(2.f * u); const float t = 1.f - 2.f * __builtin_amdgcn_rcpf(e + 1.f); return 0.5f * x * (1.f + t); }
__device__ __forceinline__ float wave_sum(float v, int  ) {
#define WS_DPP(x, ctrl) __builtin_bit_cast(float, __builtin_amdgcn_update_dpp(0, __builtin_bit_cast(int, (x)), (ctrl), 0xF, 0xF, true))
    v += WS_DPP(v, 0xB1); v += WS_DPP(v, 0x4E); v += WS_DPP(v, 0x141); v += WS_DPP(v, 0x140);
#undef WS_DPP
    const int vi = __builtin_bit_cast(int, v);
    return (__builtin_bit_cast(float, __builtin_amdgcn_readlane(vi, 0)) + __builtin_bit_cast(float, __builtin_amdgcn_readlane(vi, 16))) +
           (__builtin_bit_cast(float, __builtin_amdgcn_readlane(vi, 32)) + __builtin_bit_cast(float, __builtin_amdgcn_readlane(vi, 48)));
}
#define LDS_WAIT() asm volatile("s_waitcnt lgkmcnt(0)" ::: "memory")
#define VM_WAIT() asm volatile("s_waitcnt vmcnt(0)" ::: "memory")

#define XB_TMO      128
#define XB_XCNT(j)  (256  + 64 * (j))
#define XB_XSUB(j)  (1280 + 64 * (j))
#define XB_XGEN(j)  (2304 + 64 * (j))
#define XB_TOP      3328
#define XB_TOPGEN   3392
#define XCD_BAR_WORDS 3456
#define XB_SPIN_CAP (1u << 18)
__device__ __forceinline__ unsigned xb_ld(unsigned* p)              { return __hip_atomic_load(p, __ATOMIC_RELAXED, __HIP_MEMORY_SCOPE_AGENT); }
__device__ __forceinline__ unsigned xb_add(unsigned* p, unsigned v) { return __hip_atomic_fetch_add(p, v, __ATOMIC_RELAXED, __HIP_MEMORY_SCOPE_AGENT); }
__device__ __forceinline__ unsigned xb_xcc_id() { return (unsigned)__builtin_amdgcn_s_getreg((3 << 11) | 20) & 0xFu; }
#define XB_SPIN(cond, bar) do { unsigned _sp = 0; while (cond) { __builtin_amdgcn_s_sleep(1); \
    if ((++_sp & 255u) == 0u) { if (xb_ld(&(bar)[XB_TMO])) break; if (_sp > XB_SPIN_CAP) { atomicAdd(&(bar)[XB_TMO], 1u); break; } } } } while (0)
struct XcdBarrier { unsigned* bar; unsigned x; volatile LAS unsigned* st; };
__device__ __forceinline__ XcdBarrier xcd_barrier_post(unsigned* bar, volatile LAS unsigned* st) {
    XcdBarrier b; b.bar = bar; b.x = xb_xcc_id(); b.st = st;
    if (threadIdx.x == 0) (void)xb_add(&bar[XB_XCNT(b.x)], 1u);
    return b;
}
__device__ __forceinline__ void xcd_barrier_complete(unsigned* bar, unsigned x, unsigned& nloc, unsigned& nx) {
    const unsigned G = gridDim.x * gridDim.y * gridDim.z;
    unsigned sum, cnt, mine, sp = 0u;
    for (;;) {
        sum = 0u; cnt = 0u; mine = 0u;
#pragma unroll
        for (unsigned j = 0; j < 16; ++j) { const unsigned c = xb_ld(&bar[XB_XCNT(j)]); sum += c; cnt += (c > 0u) ? 1u : 0u; mine = (j == x) ? c : mine; }
        if (sum == G) break;
        __builtin_amdgcn_s_sleep(1);
        if ((++sp & 255u) == 0u) { if (xb_ld(&bar[XB_TMO])) break; if (sp > XB_SPIN_CAP) { atomicAdd(&bar[XB_TMO], 1u); break; } }
    }
    nloc = mine > 0u ? mine : 1u; nx = cnt > 0u ? cnt : 1u;
}
__device__ __forceinline__ void xcd_barrier(const XcdBarrier& b) {
    asm volatile("s_waitcnt vmcnt(0)" ::: "memory");
    __syncthreads();
    if (threadIdx.x == 0) {
        unsigned* bar = b.bar;
        __builtin_amdgcn_s_waitcnt(0);
        unsigned nloc = b.st[0], nx = b.st[1];
        if (nloc == 0u) { xcd_barrier_complete(bar, b.x, nloc, nx); b.st[0] = nloc; b.st[1] = nx; }
        const unsigned old = xb_add(&bar[XB_XSUB(b.x)], 1u);
        const unsigned gen = old / nloc;
        if (old + 1u == (gen + 1u) * nloc) {
            __builtin_amdgcn_fence(__ATOMIC_RELEASE, "agent");
            asm volatile("s_waitcnt vmcnt(0)" ::: "memory");
            const unsigned og = xb_add(&bar[XB_TOP], 1u);
            const unsigned tg = og / nx;
            if (og + 1u == (tg + 1u) * nx) xb_add(&bar[XB_TOPGEN], 1u);
            else XB_SPIN(xb_ld(&bar[XB_TOPGEN]) == tg, bar);
            __builtin_amdgcn_fence(__ATOMIC_ACQUIRE, "agent");
            xb_add(&bar[XB_XGEN(b.x)], 1u);
            asm volatile("s_waitcnt vmcnt(0)" ::: "memory");
        } else {
            XB_SPIN(xb_ld(&bar[XB_XGEN(b.x)]) == gen, bar);
            __builtin_amdgcn_fence(__ATOMIC_ACQUIRE, "agent");
            asm volatile("s_waitcnt vmcnt(0)" ::: "memory");
        }
    }
    __syncthreads();
}

struct Frame {
    LAS unsigned char* lds;
    int tid, lane, wave, G, bid;
    unsigned* ctl;
    const float* const __attribute__((address_space(4)))* kin;
    float* out;
    unsigned char* ws;
};
__device__ __forceinline__ const float* modp(const Frame& F, int l, int mb, int which) { return (const float*)(F.ws + WS_MODS) + ((size_t)(l * 9 + mb) * NMOD + which) * D; }
__device__ __forceinline__ int mb_of(int r) { return r < NL ? (r >> 12) : 8; }

struct Unit { const bf16* A; const bf16* B; int lda, ldb, K; int pm, pn, x0, x1, x2, x3; };

constexpr int HTB = 128 * 64 * 2;
__device__ __forceinline__ int lds_byte(int r, int c) { const int st = (r >> 4) * 2 + (c >> 5), rr = r & 15, cc = c & 31, ob = rr * 64 + cc * 2; return st * 1024 + (ob ^ (((ob >> 9) & 1) << 5)); }
__device__ __forceinline__ void stage_rc(int b, int& R, int& C) { const int st = b / 1024, sb = b % 1024, swz = sb ^ (((sb >> 9) & 1) << 5); R = (st >> 1) * 16 + swz / 64; C = (st & 1) * 32 + (swz % 64) / 2; }
__device__ __forceinline__ int perm32(int rho) { const int n = rho >> 4, i = rho & 15; return 8 * (i >> 2) + 4 * n + (i & 3); }
template <class P, class = void> struct chain_p { static constexpr bool v = false; };
template <class P> struct chain_p<P, decltype((void)P::CHAIN)> { static constexpr bool v = P::CHAIN; };
template <class P, class = void> struct earlya_p { static constexpr bool v = false; };
template <class P> struct earlya_p<P, decltype((void)P::EARLYA)> { static constexpr bool v = P::EARLYA; };
template <class P, class = void> struct upf_p { static constexpr bool v = false; };
template <class P> struct upf_p<P, decltype((void)P::UPF)> { static constexpr bool v = P::UPF; };
template <class P, class = void> struct wide8_p { static constexpr bool v = false; };
template <class P> struct wide8_p<P, decltype((void)P::WIDE8)> { static constexpr bool v = P::WIDE8; };
template <class P, class = void> struct mixed_p { static constexpr bool v = false; };
template <class P> struct mixed_p<P, decltype((void)P::MIXED)> { static constexpr bool v = P::MIXED; };
template <class P, class = void> struct bsh_p { static constexpr bool v = false; };
template <class P> struct bsh_p<P, decltype((void)P::BSH)> { static constexpr bool v = P::BSH; };
template <class P, class = void> struct lin_a { static constexpr int v = 0; };
template <class P> struct lin_a<P, decltype((void)P::LINA)> { static constexpr int v = P::LINA; };
template <class P> __device__ __forceinline__ void fast_gemm_phase(Frame& F, const P& p) {
    LAS unsigned char* lds = F.lds;
    const int tid = F.tid, wid = F.wave, lane = F.lane, wr = wid >> 2, wc = wid & 3, fr = lane & 15, fq = lane >> 4;
    int R0, C0, R1, C1; stage_rc(tid * 16, R0, C0); stage_rc(tid * 16 + 8192, R1, C1);
    const int Rb0 = (R0 & ~31) + perm32(R0 & 31);
    const unsigned ldsw = (unsigned)wid * 1024u;
    const int aoffL = lds_byte(wr * 64 + fr, fq * 8), boffL = lds_byte(wc * 32 + fr, fq * 8);
    Unit cur, nxt; int ui = 0;
    if (!p.next(0, cur)) return;
    constexpr int LINA = lin_a<P>::v;
    const char* sA; const char* sB; unsigned sa00, sa01, sa10, sa11, sb0; size_t shB;
#define FG_SET(u) do { sA = (const char*)(u).A; sB = (const char*)(u).B; if constexpr (bsh_p<P>::v) shB = (size_t)(unsigned)(u).x2; else shB = (size_t)128 * (u).ldb * 2;     \
        sa00 = p.a_off((u), R0) + C0 * 2; if constexpr (LINA == 0) { sa01 = p.a_off((u), R1) + C1 * 2; sa10 = p.a_off((u), 128 + R0) + C0 * 2; sa11 = p.a_off((u), 128 + R1) + C1 * 2; } \
        sb0 = (unsigned)(Rb0 * (u).ldb + C0) * 2u; } while (0)
#define FG_SETN(u) do { if constexpr (earlya_p<P>::v) { sA = (const char*)(u).A; sB = (const char*)(u).B; shB = (size_t)128 * (u).ldb * 2; \
        sa00 = p.a_fin(na0) + C0 * 2; sa01 = p.a_fin(na1) + C1 * 2; sa10 = p.a_fin(na2) + C0 * 2; sa11 = p.a_fin(na3) + C1 * 2; sb0 = (unsigned)(Rb0 * (u).ldb + C0) * 2u; } else FG_SET(u); } while (0)
#define FG_SA(b, h) (((b) * 2 + (h)) * HTB)
#define FG_SB(b, h) ((4 + (b) * 2 + (h)) * HTB)
#define FG_GLDS(src, bufoff, i) __builtin_amdgcn_global_load_lds((const unsigned*)(src), (LAS unsigned*)(lds + (bufoff) + ldsw + (i) * 8192), 16, 0, 0)
#define FG_OPQ(ptr) do { if constexpr (P::FP8 || mixed_p<P>::v) asm volatile("" : "+s"(ptr)); } while (0)
#define FG_STAGE_A0(bufoff, kt) do { const char* _pa = sA + (size_t)(kt) * 128; FG_OPQ(_pa); FG_GLDS(_pa + sa00, bufoff, 0); \
        if constexpr (LINA == 0) FG_GLDS(_pa + sa01, bufoff, 1); else { const char* _pa1 = _pa + 64 * LINA; FG_OPQ(_pa1); FG_GLDS(_pa1 + sa00, bufoff, 1); } } while (0)
#define FG_STAGE_A1(bufoff, kt) do { const char* _pa = sA + (size_t)(kt) * 128; FG_OPQ(_pa); \
        if constexpr (LINA == 0) { FG_GLDS(_pa + sa10, bufoff, 0); FG_GLDS(_pa + sa11, bufoff, 1); } \
        else { const char* _pa2 = _pa + 128 * LINA; const char* _pa3 = _pa + 192 * LINA; FG_OPQ(_pa2); FG_OPQ(_pa3); FG_GLDS(_pa2 + sa00, bufoff, 0); FG_GLDS(_pa3 + sa00, bufoff, 1); } } while (0)
#define FG_STAGE_B(bufoff, h, kt) do { const char* _pb = sB + ((size_t)(h) * shB + (size_t)(kt) * 128); const char* _pb1 = _pb + (shB >> 1); FG_OPQ(_pb); FG_OPQ(_pb1); FG_GLDS(_pb + sb0, bufoff, 0); FG_GLDS(_pb1 + sb0, bufoff, 1); } while (0)
#define FG_LDA(dst, b, h) do { _Pragma("unroll") for (int m = 0; m < 4; ++m) _Pragma("unroll") for (int k = 0; k < 2; ++k) dst[m][k] = *(const LAS bf16x8*)(lds + FG_SA(b, h) + aoffL + m * 2048 + k * 1024); } while (0)
#define FG_LDB(dst, b, h) do { _Pragma("unroll") for (int n = 0; n < 2; ++n) _Pragma("unroll") for (int k = 0; k < 2; ++k) dst[n][k] = *(const LAS bf16x8*)(lds + FG_SB(b, h) + boffL + n * 2048 + k * 1024); } while (0)
#define FG_MMA8(ai, bj, At, Bt) do { _Pragma("unroll") for (int m = 0; m < 4; ++m) _Pragma("unroll") for (int n = 0; n < 2; ++n) \
        acc[ai][bj][m][n] = __builtin_amdgcn_mfma_scale_f32_16x16x128_f8f6f4(cat8(Bt[n][0], Bt[n][1]), cat8(At[m][0], At[m][1]), acc[ai][bj][m][n], 0, 0, 0, 0, 0, 0); } while (0)
#define FG_MMA16(ai, bj, At, Bt) do { _Pragma("unroll") for (int m = 0; m < 4; ++m) _Pragma("unroll") for (int n = 0; n < 2; ++n) _Pragma("unroll") for (int k = 0; k < 2; ++k) \
        acc[ai][bj][m][n] = __builtin_amdgcn_mfma_f32_16x16x32_bf16(Bt[n][k], At[m][k], acc[ai][bj][m][n], 0, 0, 0); } while (0)
#define FG_MMAP8(ai, bj, At, Bt) do { __builtin_amdgcn_s_setprio(1); FG_MMA8(ai, bj, At, Bt); __builtin_amdgcn_s_setprio(0); } while (0)
#define FG_MMAP16(ai, bj, At, Bt) do { __builtin_amdgcn_s_setprio(1); FG_MMA16(ai, bj, At, Bt); __builtin_amdgcn_s_setprio(0); } while (0)
#define FG_MMA(ai, bj, At, Bt) do { if constexpr (P::FP8) FG_MMAP8(ai, bj, At, Bt); else FG_MMAP16(ai, bj, At, Bt); } while (0)
#define FG_WAIT_V(n) asm volatile("s_waitcnt vmcnt(" #n ")" ::: "memory")
#define FG_WAIT_L(n) asm volatile("s_waitcnt lgkmcnt(" #n ")" ::: "memory")
#define FG_BAR __builtin_amdgcn_s_barrier()
#define FG_SCHED __builtin_amdgcn_sched_barrier(0)
    f32x4 acc[2][2][4][2];
#pragma unroll
    for (int a = 0; a < 2; ++a)
#pragma unroll
        for (int b = 0; b < 2; ++b)
#pragma unroll
            for (int m = 0; m < 4; ++m)
#pragma unroll
                for (int n = 0; n < 2; ++n) acc[a][b][m][n] = (f32x4){0.f, 0.f, 0.f, 0.f};
    bf16x8 At[4][2], B0[2][2], B1[2][2];
    unsigned na0 = 0u, na1 = 0u, na2 = 0u, na3 = 0u; (void)na0; (void)na1; (void)na2; (void)na3;
    if constexpr (upf_p<P>::v) p.unit_prefetch(cur, wid, lane);
    FG_SET(cur);
    FG_STAGE_B(FG_SB(0, 0), 0, 0); FG_STAGE_B(FG_SB(0, 1), 1, 0); FG_STAGE_A0(FG_SA(0, 0), 0); FG_STAGE_A1(FG_SA(0, 1), 0);
    if (wr == 1) FG_BAR;
    FG_WAIT_V(2); FG_BAR;
    FG_STAGE_B(FG_SB(1, 0), 0, 1); FG_STAGE_A0(FG_SA(1, 0), 1); FG_STAGE_B(FG_SB(1, 1), 1, 1);
    FG_WAIT_V(6); FG_BAR;
#define FG_KLOOP(MMA) \
        for (int t = 0; t < nt; t += 2) { \
            const bool last = (t == nt - 2); \
            const int k2 = last ? 0 : t + 2, k3 = k2 + 1; \
            FG_LDB(B0, 0, 0); FG_LDB(B1, 0, 1); FG_SCHED; FG_LDA(At, 0, 0); FG_STAGE_A1(FG_SA(1, 1), t + 1); \
            if (last && has_next) { FG_SETN(nxt); if constexpr (upf_p<P>::v) p.unit_prefetch(nxt, wid, lane); } \
            FG_WAIT_V(8); FG_WAIT_L(0); FG_BAR; MMA(0, 0, At, B0); MMA(0, 1, At, B1); FG_BAR; FG_SCHED; \
            FG_LDA(At, 0, 1); FG_STAGE_B(FG_SB(0, 0), 0, k2); FG_STAGE_B(FG_SB(0, 1), 1, k2); FG_STAGE_A0(FG_SA(0, 0), k2); \
            FG_WAIT_V(8); FG_WAIT_L(0); FG_BAR; MMA(1, 0, At, B0); MMA(1, 1, At, B1); FG_BAR; FG_SCHED; \
            FG_LDB(B0, 1, 0); FG_LDB(B1, 1, 1); FG_SCHED; FG_LDA(At, 1, 0); FG_STAGE_A1(FG_SA(0, 1), k2); \
            FG_WAIT_V(8); FG_WAIT_L(0); FG_BAR; MMA(0, 0, At, B0); MMA(0, 1, At, B1); FG_BAR; FG_SCHED; \
            FG_LDA(At, 1, 1); FG_STAGE_B(FG_SB(1, 0), 0, k3); FG_STAGE_B(FG_SB(1, 1), 1, k3); FG_STAGE_A0(FG_SA(1, 0), k3); \
            FG_WAIT_V(8); FG_WAIT_L(0); FG_BAR; MMA(1, 0, At, B0); MMA(1, 1, At, B1); FG_BAR; FG_SCHED; \
        }
    if constexpr (mixed_p<P>::v) {
      for (;;) {
        p.next(ui + 1, nxt);
        { const bool has_next = true; int nt = cur.K >> 6; asm volatile("" : "+s"(nt)); FG_KLOOP(FG_MMAP8) }
        if (wr == 0) FG_BAR;
        { int fr_ = fr, fq_ = fq; asm volatile("" : "+v"(fr_), "+v"(fq_)); const int fr = fr_, fq = fq_;
          if constexpr (chain_p<P>::v) {
          constexpr int NBT = 8 / P::EB;
          typename P::Pre pre[2][P::EB];
#pragma unroll
          for (int e = 0; e < P::EB; ++e) pre[0][e] = p.pre(cur, wr * 64 + e * 16 + fr, wc * 32 + fq * 8);
#pragma unroll
          for (int b = 0; b < NBT; ++b) {
            if (b + 1 < NBT) { const int ai1 = ((b + 1) * P::EB) >> 2, mb1 = ((b + 1) * P::EB) & 3;
#pragma unroll
                for (int e = 0; e < P::EB; ++e) pre[(b + 1) & 1][e] = p.pre(cur, ai1 * 128 + wr * 64 + (mb1 + e) * 16 + fr, wc * 32 + fq * 8); }
            asm volatile("" ::: "memory"); __builtin_amdgcn_sched_barrier(0);
            const int ai = (b * P::EB) >> 2, mb = (b * P::EB) & 3;
#pragma unroll
            for (int e = 0; e < P::EB; ++e) { const int m = mb + e; f32x4 q[4]; p.scale(pre[b & 1][e], q);
                acc[ai][0][m][0] *= q[0]; acc[ai][0][m][1] *= q[1]; acc[ai][1][m][0] *= q[2]; acc[ai][1][m][1] *= q[3];
                asm volatile("" : "+v"(acc[ai][0][m][0]), "+v"(acc[ai][0][m][1]), "+v"(acc[ai][1][m][0]), "+v"(acc[ai][1][m][1]));
                __builtin_amdgcn_sched_barrier(0); } } }
        }
        cur = nxt; ++ui;
        if (wr == 1) FG_BAR;
        const bool has_next = p.next(ui + 1, nxt);
        { int nt = cur.K >> 6; asm volatile("" : "+s"(nt)); FG_KLOOP(FG_MMAP16) }
        if (wr == 0) FG_BAR;
        { int fr_ = fr, fq_ = fq; asm volatile("" : "+v"(fr_), "+v"(fq_)); const int fr = fr_, fq = fq_;
          const typename P::UPre up = p.upre(cur, wc * 32 + fq * 8);
          constexpr int NBT = 8 / P::EB;
          typename P::Pre pre[2][P::EB];
#pragma unroll
          for (int e = 0; e < P::EB; ++e) pre[0][e] = p.pre(cur, wr * 64 + e * 16 + fr, wc * 32 + fq * 8);
#pragma unroll
          for (int b = 0; b < NBT; ++b) {
            if (b + 1 < NBT) { const int ai1 = ((b + 1) * P::EB) >> 2, mb1 = ((b + 1) * P::EB) & 3;
#pragma unroll
                for (int e = 0; e < P::EB; ++e) pre[(b + 1) & 1][e] = p.pre(cur, ai1 * 128 + wr * 64 + (mb1 + e) * 16 + fr, wc * 32 + fq * 8); }
            asm volatile("" ::: "memory"); __builtin_amdgcn_sched_barrier(0);
            const int ai = (b * P::EB) >> 2, mb = (b * P::EB) & 3;
#pragma unroll
            for (int e = 0; e < P::EB; ++e) { const int m = mb + e;
                const float v0[8] = {acc[ai][0][m][0][0], acc[ai][0][m][0][1], acc[ai][0][m][0][2], acc[ai][0][m][0][3], acc[ai][0][m][1][0], acc[ai][0][m][1][1], acc[ai][0][m][1][2], acc[ai][0][m][1][3]};
                const float v1[8] = {acc[ai][1][m][0][0], acc[ai][1][m][0][1], acc[ai][1][m][0][2], acc[ai][1][m][0][3], acc[ai][1][m][1][0], acc[ai][1][m][1][1], acc[ai][1][m][1][2], acc[ai][1][m][1][3]};
                p.epi(cur, ai * 128 + wr * 64 + m * 16 + fr, wc * 32 + fq * 8, v0, v1, pre[b & 1][e], up);
            } } }
        if (!has_next) break;
        {
#pragma unroll
        for (int a = 0; a < 2; ++a)
#pragma unroll
            for (int b = 0; b < 2; ++b)
#pragma unroll
                for (int m = 0; m < 4; ++m)
#pragma unroll
                    for (int n = 0; n < 2; ++n) acc[a][b][m][n] = zero4(); }
        cur = nxt; ++ui;
        if (wr == 1) FG_BAR;
      }
    } else
    for (;;) {
        const bool has_next = p.next(ui + 1, nxt);
        if constexpr (earlya_p<P>::v) { if (has_next) { na0 = p.a_raw(nxt, R0); na1 = p.a_raw(nxt, R1); na2 = p.a_raw(nxt, 128 + R0); na3 = p.a_raw(nxt, 128 + R1); } }
        int nt = cur.K >> 6; asm volatile("" : "+s"(nt));
        FG_KLOOP(FG_MMA)
        if (wr == 0) FG_BAR;
        if constexpr (P::PAIRED) {
#pragma unroll
            for (int m = 0; m < 4; ++m) {
                const float r0[8] = {acc[0][0][m][0][0], acc[0][0][m][0][1], acc[0][0][m][0][2], acc[0][0][m][0][3], acc[0][0][m][1][0], acc[0][0][m][1][1], acc[0][0][m][1][2], acc[0][0][m][1][3]};
                const float r1[8] = {acc[0][1][m][0][0], acc[0][1][m][0][1], acc[0][1][m][0][2], acc[0][1][m][0][3], acc[0][1][m][1][0], acc[0][1][m][1][1], acc[0][1][m][1][2], acc[0][1][m][1][3]};
                const float i0[8] = {acc[1][0][m][0][0], acc[1][0][m][0][1], acc[1][0][m][0][2], acc[1][0][m][0][3], acc[1][0][m][1][0], acc[1][0][m][1][1], acc[1][0][m][1][2], acc[1][0][m][1][3]};
                const float i1[8] = {acc[1][1][m][0][0], acc[1][1][m][0][1], acc[1][1][m][0][2], acc[1][1][m][0][3], acc[1][1][m][1][0], acc[1][1][m][1][1], acc[1][1][m][1][2], acc[1][1][m][1][3]};
                p.epi2(cur, wr * 64 + m * 16 + fr, wc * 32 + fq * 8, r0, r1, i0, i1);
                __builtin_amdgcn_sched_barrier(0);
            }
        } else if (chain_p<P>::v && cur.x0 == 0) {
          if constexpr (chain_p<P>::v) {
          constexpr int NBT = 8 / P::EB;
          typename P::Pre pre[2][P::EB];
#pragma unroll
          for (int e = 0; e < P::EB; ++e) pre[0][e] = p.pre(cur, wr * 64 + e * 16 + fr, wc * 32 + fq * 8);
#pragma unroll
          for (int b = 0; b < NBT; ++b) {
            if (b + 1 < NBT) { const int ai1 = ((b + 1) * P::EB) >> 2, mb1 = ((b + 1) * P::EB) & 3;
#pragma unroll
                for (int e = 0; e < P::EB; ++e) pre[(b + 1) & 1][e] = p.pre(cur, ai1 * 128 + wr * 64 + (mb1 + e) * 16 + fr, wc * 32 + fq * 8); }
            const int ai = (b * P::EB) >> 2, mb = (b * P::EB) & 3;
#pragma unroll
            for (int e = 0; e < P::EB; ++e) { const int m = mb + e; f32x4 q[4]; p.scale(pre[b & 1][e], q);
                acc[ai][0][m][0] *= q[0]; acc[ai][0][m][1] *= q[1]; acc[ai][1][m][0] *= q[2]; acc[ai][1][m][1] *= q[3]; __builtin_amdgcn_sched_barrier(0); } } }
        } else
        { const typename P::UPre up = p.upre(cur, wc * 32 + fq * 8);
          constexpr int NBT = 8 / P::EB;
          typename P::Pre pre[2][P::EB];
#pragma unroll
          for (int e = 0; e < P::EB; ++e) pre[0][e] = p.pre(cur, wr * 64 + e * 16 + fr, wc * 32 + fq * 8);
#pragma unroll
          for (int b = 0; b < NBT; ++b) {
            if (b + 1 < NBT) { const int ai1 = ((b + 1) * P::EB) >> 2, mb1 = ((b + 1) * P::EB) & 3;
#pragma unroll
                for (int e = 0; e < P::EB; ++e) pre[(b + 1) & 1][e] = p.pre(cur, ai1 * 128 + wr * 64 + (mb1 + e) * 16 + fr, wc * 32 + fq * 8); }
            if constexpr (upf_p<P>::v) { asm volatile("" ::: "memory"); __builtin_amdgcn_sched_barrier(0); }
            const int ai = (b * P::EB) >> 2, mb = (b * P::EB) & 3;
            if constexpr (wide8_p<P>::v) {
#pragma unroll
              for (int e = 0; e < P::EB; e += 2) { const int m = mb + e;
                const float a0[8] = {acc[ai][0][m][0][0], acc[ai][0][m][0][1], acc[ai][0][m][0][2], acc[ai][0][m][0][3], acc[ai][0][m][1][0], acc[ai][0][m][1][1], acc[ai][0][m][1][2], acc[ai][0][m][1][3]};
                const float a1[8] = {acc[ai][1][m][0][0], acc[ai][1][m][0][1], acc[ai][1][m][0][2], acc[ai][1][m][0][3], acc[ai][1][m][1][0], acc[ai][1][m][1][1], acc[ai][1][m][1][2], acc[ai][1][m][1][3]};
                const float b0[8] = {acc[ai][0][m + 1][0][0], acc[ai][0][m + 1][0][1], acc[ai][0][m + 1][0][2], acc[ai][0][m + 1][0][3], acc[ai][0][m + 1][1][0], acc[ai][0][m + 1][1][1], acc[ai][0][m + 1][1][2], acc[ai][0][m + 1][1][3]};
                const float b1[8] = {acc[ai][1][m + 1][0][0], acc[ai][1][m + 1][0][1], acc[ai][1][m + 1][0][2], acc[ai][1][m + 1][0][3], acc[ai][1][m + 1][1][0], acc[ai][1][m + 1][1][1], acc[ai][1][m + 1][1][2], acc[ai][1][m + 1][1][3]};
                p.epiw(cur, ai * 128 + wr * 64 + m * 16 + fr, wc * 32 + fq * 8, a0, a1, b0, b1, pre[b & 1][e], pre[b & 1][e + 1], up); }
            } else {
#pragma unroll
            for (int e = 0; e < P::EB; ++e) { const int m = mb + e;
                const float v0[8] = {acc[ai][0][m][0][0], acc[ai][0][m][0][1], acc[ai][0][m][0][2], acc[ai][0][m][0][3], acc[ai][0][m][1][0], acc[ai][0][m][1][1], acc[ai][0][m][1][2], acc[ai][0][m][1][3]};
                const float v1[8] = {acc[ai][1][m][0][0], acc[ai][1][m][0][1], acc[ai][1][m][0][2], acc[ai][1][m][0][3], acc[ai][1][m][1][0], acc[ai][1][m][1][1], acc[ai][1][m][1][2], acc[ai][1][m][1][3]};
                p.epi(cur, ai * 128 + wr * 64 + m * 16 + fr, wc * 32 + fq * 8, v0, v1, pre[b & 1][e], up);
            } } } }
        if (!has_next) break;
        if (!(chain_p<P>::v && cur.x0 == 0)) {
#pragma unroll
        for (int a = 0; a < 2; ++a)
#pragma unroll
            for (int b = 0; b < 2; ++b)
#pragma unroll
                for (int m = 0; m < 4; ++m)
#pragma unroll
                    for (int n = 0; n < 2; ++n) acc[a][b][m][n] = zero4(); }
        cur = nxt; ++ui;
        if (wr == 1) FG_BAR;
    }
    FG_WAIT_V(0);
    FG_BAR;
#undef FG_SET
#undef FG_SETN
#undef FG_SA
#undef FG_SB
#undef FG_GLDS
#undef FG_OPQ
#undef FG_STAGE_A0
#undef FG_STAGE_A1
#undef FG_STAGE_B
#undef FG_LDA
#undef FG_LDB
#undef FG_MMA
#undef FG_MMA8
#undef FG_MMA16
#undef FG_MMAP8
#undef FG_KLOOP
#undef FG_MMAP16
#undef FG_WAIT_V
#undef FG_WAIT_L
#undef FG_BAR
#undef FG_SCHED
}

__device__ __forceinline__ void order2d(int L, int nM, int nN, int& pm, int& pn) {
    const int nwg = nM * nN; int wgid = L; { const int q = nwg >> 3, r = nwg & 7, xcd = wgid & 7, off = wgid >> 3; wgid = (xcd < r ? xcd * (q + 1) : r * (q + 1) + (xcd - r) * q) + off; }
    const int nig = 8 * nN, gid = wgid / nig, fm = gid * 8, gsz = (nM - fm) < 8 ? (nM - fm) : 8;
    pm = fm + ((wgid % nig) % gsz); pn = (wgid % nig) / gsz;
}
struct NoPre {};
struct PInproj {
    static constexpr bool PAIRED = false, FP8 = false; static constexpr int EB = 4;
    int G, c, l; const bf16* hx; const bf16* wt; bf16 *urnn, *gate;
    __device__ __forceinline__ int count() const { return 1024 + 8 * (l == 1 ? 4 : 8); }
    __device__ __forceinline__ bool next(int i, Unit& u) const {
        const int idx = i * G + c; if (idx >= count()) return false;
        if (idx < 1024) order2d(idx, 128, 8, u.pm, u.pn); else { const int j = idx - 1024; u.pm = 128 + (j & 7); u.pn = j >> 3; }
        u.A = hx + (size_t)u.pm * 256 * D; u.lda = D; u.B = wt + (size_t)u.pn * 256 * D; u.ldb = D; u.K = D; return true; }
    __device__ __forceinline__ unsigned a_off(const Unit& u, int row) const { return (unsigned)row * (D * 2); }
    typedef NoPre Pre; typedef NoPre UPre;
    __device__ __forceinline__ NoPre pre(const Unit&, int, int) const { return NoPre{}; }
    __device__ __forceinline__ NoPre upre(const Unit&, int) const { return NoPre{}; }
    __device__ __forceinline__ void epi(const Unit& u, int row, int c8, const float* v0, const float* v1, const NoPre&, const NoPre&) const {
        const size_t r = (size_t)u.pm * 256 + row; const int col = u.pn * 256 + c8;
        float a[8], b[8];
        if (col < 1024) { *(GAS v4u*)(urnn + r * D + col) = pack8(v0); *(GAS v4u*)(urnn + r * D + col + 128) = pack8(v1); }
        else {
#pragma unroll
            for (int j = 0; j < 8; j += 2) { const f32x2 ga = gelu_pk((f32x2){v0[j], v0[j + 1]}), gb = gelu_pk((f32x2){v1[j], v1[j + 1]}); a[j] = ga.x; a[j + 1] = ga.y; b[j] = gb.x; b[j + 1] = gb.y; }
            *(GAS v4u*)(gate + r * D + col - 1024) = pack8(a); *(GAS v4u*)(gate + r * D + col - 1024 + 128) = pack8(b); }
    }
};
struct PFourT {
    static constexpr bool PAIRED = false, FP8 = true, BSH = true; static constexpr int EB = 4, LINA = D;
    int G, c, l, rot; const unsigned char* hx; const unsigned char* wt; bf16 *ut4, *utc;
    __device__ __forceinline__ int count() const { return 256 + (l == 0 ? 16 : 0); }
    __device__ __forceinline__ bool next(int i, Unit& u) const {
        int cr = c - rot; cr += cr < 0 ? G : 0; const int idx = i * G + cr; if (idx >= count()) return false;
        if (idx < 256) { const int ct = idx & 1, rest = idx >> 1, b = rest >> 4, tg = rest & 15; u.x0 = b; u.x1 = tg; u.pm = ct; u.pn = 0;
            u.B = (const bf16*)(hx + ((size_t)b * 4096 + tg * 4) * D); u.ldb = 32 * D; u.x2 = 2 * D; }
        else { const int j = idx - 256, ct = j & 1, b = j >> 1; u.x0 = b; u.x1 = 0; u.pm = ct; u.pn = 1; u.B = (const bf16*)(hx + ((size_t)NL + b * 256) * D); u.ldb = D / 2; u.x2 = 128 * D; }
        u.A = (const bf16*)(wt + (size_t)(u.pm * 256) * D); u.lda = D / 2; u.K = D / 2; return true; }
    __device__ __forceinline__ unsigned a_off(const Unit& u, int row) const { return (unsigned)row * D; }
    typedef NoPre Pre; typedef NoPre UPre;
    __device__ __forceinline__ NoPre pre(const Unit&, int, int) const { return NoPre{}; }
    __device__ __forceinline__ NoPre upre(const Unit&, int) const { return NoPre{}; }
    __device__ __forceinline__ void epi(const Unit& u, int row, int c8, const float* v0, const float* v1, const NoPre&, const NoPre&) const {
        const int ch = u.pm * 256 + row; float w0[8], w1[8];
#pragma unroll
        for (int j = 0; j < 8; ++j) { w0[j] = v0[j] * (1.f / MOE_WS); w1[j] = v1[j] * (1.f / MOE_WS); }
        v0 = w0; v1 = w1;
        if (u.pn == 0) { const int cp = ch >> 1, cq = ch & 1, t2 = u.x1 * 4 + (c8 >> 6), t1 = c8 & 63;
            bf16* dst = ut4 + ((((size_t)u.x0 * 256 + cp) * 64 + t2) * 2 + cq) * 64 + t1; *(GAS v4u*)dst = pack8(v0); *(GAS v4u*)(dst + 256) = pack8(v1); }
        else { bf16* dst = utc + ((size_t)u.x0 * 512 + ch) * 256 + c8; *(GAS v4u*)dst = pack8(v0); *(GAS v4u*)(dst + 128) = pack8(v1); }
    }
};
struct PInproj8 {
    static constexpr bool PAIRED = false, FP8 = true, WIDE8 = true; static constexpr int EB = 4, LINA = D;
    int G, c, npan, rot; const unsigned char* hx8; const unsigned char* wt8; unsigned char *sgr, *sgf;
    __device__ __forceinline__ bool next(int i, Unit& u) const {
        int cr = c - rot; cr += cr < 0 ? G : 0; const int cnt = npan * 8, n2 = cnt / G, r2 = cnt - n2 * G; int idx = i * G + cr;
        if (r2 + 2 * rot <= G && n2 >= 2) {
            if (cr >= G - rot) { if (i >= n2 - 1) return false; }
            else if (i == n2 && cr >= r2 && cr < r2 + rot) idx = (n2 - 1) * G + (G - rot) + (cr - r2);
        }
        if (idx >= cnt) return false;
        order2d(idx, npan, 8, u.pm, u.pn); u.A = (const bf16*)(hx8 + (size_t)u.pm * 256 * D); u.lda = D / 2; u.B = (const bf16*)(wt8 + (size_t)u.pn * 256 * D); u.ldb = D / 2; u.K = D / 2; return true; }
    __device__ __forceinline__ unsigned a_off(const Unit& u, int row) const { return (unsigned)row * D; }
    typedef NoPre Pre; typedef NoPre UPre;
    __device__ __forceinline__ NoPre pre(const Unit&, int, int) const { return NoPre{}; }
    __device__ __forceinline__ NoPre upre(const Unit&, int) const { return NoPre{}; }
    __device__ __forceinline__ void epi(const Unit& u, int row, int c8, const float* v0, const float* v1, const NoPre&, const NoPre&) const {
        const size_t r = (size_t)u.pm * 256 + row; const int col = u.pn * 256 + c8; float a[8], b[8];
#pragma unroll
        for (int j = 0; j < 8; j += 2) { const f32x2 ga = sigmoid_pk_s((f32x2){v0[j], v0[j + 1]}, 1.f / MOE_WS, 255.f), gb = sigmoid_pk_s((f32x2){v1[j], v1[j + 1]}, 1.f / MOE_WS, 255.f); a[j] = ga.x; a[j + 1] = ga.y; b[j] = gb.x; b[j + 1] = gb.y; }
        unsigned char* dst = col < 1024 ? sgr + r * D + col : sgf + r * D + (col - 1024);
        *(GAS v2u*)dst = pk8_u8(a); *(GAS v2u*)(dst + 128) = pk8_u8(b);
    }
    __device__ __forceinline__ void epiw(const Unit& u, int row, int c8, const float* a0, const float* a1, const float* b0, const float* b1, const NoPre&, const NoPre&, const NoPre&) const {
        float xa[8], ya[8], xb[8], yb[8];
#pragma unroll
        for (int j = 0; j < 8; j += 2) { const f32x2 g0 = sigmoid_pk_s((f32x2){a0[j], a0[j + 1]}, 1.f / MOE_WS, 255.f), g1 = sigmoid_pk_s((f32x2){a1[j], a1[j + 1]}, 1.f / MOE_WS, 255.f),
                                                 h0 = sigmoid_pk_s((f32x2){b0[j], b0[j + 1]}, 1.f / MOE_WS, 255.f), h1 = sigmoid_pk_s((f32x2){b1[j], b1[j + 1]}, 1.f / MOE_WS, 255.f);
            xa[j] = g0.x; xa[j + 1] = g0.y; ya[j] = g1.x; ya[j + 1] = g1.y; xb[j] = h0.x; xb[j + 1] = h0.y; yb[j] = h1.x; yb[j + 1] = h1.y; }
        const int odd = (c8 >> 3) & 1; const size_t r = (size_t)u.pm * 256 + row + 16 * odd; const int col = u.pn * 256 + (c8 & ~8);
        unsigned char* dst = col < 1024 ? sgr + r * D + col : sgf + r * D + (col - 1024);
        *(GAS v4u*)dst = swap8_pair(pk8_u8(xa), pk8_u8(xb)); *(GAS v4u*)(dst + 128) = swap8_pair(pk8_u8(ya), pk8_u8(yb));
    }
};
struct PDft {
    static constexpr bool PAIRED = false, FP8 = false, WIDE8 = true; static constexpr int EB = 4;
    int G, c; const bf16 *csc, *ut; bf16* g;
    __device__ __forceinline__ bool next(int i, Unit& u) const {
        const int j = i * G + c; if (j >= 32) return false;
        const int b = j >> 2, rem = j & 3; u.pm = rem >> 1; u.pn = rem & 1; u.x0 = b;
        u.A = csc + (size_t)u.pm * 256 * 256; u.lda = 256; u.B = ut + ((size_t)b * 512 + u.pn * 256) * 256; u.ldb = 256; u.K = 256; return true; }
    __device__ __forceinline__ unsigned a_off(const Unit& u, int row) const { return (unsigned)row * 512u; }
    typedef NoPre Pre; typedef NoPre UPre;
    __device__ __forceinline__ NoPre pre(const Unit&, int, int) const { return NoPre{}; }
    __device__ __forceinline__ NoPre upre(const Unit&, int) const { return NoPre{}; }
    __device__ __forceinline__ void epi(const Unit& u, int row, int c8, const float* v0, const float* v1, const NoPre&, const NoPre&) const {
        const size_t r = (size_t)NL + u.x0 * 256 + row; const int col = u.pm * 512 + u.pn * 256 + c8;
        unsigned char* gd = (unsigned char*)g + r * (D * 2) + col;
        *(GAS v2u*)gd = (v2u){pk4_fp8(v0[0], v0[1], v0[2], v0[3]), pk4_fp8(v0[4], v0[5], v0[6], v0[7])}; *(GAS v2u*)(gd + 128) = (v2u){pk4_fp8(v1[0], v1[1], v1[2], v1[3]), pk4_fp8(v1[4], v1[5], v1[6], v1[7])};
    }
    __device__ __forceinline__ void epiw(const Unit& u, int row, int c8, const float* a0, const float* a1, const float* b0, const float* b1, const NoPre&, const NoPre&, const NoPre&) const {
        const int odd = (c8 >> 3) & 1; const size_t r = (size_t)NL + u.x0 * 256 + row + 16 * odd; const int col = u.pm * 512 + u.pn * 256 + (c8 & ~8);
        unsigned char* gd = (unsigned char*)g + r * (D * 2) + col;
#define F8W(v) (v2u){pk4_fp8(v[0], v[1], v[2], v[3]), pk4_fp8(v[4], v[5], v[6], v[7])}
        *(GAS v4u*)gd = swap8_pair(F8W(a0), F8W(b0)); *(GAS v4u*)(gd + 128) = swap8_pair(F8W(a1), F8W(b1));
#undef F8W
    }
};
struct PFftA {
    static constexpr bool PAIRED = true, FP8 = false; static constexpr int EB = 4;
    int G, c; const bf16 *fa, *ut4; unsigned char* zt;
    __device__ __forceinline__ bool next(int i, Unit& u) const {
        const int idx = i * G + c; if (idx >= 512) return false;
        u.pm = 0; u.pn = idx; u.A = fa; u.lda = 128; u.B = ut4 + (size_t)idx * 256 * 128; u.ldb = 128; u.K = 128; return true; }
    __device__ __forceinline__ unsigned a_off(const Unit& u, int row) const { return (unsigned)row * 256u; }
    __device__ __forceinline__ void epi2(const Unit& u, int row, int c8, const float* r0, const float* r1, const float* i0, const float* i1) const {
        const int cq = row >> 6, k1 = row & 63;
#pragma unroll
        for (int h = 0; h < 2; ++h) { const float* zr = h ? r1 : r0; const float* zi = h ? i1 : i0; const int n = u.pn * 256 + c8 + h * 128, cp = (n >> 6) & 255, b = n >> 14; int t2 = n & 63;
            asm volatile("" : "+v"(t2));
            float orr[8], oi[8];
#pragma unroll
            for (int j = 0; j < 8; ++j) { const float ph = (float)(k1 * (t2 + j)) * (1.0f / 4096.0f); const float cs = __builtin_amdgcn_cosf(ph), sn = __builtin_amdgcn_sinf(ph);
                orr[j] = zr[j] * cs + zi[j] * sn; oi[j] = zi[j] * cs - zr[j] * sn; }
            unsigned char* dst = zt + ((((size_t)b * 512 + 2 * cp + cq) * 64 + k1) * 2) * 64 + t2;
            *(GAS v2u*)dst = (v2u){pk4_fp8(orr[0], orr[1], orr[2], orr[3]), pk4_fp8(orr[4], orr[5], orr[6], orr[7])}; *(GAS v2u*)(dst + 64) = (v2u){pk4_fp8(oi[0], oi[1], oi[2], oi[3]), pk4_fp8(oi[4], oi[5], oi[6], oi[7])};
            __builtin_amdgcn_sched_barrier(0); }
    }
};
struct PFftC {
    static constexpr bool PAIRED = false, FP8 = true, WIDE8 = true; static constexpr int EB = 4, LINA = 256;
    int G, c; const unsigned char *fc, *zt; bf16* g;
    __device__ __forceinline__ bool next(int i, Unit& u) const {
        const int idx = i * G + c; if (idx >= 512) return false;
        const int b = idx >> 6, k1p = (idx >> 1) & 31, ct = idx & 1; u.x0 = b; u.x2 = k1p; u.pm = 0; u.pn = ct;
        u.A = (const bf16*)fc; u.lda = 128; u.K = 128; u.B = (const bf16*)(zt + (((size_t)b * 512 + ct * 256) * 64 + 2 * k1p) * 128); u.ldb = 64 * 64; return true; }
    __device__ __forceinline__ unsigned a_off(const Unit& u, int row) const { return (unsigned)row * 256u; }
    typedef NoPre Pre; typedef NoPre UPre;
    __device__ __forceinline__ NoPre pre(const Unit&, int, int) const { return NoPre{}; }
    __device__ __forceinline__ NoPre upre(const Unit&, int) const { return NoPre{}; }
    __device__ __forceinline__ void epi(const Unit& u, int row, int c8, const float* v0, const float* v1, const NoPre&, const NoPre&) const {
        const int k1 = 2 * u.x2 + (row >> 7), ty = (row >> 6) & 1, k2 = row & 63; const size_t r = (size_t)u.x0 * 4096 + k1 + 64 * k2; const int col = ty * 512 + u.pn * 256 + c8;
        unsigned char* gd = (unsigned char*)g + r * (D * 2) + col;
        const float scl = 0.001381067932f;
        *(GAS v2u*)gd = (v2u){pk4_fp8(v0[0] * scl, v0[1] * scl, v0[2] * scl, v0[3] * scl), pk4_fp8(v0[4] * scl, v0[5] * scl, v0[6] * scl, v0[7] * scl)};
        *(GAS v2u*)(gd + 128) = (v2u){pk4_fp8(v1[0] * scl, v1[1] * scl, v1[2] * scl, v1[3] * scl), pk4_fp8(v1[4] * scl, v1[5] * scl, v1[6] * scl, v1[7] * scl)};
    }
    __device__ __forceinline__ void epiw(const Unit& u, int row, int c8, const float* a0, const float* a1, const float* b0, const float* b1, const NoPre&, const NoPre&, const NoPre&) const {
        const float scl = 0.001381067932f; const int odd = (c8 >> 3) & 1;
        const int k1 = 2 * u.x2 + (row >> 7), ty = (row >> 6) & 1, k2 = (row & 63) + 16 * odd; const size_t r = (size_t)u.x0 * 4096 + k1 + 64 * k2; const int col = ty * 512 + u.pn * 256 + (c8 & ~8);
        unsigned char* gd = (unsigned char*)g + r * (D * 2) + col;
#define F8W(v) pk8_fp8s(v, scl)
        *(GAS v4u*)gd = swap8_pair(F8W(a0), F8W(b0)); *(GAS v4u*)(gd + 128) = swap8_pair(F8W(a1), F8W(b1));
#undef F8W
    }
};
struct PFold {
    static constexpr bool PAIRED = false, FP8 = false; static constexpr int EB = 4, LINA = 1024;
    int first, c; const bf16 *wft, *fb; bf16* wf;
    __device__ __forceinline__ bool next(int i, Unit& u) const {
        const int idx = c - first; if (i != 0 || idx < 0 || idx >= 32) return false;
        const int l = idx >> 4, g = (idx >> 2) & 3, nt = idx & 3; u.x0 = l; u.x1 = g; u.pm = nt; u.pn = 0;
        u.A = wft + ((size_t)l * D + nt * 256) * 512 + g * 128; u.lda = 512; u.B = fb; u.ldb = 128; u.K = 128; return true; }
    __device__ __forceinline__ unsigned a_off(const Unit& u, int row) const { return (unsigned)row * 1024u; }
    typedef NoPre Pre; typedef NoPre UPre;
    __device__ __forceinline__ NoPre pre(const Unit&, int, int) const { return NoPre{}; }
    __device__ __forceinline__ NoPre upre(const Unit&, int) const { return NoPre{}; }
    __device__ __forceinline__ void epi(const Unit& u, int row, int c8, const float* v0, const float* v1, const NoPre&, const NoPre&) const {
        unsigned char* dst = (unsigned char*)wf + (size_t)u.x0 * D * D + (size_t)(u.pm * 256 + row) * D + u.x1 * 128 + c8;
        *(GAS v2u*)dst = (v2u){pk4_fp8(v0[0] * MOE_WS, v0[1] * MOE_WS, v0[2] * MOE_WS, v0[3] * MOE_WS), pk4_fp8(v0[4] * MOE_WS, v0[5] * MOE_WS, v0[6] * MOE_WS, v0[7] * MOE_WS)};
        *(GAS v2u*)(dst + 512) = (v2u){pk4_fp8(v1[0] * MOE_WS, v1[1] * MOE_WS, v1[2] * MOE_WS, v1[3] * MOE_WS), pk4_fp8(v1[4] * MOE_WS, v1[5] * MOE_WS, v1[6] * MOE_WS, v1[7] * MOE_WS)};
    }
};
struct PMerge {
    static constexpr bool PAIRED = false, FP8 = false, CHAIN = true, MIXED = true; static constexpr int EB = 2, LINA = 2 * D;
    int G, c, npan; const unsigned char *gm, *wf, *sgr, *sgf; const bf16 *y, *wr; bf16 *mg;
    __device__ __forceinline__ bool next(int i, Unit& u) const {
        const int tile = (i >> 1) * G + c; if (tile >= npan * 4) return false;
        order2d(tile, npan, 4, u.pm, u.pn); u.x0 = i & 1; u.lda = D; u.ldb = u.x0 ? D : D / 2; u.K = u.x0 ? D : D / 2;
        u.A = u.x0 ? y + (size_t)u.pm * 256 * D : (const bf16*)(gm + (size_t)u.pm * 256 * D * 2); u.B = u.x0 ? wr + (size_t)u.pn * 256 * D : (const bf16*)(wf + (size_t)u.pn * 256 * D); return true; }
    __device__ __forceinline__ unsigned a_off(const Unit& u, int row) const { return (unsigned)row * (D * 2); }
    struct Pre { v2u a0, a1, b0, b1; }; typedef NoPre UPre;
    __device__ __forceinline__ NoPre upre(const Unit&, int) const { return NoPre{}; }
    __device__ __forceinline__ Pre pre(const Unit& u, int row, int c8) const {
        const unsigned o = (unsigned)(((size_t)u.pm * 256 + row) * D + u.pn * 256 + c8); Pre r; const unsigned char* s = u.x0 ? sgr : sgf;
        const __amdgpu_buffer_rsrc_t ra = __builtin_amdgcn_make_buffer_rsrc((void*)s, 0, (int)((size_t)NT * D), 0x00020000), rb = __builtin_amdgcn_make_buffer_rsrc((void*)sgr, 0, u.x0 ? 0 : (int)((size_t)NT * D), 0x00020000);
        r.a0 = __builtin_amdgcn_raw_buffer_load_b64(ra, (int)o, 0, 0); r.a1 = __builtin_amdgcn_raw_buffer_load_b64(ra, (int)o + 128, 0, 0);
        r.b0 = __builtin_amdgcn_raw_buffer_load_b64(rb, (int)o, 0, 0); r.b1 = __builtin_amdgcn_raw_buffer_load_b64(rb, (int)o + 128, 0, 0);
        return r; }
    __device__ __forceinline__ void scale(const Pre& pr, f32x4* q) const {
        float s[16], t[16]; unpack8_u8(pr.a0, s); unpack8_u8(pr.a1, s + 8); unpack8_u8(pr.b0, t); unpack8_u8(pr.b1, t + 8);
#pragma unroll
        for (int j = 0; j < 16; ++j) q[j >> 2][j & 3] = s[j] * (1.f / MOE_WS) * __builtin_amdgcn_rcpf(fmaxf(t[j], 1.f)); }
    __device__ __forceinline__ void epi(const Unit& u, int row, int c8, const float* v0, const float* v1, const Pre& pr, const NoPre&) const {
        const unsigned o = (unsigned)(((size_t)u.pm * 256 + row) * D + u.pn * 256 + c8) * 2u;
        const __amdgpu_buffer_rsrc_t rm = __builtin_amdgcn_make_buffer_rsrc((void*)mg, 0, (int)((size_t)NT * D * 2), 0x00020000);
#pragma unroll
        for (int h = 0; h < 2; ++h) { const float* v = h ? v1 : v0; float s[8], r[8];
            unpack8_u8(h ? pr.a1 : pr.a0, s);
#pragma unroll
            for (int j = 0; j < 8; ++j) r[j] = fmaxf(s[j], 1.f) * (1.f / 255.f) * v[j];
            __builtin_amdgcn_raw_buffer_store_b128(pack8(r), rm, (int)o + h * 256, 0, 0); }
    }
};
struct PWout {
    static constexpr bool PAIRED = false, FP8 = false; static constexpr int EB = 2, LINA = 2 * D;
    int G, c, npan, l; const bf16 *mg, *wo; const float *xold_l, *xold_c; bf16* xs; const float* g1;
    __device__ __forceinline__ bool next(int i, Unit& u) const {
        const int idx = i * G + c; if (idx >= npan * 4) return false;
        order2d(idx, npan, 4, u.pm, u.pn); u.lda = D; u.ldb = D; u.K = D; u.A = mg + (size_t)u.pm * 256 * D; u.B = wo + (size_t)u.pn * 256 * D; return true; }
    __device__ __forceinline__ unsigned a_off(const Unit& u, int row) const { return (unsigned)row * (D * 2); }
    struct Pre { f32x4 x[4]; }; struct UPre { f32x4 g[4]; };
    __device__ __forceinline__ UPre upre(const Unit& u, int c8) const { const float* gg = g1 + (size_t)mb_of(u.pm * 256) * NMOD * D + u.pn * 256 + c8; UPre r;
        r.g[0] = *(const GAS f32x4*)gg; r.g[1] = *(const GAS f32x4*)(gg + 4); r.g[2] = *(const GAS f32x4*)(gg + 128); r.g[3] = *(const GAS f32x4*)(gg + 132); return r; }
    __device__ __forceinline__ Pre pre(const Unit& u, int row, int c8) const { const int r = u.pm * 256 + row;
        Pre p;
        const bool lat = u.pm < NL / 256;
        const char* base = l ? (const char*)xs : lat ? (const char*)xold_l : (const char*)(xold_c - (size_t)NL * D); const int esz = l ? 2 : 4;
        const char* xo = base + ((size_t)r * D + u.pn * 256 + c8) * esz; const int o1 = l ? 256 : 16, o2 = l ? 0 : 512, o3 = l ? 256 : 528;
        p.x[0] = *(const GAS f32x4*)xo; p.x[1] = *(const GAS f32x4*)(xo + o1); p.x[2] = *(const GAS f32x4*)(xo + o2); p.x[3] = *(const GAS f32x4*)(xo + o3);
        return p; }
    __device__ __forceinline__ void epi(const Unit& u, int row, int c8, const float* v0, const float* v1, const Pre& pr, const UPre& up) const {
        const int r = u.pm * 256 + row;
        bf16* xn = xs + (size_t)r * D + u.pn * 256 + c8; float xo[16], o[16];
        float xb[16]; unpack8(__builtin_bit_cast(v4u, pr.x[0]), xb); unpack8(__builtin_bit_cast(v4u, pr.x[1]), xb + 8);
#pragma unroll
        for (int q = 0; q < 4; ++q) { xo[4 * q] = l ? xb[4 * q] : pr.x[q][0]; xo[4 * q + 1] = l ? xb[4 * q + 1] : pr.x[q][1]; xo[4 * q + 2] = l ? xb[4 * q + 2] : pr.x[q][2]; xo[4 * q + 3] = l ? xb[4 * q + 3] : pr.x[q][3]; }
#pragma unroll
        for (int q = 0; q < 4; ++q) { const float* v = (q < 2 ? v0 : v1) + 4 * (q & 1);
            o[4 * q] = xo[4 * q] + up.g[q][0] * v[0]; o[4 * q + 1] = xo[4 * q + 1] + up.g[q][1] * v[1]; o[4 * q + 2] = xo[4 * q + 2] + up.g[q][2] * v[2]; o[4 * q + 3] = xo[4 * q + 3] + up.g[q][3] * v[3]; }
        *(GAS v4u*)xn = pack8(o); *(GAS v4u*)(xn + 128) = pack8(o + 8);
    }
};
struct PMoe1 {
    static constexpr bool PAIRED = false, FP8 = true, WIDE8 = true, EARLYA = true; static constexpr int EB = 4;
    int G, c; const unsigned char* hx2; const unsigned char* w; const int2* list; unsigned char* he; const LAS int* ts; const LAS int* cn;
    __device__ __forceinline__ bool next(int i, Unit& u) const {
        const int ntl = __builtin_amdgcn_readfirstlane(ts[16]); const int idx = i * G + c; if (idx >= ntl * 8) return false;
        int tile; order2d(idx, ntl, 8, tile, u.pn); u.pm = tile; int e = 0;
#pragma unroll
        for (int j = 1; j < 16; ++j) e += (tile >= ts[j]) ? 1 : 0;
        e = __builtin_amdgcn_readfirstlane(e);
        u.x0 = e; u.x1 = (tile - __builtin_amdgcn_readfirstlane(ts[e])) * 256; u.x2 = __builtin_amdgcn_readfirstlane(cn[e]);
        u.A = (const bf16*)hx2; u.lda = D / 2; u.B = (const bf16*)(w + (size_t)e * 3 * D * D + (size_t)u.pn * 256 * D); u.ldb = D / 2; u.K = D / 2; return true; }
    __device__ __forceinline__ unsigned a_off(const Unit& u, int row) const {
        int p = u.x1 + row; p = p < u.x2 ? p : u.x2 - 1; const int r = ((const GAS int*)list)[2 * ((size_t)u.x0 * NT + p)] & 0x7fffffff; return (unsigned)r * D; }
    __device__ __forceinline__ unsigned a_raw(const Unit& u, int row) const { int p = u.x1 + row; p = p < u.x2 ? p : u.x2 - 1; return (unsigned)((const GAS int*)list)[2 * ((size_t)u.x0 * NT + p)]; }
    __device__ __forceinline__ unsigned a_fin(unsigned raw) const { return (raw & 0x7fffffffu) * D; }
    typedef NoPre Pre; typedef NoPre UPre;
    __device__ __forceinline__ NoPre pre(const Unit&, int, int) const { return NoPre{}; }
    __device__ __forceinline__ NoPre upre(const Unit&, int) const { return NoPre{}; }
    __device__ __forceinline__ void epi(const Unit& u, int row, int c8, const float* v0, const float* v1, const NoPre&, const NoPre&) const {
        float r[8];
#pragma unroll
        for (int j = 0; j < 8; j += 2) { const f32x2 x0 = (f32x2){v0[j], v0[j + 1]}; const f32x2 g = (x0 * (f32x2){v1[j], v1[j + 1]}) * sigmoid_pk_s(x0, 1.f / MOE_WS, MOE_HS / (MOE_WS * MOE_WS)); r[j] = g.x; r[j + 1] = g.y; }
        *(GAS v2u*)(he + ((size_t)u.pm * 256 + row) * D + u.pn * 128 + c8) = (v2u){pk4_fp8(r[0], r[1], r[2], r[3]), pk4_fp8(r[4], r[5], r[6], r[7])};
    }
    __device__ __forceinline__ void epiw(const Unit& u, int row, int c8, const float* a0, const float* a1, const float* b0, const float* b1, const NoPre&, const NoPre&, const NoPre&) const {
        float ra[8], rb[8];
#pragma unroll
        for (int j = 0; j < 8; j += 2) { const f32x2 xa = (f32x2){a0[j], a0[j + 1]}, xb = (f32x2){b0[j], b0[j + 1]};
            const f32x2 ga = (xa * (f32x2){a1[j], a1[j + 1]}) * sigmoid_pk_s(xa, 1.f / MOE_WS, MOE_HS / (MOE_WS * MOE_WS)), gb = (xb * (f32x2){b1[j], b1[j + 1]}) * sigmoid_pk_s(xb, 1.f / MOE_WS, MOE_HS / (MOE_WS * MOE_WS));
            ra[j] = ga.x; ra[j + 1] = ga.y; rb[j] = gb.x; rb[j + 1] = gb.y; }
        const v4u o = swap8_pair((v2u){pk4_fp8(ra[0], ra[1], ra[2], ra[3]), pk4_fp8(ra[4], ra[5], ra[6], ra[7])}, (v2u){pk4_fp8(rb[0], rb[1], rb[2], rb[3]), pk4_fp8(rb[4], rb[5], rb[6], rb[7])});
        const int odd = (c8 >> 3) & 1;
        *(GAS v4u*)(he + ((size_t)u.pm * 256 + row + 16 * odd) * D + u.pn * 128 + (c8 & ~8)) = o;
    }
};
struct PMoe2 {
    static constexpr bool PAIRED = false, FP8 = true, WIDE8 = true, UPF = true; static constexpr int EB = 4, LINA = D;
    int G, c; const unsigned char* he; const unsigned char* w; const int2* list; unsigned char* c01; const LAS int* ts; const LAS int* cn; LAS unsigned char* lbuf;
    __device__ __forceinline__ bool next(int i, Unit& u) const {
        const int ntl = __builtin_amdgcn_readfirstlane(ts[16]); const int idx = i * G + c; if (idx >= ntl * 4) return false;
        int tile; order2d(idx, ntl, 4, tile, u.pn); u.pm = tile; int e = 0;
#pragma unroll
        for (int j = 1; j < 16; ++j) e += (tile >= ts[j]) ? 1 : 0;
        e = __builtin_amdgcn_readfirstlane(e);
        u.x0 = e; u.x1 = (tile - __builtin_amdgcn_readfirstlane(ts[e])) * 256; u.x2 = __builtin_amdgcn_readfirstlane(cn[e]);
        u.A = (const bf16*)(he + (size_t)tile * 256 * D); u.lda = D / 2; u.B = (const bf16*)(w + (size_t)e * 3 * D * D + (size_t)2 * D * D + (size_t)u.pn * 256 * D); u.ldb = D / 2; u.K = D / 2; u.x3 = i & 1; return true; }
    __device__ __forceinline__ unsigned a_off(const Unit& u, int row) const { return (unsigned)row * D; }
    __device__ __forceinline__ void unit_prefetch(const Unit& u, int wid, int lane) const {
        if (wid < 2) { unsigned lo = (unsigned)lane * 16u; asm volatile("" : "+v"(lo));
            __builtin_amdgcn_global_load_lds((const unsigned*)((const char*)(list + (size_t)u.x0 * NT + u.x1) + wid * 1024 + lo), (LAS unsigned*)(lbuf + u.x3 * 2048 + wid * 1024), 16, 0, 0); } }
    struct Pre { int2 en; }; typedef NoPre UPre;
    __device__ __forceinline__ NoPre upre(const Unit&, int) const { return NoPre{}; }
    __device__ __forceinline__ Pre pre(const Unit& u, int row, int) const { Pre r; const v2u e2 = *(const LAS v2u*)(lbuf + u.x3 * 2048 + row * 8); r.en.x = (int)e2.x; r.en.y = (int)e2.y; return r; }
    __device__ __forceinline__ void epi(const Unit& u, int row, int c8, const float* v0, const float* v1, const Pre& pr, const NoPre&) const {
        const int p = u.x1 + row; if (p >= u.x2) return;
        const int2 en = pr.en; const int r = en.x & 0x7fffffff, s = (en.x >> 31) & 1; const float w8 = __builtin_bit_cast(float, en.y) * (MOE_CS / (MOE_WS * MOE_HS));
        unsigned char* dst = c01 + ((size_t)s * NT + r) * D + u.pn * 256 + c8;
        *(GAS v2u*)dst = pk8_fp8s(v0, w8); *(GAS v2u*)(dst + 128) = pk8_fp8s(v1, w8);
    }
    __device__ __forceinline__ void epiw(const Unit& u, int row, int c8, const float* a0, const float* a1, const float* b0, const float* b1, const Pre& pa, const Pre& pb, const NoPre&) const {
        const float wa = __builtin_bit_cast(float, pa.en.y) * (MOE_CS / (MOE_WS * MOE_HS)), wb = __builtin_bit_cast(float, pb.en.y) * (MOE_CS / (MOE_WS * MOE_HS));
        const v4u o0 = swap8_pair(pk8_fp8s(a0, wa), pk8_fp8s(b0, wb));
        const v4u o1 = swap8_pair(pk8_fp8s(a1, wa), pk8_fp8s(b1, wb));
        const int odd = (c8 >> 3) & 1, p = u.x1 + row + 16 * odd; if (p >= u.x2) return;
        const int ex = odd ? pb.en.x : pa.en.x, r = ex & 0x7fffffff, s = (ex >> 31) & 1;
        unsigned char* dst = c01 + ((size_t)s * NT + r) * D + u.pn * 256 + (c8 & ~8);
        *(GAS v4u*)dst = o0; *(GAS v4u*)(dst + 128) = o1;
    }
};

template <int F8 = 0> __device__ __forceinline__ void transpose_item(const float* W, int K, int N, bf16* WT, int k0, int n0, int drow0, LAS float* scr, int lane) {
    const int kr = lane >> 3, n4 = (lane & 7) * 4; f32x4 v[8];
#pragma unroll
    for (int i = 0; i < 8; ++i) v[i] = __builtin_nontemporal_load((const GAS f32x4*)(W + (size_t)(k0 + 8 * i + kr) * N + n0 + n4));
#pragma unroll
    for (int i = 0; i < 8; ++i) { LAS float* d = scr + (8 * i + kr) * 33 + n4; d[0] = v[i][0]; d[1] = v[i][1]; d[2] = v[i][2]; d[3] = v[i][3]; }
    LDS_WAIT(); asm volatile("" ::: "memory");
    const int c = lane & 7;
#pragma unroll
    for (int j = 0; j < 4; ++j) { const int n = (lane >> 3) + 8 * j; const LAS float* s = scr + (8 * c) * 33 + n;
        if constexpr (F8) { *(GAS v2u*)((unsigned char*)WT + (size_t)(drow0 + n) * K + k0 + 8 * c) = (v2u){pk4_fp8(s[0 * 33] * MOE_WS, s[1 * 33] * MOE_WS, s[2 * 33] * MOE_WS, s[3 * 33] * MOE_WS), pk4_fp8(s[4 * 33] * MOE_WS, s[5 * 33] * MOE_WS, s[6 * 33] * MOE_WS, s[7 * 33] * MOE_WS)}; }
        else { v4u o; o.x = pk2(s[0 * 33], s[1 * 33]); o.y = pk2(s[2 * 33], s[3 * 33]); o.z = pk2(s[4 * 33], s[5 * 33]); o.w = pk2(s[6 * 33], s[7 * 33]);
        *(GAS v4u*)(WT + (size_t)(drow0 + n) * K + k0 + 8 * c) = o; } }
    LDS_WAIT(); asm volatile("" ::: "memory");
}
__device__ __forceinline__ void p_prologue(Frame& F) {
    const int gw = F.bid * NWAVES + F.wave, NGW = F.G * NWAVES;
    LAS float* scr = (LAS float*)(F.lds + F.wave * 16384);
    constexpr int I_IN = 16 * 144, I_SQ = 16 * 32, I_WF = 8 * 32;
    constexpr int NIT = 2 * (I_IN + 2 * I_SQ + I_WF);
    const int tw0 = F.G > 192 + 32 ? 192 : 0, gwt = (F.bid - tw0) * NWAVES + F.wave, NGWT = (F.G - tw0) * NWAVES; const int NIT1 = tw0 ? 4864 : NIT;
    if (F.bid >= tw0)
    for (int it = gwt; it < NIT1; it += NGWT) {
        int r = it; const int l = r / (I_IN + 2 * I_SQ + I_WF); r -= l * (I_IN + 2 * I_SQ + I_WF);
        if (r >= I_IN + 2 * I_SQ) { r -= I_IN + 2 * I_SQ; const int kb = r / 32, nb = r % 32;
            transpose_item(F.kin[16] + (size_t)l * 512 * D, 512, D, (bf16*)(F.ws + WS_LRU) + (size_t)l * D * 512, kb * 64, nb * 32, nb * 32, scr, F.lane); continue; }
        if (r < I_IN) { const int kb = r / 144, nb = r % 144;
            if (nb < 64) transpose_item(F.kin[7] + (size_t)l * D * INW, D, INW, (bf16*)(F.ws + WS_WIN) + (size_t)l * INW * D, kb * 64, nb * 32, nb * 32, scr, F.lane);
            else if (nb < 80) transpose_item<1>(F.kin[7] + (size_t)l * D * INW, D, INW, (bf16*)(F.ws + WS_WIN) + (size_t)l * INW * D + (size_t)2048 * D, kb * 64, nb * 32, nb * 32 - 2048, scr, F.lane);
            else transpose_item<1>(F.kin[7] + (size_t)l * D * INW, D, INW, (bf16*)(F.ws + WS_WIN) + (size_t)l * INW * D + (size_t)2560 * D, kb * 64, nb * 32, nb * 32 - 2560, scr, F.lane);
            continue; }
        r -= I_IN;
        const int which = r / I_SQ; r -= which * I_SQ; const int kb = r / 32, nb = r % 32;
        transpose_item(F.kin[which ? 17 : 15] + (size_t)l * D * D, D, D, (bf16*)(F.ws + (which ? WS_WO : WS_WR)) + (size_t)l * D * D, kb * 64, nb * 32, nb * 32, scr, F.lane);
    }
    __syncthreads();
    LAS float* T4 = (LAS float*)(F.lds + 65536);
    for (int o = F.tid; o < 4096; o += NTHR) T4[o] = cospif((float)o * (2.0f / 4096.0f));
    __syncthreads();
    { const float scl = 1.0f / sqrtf(4096.f * 128.f), scc = 1.0f / sqrtf(256.f * 128.f);
      bf16* fa = (bf16*)(F.ws + WS_CSC + 256 * 1024); bf16* fc = (bf16*)(F.ws + WS_CSC + 512 * 1024);
      for (int o = F.bid * NTHR + F.tid; o < 256 * 128; o += F.G * NTHR) {
          const int m = o >> 7, k = o & 127, ri = m >> 7, cqm = (m >> 6) & 1, k1 = m & 63, cqk = k >> 6, t1 = k & 63;
          const float v = cqm == cqk ? T4[(64 * ((k1 * t1) & 63) + (ri ? 1024 : 0)) & 4095] : 0.f; fa[o] = (bf16)f2bf(v); }
      for (int o = F.bid * NTHR + F.tid; o < 256 * 64; o += F.G * NTHR) {
          const int m = o >> 6, k0 = (o & 63) * 4, qm = m >> 7, ty = (m >> 6) & 1, k2 = m & 63; float v4[4];
#pragma unroll
          for (int j = 0; j < 4; ++j) { const int k = k0 + j, qk = k >> 7, ri = (k >> 6) & 1, t2 = k & 63;
              const int sh = ty == 0 ? (ri == 0 ? 0 : 3072) : (ri == 0 ? 3072 : 2048);
              v4[j] = qm == qk ? T4[(64 * ((k2 * t2) & 63) + sh) & 4095] : 0.f; }
          *(GAS unsigned*)((unsigned char*)fc + (size_t)m * 256 + k0) = pk4_fp8(v4[0], v4[1], v4[2], v4[3]); }
      for (int o = F.bid * NTHR + F.tid; o < 256 * 128; o += F.G * NTHR) {
          const int cp = o >> 7, m = o & 127, ph = ((cp & 127) * m) & 127; ((bf16*)(F.ws + WS_CSC + 768 * 1024))[o] = (bf16)f2bf(T4[(32 * ph + (cp < 128 ? 0 : 1024)) & 4095]); }
      for (int o = F.bid * NTHR + F.tid; o < 512 * 32; o += F.G * NTHR) {
          const int r = o >> 5, t0 = (o & 31) * 8, rr = r & 255, sh = r < 256 ? 0 : 3072; float v[8];
#pragma unroll
          for (int j = 0; j < 8; ++j) v[j] = T4[(16 * ((rr * (t0 + j)) & 255) + sh) & 4095] * scc;
          *(GAS v4u*)((bf16*)(F.ws + WS_CSC) + (size_t)r * 256 + t0) = pack8(v); } }
    for (int o = F.bid * NTHR + F.tid; o < 2 * 2 * 1024; o += F.G * NTHR) { const float lam = F.kin[14][o]; const float sp = (-lam > 20.f) ? -lam : log1pf(__expf(-lam));
        ((float*)(F.ws + WS_MODS + 512 * 1024))[o] = -8.0f * sp; }
    __syncthreads();
    { LAS float* sc = (LAS float*)(F.lds + 131072 - 9 * 1024 * 4);
      LAS float* red = (LAS float*)F.lds;
      for (int o = F.tid; o < 9 * 1024; o += NTHR) { const float cv = o < 8192 ? F.kin[1][o] : F.kin[3][o - 8192]; sc[o] = siluf_(cv); }
      __syncthreads();
      for (int it = F.bid; it < 2 * (NMOD * D / 64); it += F.G) {
          const int l = it / (NMOD * D / 64), nb = it % (NMOD * D / 64), lq = F.lane & 15, lg = F.lane >> 4;
          const float* w = F.kin[4] + (size_t)l * D * NMOD * D + nb * 64 + lq * 4; f32x4 acc[9];
#pragma unroll
          for (int q = 0; q < 9; ++q) acc[q] = (f32x4){0.f, 0.f, 0.f, 0.f};
          const int kb = F.wave * 128 + lg;
          for (int i0 = 0; i0 < 32; i0 += 32) { f32x4 wv[32];
#pragma unroll
              for (int i = 0; i < 32; ++i) wv[i] = *(const GAS f32x4*)(w + (size_t)(kb + 4 * (i0 + i)) * NMOD * D);
#pragma unroll
              for (int i = 0; i < 32; ++i) { const int k = kb + 4 * (i0 + i);
#pragma unroll
                  for (int q = 0; q < 9; ++q) acc[q] += sc[q * 1024 + k] * wv[i];
                  __builtin_amdgcn_sched_barrier(0); } }
#pragma unroll
          for (int q = 0; q < 9; ++q) *(LAS f32x4*)(red + ((F.wave * 4 + lg) * 9 + q) * 64 + lq * 4) = acc[q];
          __syncthreads();
          for (int o = F.tid; o < 9 * 64; o += NTHR) { const int q = o >> 6, ln = o & 63; float s = 0.f;
#pragma unroll
              for (int pp = 0; pp < 32; ++pp) s += red[(pp * 9 + q) * 64 + ln];
              const int nn = nb * 64 + ln;
              ((float*)(F.ws + WS_MODS))[((size_t)(l * 9 + q)) * NMOD * D + nn] = s + F.kin[5][(size_t)l * NMOD * D + nn]; }
          __syncthreads();
      } }
    __syncthreads();
    if (tw0 && F.bid < tw0)
    for (int it = NIT1 + F.bid * NWAVES + F.wave; it < NIT; it += tw0 * NWAVES) {
        int r = it; const int l = r / (I_IN + 2 * I_SQ + I_WF); r -= l * (I_IN + 2 * I_SQ + I_WF);
        if (r >= I_IN + 2 * I_SQ) { r -= I_IN + 2 * I_SQ; const int kb = r / 32, nb = r % 32;
            transpose_item(F.kin[16] + (size_t)l * 512 * D, 512, D, (bf16*)(F.ws + WS_LRU) + (size_t)l * D * 512, kb * 64, nb * 32, nb * 32, scr, F.lane); continue; }
        if (r < I_IN) { const int kb = r / 144, nb = r % 144;
            if (nb < 64) transpose_item(F.kin[7] + (size_t)l * D * INW, D, INW, (bf16*)(F.ws + WS_WIN) + (size_t)l * INW * D, kb * 64, nb * 32, nb * 32, scr, F.lane);
            else if (nb < 80) transpose_item<1>(F.kin[7] + (size_t)l * D * INW, D, INW, (bf16*)(F.ws + WS_WIN) + (size_t)l * INW * D + (size_t)2048 * D, kb * 64, nb * 32, nb * 32 - 2048, scr, F.lane);
            else transpose_item<1>(F.kin[7] + (size_t)l * D * INW, D, INW, (bf16*)(F.ws + WS_WIN) + (size_t)l * INW * D + (size_t)2560 * D, kb * 64, nb * 32, nb * 32 - 2560, scr, F.lane);
            continue; }
        r -= I_IN;
        const int which = r / I_SQ; r -= which * I_SQ; const int kb = r / 32, nb = r % 32;
        transpose_item(F.kin[which ? 17 : 15] + (size_t)l * D * D, D, D, (bf16*)(F.ws + (which ? WS_WO : WS_WR)) + (size_t)l * D * D, kb * 64, nb * 32, nb * 32, scr, F.lane);
    }
}

template <int MODE, bool F32IN = false> __device__ __forceinline__ void p_rows(Frame& F, int l, int dummy = 0) {
    const int NR = (MODE == 2 || (MODE == 1 && l == 1)) ? NL : NT;
    const bool comb = (MODE == 0 && l == 1) || MODE == 2;
    const int lane = F.lane;
    LAS float* RW = (LAS float*)F.lds;
    LAS int* lcnt = (LAS int*)(F.lds + 65536);
    LAS int* rinfo = lcnt + 64;
    LAS float* lgs = (LAS float*)(F.lds + 69632);
    const int rpb = (NR + F.G - 1) / F.G, r0 = F.bid * rpb, r1 = (r0 + rpb < NR) ? r0 + rpb : NR;
    const int rpw = (rpb + NWAVES - 1) / NWAVES, w0 = r0 + F.wave * rpw, w1 = (w0 + rpw < r1) ? w0 + rpw : r1;
    if (MODE == 1) {
#pragma unroll
        for (int i = 0; i < 8; ++i) { const int f = F.tid + NTHR * i, k = f >> 2, e4 = f & 3; const f32x4 wv = *(const GAS f32x4*)(F.kin[19] + (size_t)f * 4);
            *(LAS f32x4*)(RW + ((((k >> 8) * 4 + (k & 3)) * 4 + e4) * 64 + ((k & 255) >> 2)) * 4) = wv; }
        if (F.tid < 32) lcnt[F.tid] = 0; __syncthreads(); }
    const float* gn = MODE == 0 ? F.kin[6] + (size_t)l * D : MODE == 1 ? F.kin[18] + (size_t)l * D : F.kin[24];
    bf16* hx = (bf16*)(F.ws + WS_RA); const unsigned char* c01 = F.ws + WS_C01;
    constexpr bool f32in = F32IN;
    const float* xin_l = F.kin[0]; const float* xin_c = F.kin[2]; bf16* xs = (bf16*)(F.ws + WS_XS);
    float cA[16], cB[16], g2v[16]; int cur_mb = -1;
#pragma unroll
    for (int q = 0; q < 16; ++q) { cA[q] = 0.f; cB[q] = 0.f; g2v[q] = 0.f; }
    constexpr int RS = 2;
    f32x4 nv[RS][4]; v2u nb[RS][4]; unsigned nc0[RS][4], nc1[RS][4];
#pragma unroll
    for (int s = 0; s < RS; ++s)
#pragma unroll
    for (int j = 0; j < 4; ++j) { nv[s][j] = (f32x4){0.f, 0.f, 0.f, 0.f}; nb[s][j] = (v2u){0u, 0u}; nc0[s][j] = 0u; nc1[s][j] = 0u; }
#define PR_LOAD(S, R) do { const int r_ = (R); const float* s_ = r_ < NL ? xin_l + (size_t)r_ * D : xin_c + (size_t)(r_ - NL) * D; \
        _Pragma("unroll") for (int j = 0; j < 4; ++j) { if (MODE == 0 && f32in) nv[S][j] = *(const GAS f32x4*)(s_ + lane * 4 + 256 * j); else nb[S][j] = *(const GAS v2u*)(xs + (size_t)r_ * D + lane * 4 + 256 * j); \
            if (comb) { nc0[S][j] = *(const GAS unsigned*)(c01 + (size_t)r_ * D + lane * 4 + 256 * j); nc1[S][j] = *(const GAS unsigned*)(c01 + ((size_t)NT + r_) * D + lane * 4 + 256 * j); } } } while (0)
    v2u p_x[RS][4], p_h[RS][4]; unsigned p_8[RS][4]; f32x4 p_o[RS][4]; int p_row[RS];
#pragma unroll
    for (int s = 0; s < RS; ++s) { p_row[s] = -1;
#pragma unroll
    for (int j = 0; j < 4; ++j) { p_x[s][j] = (v2u){0u, 0u}; p_h[s][j] = (v2u){0u, 0u}; p_8[s][j] = 0u; p_o[s][j] = (f32x4){0.f, 0.f, 0.f, 0.f}; } }
#define PR_FLUSH() do { _Pragma("unroll") for (int s_ = 0; s_ < RS; ++s_) if (p_row[s_] >= 0) { _Pragma("unroll") for (int j = 0; j < 4; ++j) { const int k_ = lane * 4 + 256 * j; \
        if (MODE == 0 && comb) *(GAS v2u*)(xs + (size_t)p_row[s_] * D + k_) = p_x[s_][j]; \
        if (MODE == 0) { *(GAS v2u*)(hx + (size_t)p_row[s_] * D + k_) = p_h[s_][j]; *(GAS unsigned*)(F.ws + WS_CSL + (size_t)p_row[s_] * D + k_) = p_8[s_][j]; } \
        if (MODE == 1) *(GAS unsigned*)((unsigned char*)hx + (size_t)p_row[s_] * D + k_) = p_8[s_][j]; \
        if (MODE == 2) *(GAS f32x4*)(F.out + (size_t)p_row[s_] * D + k_) = p_o[s_][j]; } } } while (0)
#pragma unroll
    for (int s = 0; s < RS; ++s) if (w0 + s < w1) PR_LOAD(s, w0 + s);
    for (int r = w0; r < w1; r += RS) {
#pragma unroll
        for (int s = 0; s < RS; ++s) {
            if (MODE == 0 && f32in) asm volatile("" :: "v"(nv[s][0]), "v"(nv[s][1]), "v"(nv[s][2]), "v"(nv[s][3])); else asm volatile("" :: "v"(nb[s][0]), "v"(nb[s][1]), "v"(nb[s][2]), "v"(nb[s][3]));
            if (comb) asm volatile("" :: "v"(nc0[s][0]), "v"(nc0[s][1]), "v"(nc0[s][2]), "v"(nc0[s][3]), "v"(nc1[s][0]), "v"(nc1[s][1]), "v"(nc1[s][2]), "v"(nc1[s][3])); }
        __builtin_amdgcn_sched_barrier(0);
        PR_FLUSH();
        __builtin_amdgcn_sched_barrier(0);
        f32x4 vf[RS][4]; v2u vb[RS][4]; unsigned c0[RS][4], c1[RS][4];
#pragma unroll
        for (int s = 0; s < RS; ++s)
#pragma unroll
        for (int j = 0; j < 4; ++j) { vf[s][j] = nv[s][j]; vb[s][j] = nb[s][j]; c0[s][j] = nc0[s][j]; c1[s][j] = nc1[s][j]; }
#pragma unroll
        for (int s = 0; s < RS; ++s) if (r + RS + s < w1) PR_LOAD(s, r + RS + s);
        float oall[RS][16];
#pragma unroll
        for (int s = 0; s < RS; ++s) {
          const int rr = r + s; p_row[s] = -1;
#pragma unroll
          for (int i = 0; i < 16; ++i) oall[s][i] = 0.f;
          if (rr < w1) {
            f32x4 vrow[4];
#pragma unroll
            for (int j = 0; j < 4; ++j) vrow[j] = (MODE == 0 && f32in) ? vf[s][j] : (f32x4){bflo(vb[s][j].x), bfhi(vb[s][j].x), bflo(vb[s][j].y), bfhi(vb[s][j].y)};
            const int mb = mb_of(rr);
            if (mb != cur_mb) { cur_mb = mb;
                const float *sh = modp(F, l, mb, MODE == 1 ? 3 : 0), *sc = modp(F, l, mb, MODE == 1 ? 4 : 1), *g2 = modp(F, MODE == 2 ? 1 : 0, mb, 5);
#pragma unroll
                for (int j = 0; j < 4; ++j) { const int k = lane * 4 + 256 * j; const f32x4 g = *(const GAS f32x4*)(gn + k);
                    if (MODE != 2) { const f32x4 s1 = *(const GAS f32x4*)(sc + k), s0 = *(const GAS f32x4*)(sh + k);
#pragma unroll
                        for (int q = 0; q < 4; ++q) { cA[4 * j + q] = g[q] * (1.f + s1[q]); cB[4 * j + q] = s0[q]; } }
                    else {
#pragma unroll
                        for (int q = 0; q < 4; ++q) cA[4 * j + q] = g[q]; }
                    if (comb) { const f32x4 gv = *(const GAS f32x4*)(g2 + k);
#pragma unroll
                        for (int q = 0; q < 4; ++q) g2v[4 * j + q] = gv[q] * (1.f / MOE_CS); } } }
            float ss = 0.f;
#pragma unroll
            for (int j = 0; j < 4; ++j) {
                if (comb) { const f32x2 a01 = __builtin_amdgcn_cvt_pk_f32_fp8((int)c0[s][j], false), a23 = __builtin_amdgcn_cvt_pk_f32_fp8((int)c0[s][j], true), b01 = __builtin_amdgcn_cvt_pk_f32_fp8((int)c1[s][j], false), b23 = __builtin_amdgcn_cvt_pk_f32_fp8((int)c1[s][j], true);
                            vrow[j][0] += g2v[4 * j] * (a01.x + b01.x); vrow[j][1] += g2v[4 * j + 1] * (a01.y + b01.y);
                            vrow[j][2] += g2v[4 * j + 2] * (a23.x + b23.x); vrow[j][3] += g2v[4 * j + 3] * (a23.y + b23.y);
                            if (MODE == 0) { p_x[s][j].x = pk2(vrow[j][0], vrow[j][1]); p_x[s][j].y = pk2(vrow[j][2], vrow[j][3]); } }
                ss += (vrow[j][0] * vrow[j][0] + vrow[j][1] * vrow[j][1]) + (vrow[j][2] * vrow[j][2] + vrow[j][3] * vrow[j][3]); }
            const float rstd = rsqrtf(wave_sum(ss, lane) * (1.f / D) + RMS_EPS);
#pragma unroll
            for (int j = 0; j < 4; ++j) { float o[4];
#pragma unroll
                for (int q = 0; q < 4; ++q) { o[q] = vrow[j][q] * rstd * cA[4 * j + q] + cB[4 * j + q]; oall[s][4 * j + q] = o[q]; }
                if (MODE == 2) p_o[s][j] = (f32x4){o[0], o[1], o[2], o[3]};
                else if (MODE == 1) p_8[s][j] = pk4_fp8(o[0], o[1], o[2], o[3]);
                else { p_h[s][j].x = pk2(o[0], o[1]); p_h[s][j].y = pk2(o[2], o[3]); p_8[s][j] = pk4_fp8(o[0], o[1], o[2], o[3]); } }
            p_row[s] = rr; }
          __builtin_amdgcn_sched_barrier(0); }
        if (MODE == 1) {
          f32x2 lgA[8], lgB[8];
#pragma unroll
          for (int e = 0; e < 8; ++e) { lgA[e] = (f32x2){0.f, 0.f}; lgB[e] = (f32x2){0.f, 0.f}; }
          int rwo = lane * 16; asm volatile("" : "+v"(rwo));
#pragma unroll 1
          for (int i4 = 0; i4 < 16; i4 += 4)
#pragma unroll
          for (int i = i4; i < i4 + 4; ++i) { const LAS f32x4* rw = (const LAS f32x4*)((const LAS char*)RW + rwo) + (i * 4) * 64; const f32x2 oa = (f32x2){oall[0][i], oall[0][i]}, ob = (f32x2){oall[RS - 1][i], oall[RS - 1][i]};
#pragma unroll
              for (int e4 = 0; e4 < 4; ++e4) { const f32x4 w = rw[e4 * 64]; const f32x2 wl = (f32x2){w[0], w[1]}, wh = (f32x2){w[2], w[3]};
                  lgA[2 * e4] += oa * wl; lgA[2 * e4 + 1] += oa * wh; lgB[2 * e4] += ob * wl; lgB[2 * e4 + 1] += ob * wh; }
              if (i & 1) __builtin_amdgcn_sched_barrier(0); }
          const int npass = r + 1 < w1 ? 2 : 1;
          for (int ps = 0; ps < npass; ++ps) {
            const bool first = ps == 0; const int rr = r + ps; float lg[16];
#pragma unroll
            for (int e = 0; e < 8; ++e) { lg[2 * e] = first ? lgA[e].x : lgB[e].x; lg[2 * e + 1] = first ? lgA[e].y : lgB[e].y; }
#define PR_BP(x, m) __builtin_bit_cast(float, __builtin_amdgcn_ds_bpermute((lane ^ (m)) << 2, __builtin_bit_cast(int, (x))))
            float t8[8], t4[4], t2[2]; const bool b3 = lane & 8, b2 = lane & 4, b1 = lane & 2, b0 = lane & 1;
#pragma unroll
            for (int i = 0; i < 8; ++i) { const float snd = b3 ? lg[i] : lg[i + 8]; t8[i] = (b3 ? lg[i + 8] : lg[i]) + PR_BP(snd, 8); }
#pragma unroll
            for (int i = 0; i < 4; ++i) { const float snd = b2 ? t8[i] : t8[i + 4]; t4[i] = (b2 ? t8[i + 4] : t8[i]) + PR_BP(snd, 4); }
#pragma unroll
            for (int i = 0; i < 2; ++i) { const float snd = b1 ? t4[i] : t4[i + 2]; t2[i] = (b1 ? t4[i + 2] : t4[i]) + PR_BP(snd, 2); }
            float val; { const float snd = b0 ? t2[0] : t2[1]; val = (b0 ? t2[1] : t2[0]) + PR_BP(snd, 1); }
            val += PR_BP(val, 16); val += PR_BP(val, 32);
#undef PR_BP
            if (lane < 16) lgs[(rr - r0) * 16 + lane] = val;
          }
        }
    }
    PR_FLUSH();
#undef PR_FLUSH
#undef PR_LOAD
    if (MODE == 1) {
        __syncthreads();
        for (int rl = F.tid; rl < r1 - r0; rl += NTHR) {
            float aff[16], sel[16];
#pragma unroll
            for (int e4 = 0; e4 < 4; ++e4) { const f32x4 lv = *(const LAS f32x4*)(lgs + rl * 16 + 4 * e4);
#pragma unroll
                for (int i = 0; i < 4; ++i) { aff[4 * e4 + i] = sigmoidf_(lv[i]); sel[4 * e4 + i] = aff[4 * e4 + i] + F.kin[20][4 * e4 + i]; } }
            int grp = 0; float best = -1e30f;
#pragma unroll
            for (int g = 0; g < 4; ++g) { const float a = sel[4 * g], b = sel[4 * g + 1], c = sel[4 * g + 2], dd = sel[4 * g + 3];
                const float s = fmaxf(fmaxf(fmaxf(a + b, a + c), fmaxf(a + dd, b + c)), fmaxf(b + dd, c + dd));
                if (s > best) { best = s; grp = g; } }
            float s4[4], a4[4];
#pragma unroll
            for (int q = 0; q < 4; ++q) { s4[q] = grp == 0 ? sel[q] : grp == 1 ? sel[4 + q] : grp == 2 ? sel[8 + q] : sel[12 + q]; a4[q] = grp == 0 ? aff[q] : grp == 1 ? aff[4 + q] : grp == 2 ? aff[8 + q] : aff[12 + q]; }
            int i0 = 0; float m0 = s4[0], af0 = a4[0];
#pragma unroll
            for (int q = 1; q < 4; ++q) if (s4[q] > m0) { m0 = s4[q]; i0 = q; af0 = a4[q]; }
            int i1 = -1; float m1 = -1e30f, af1 = 0.f;
#pragma unroll
            for (int q = 0; q < 4; ++q) if (q != i0 && s4[q] > m1) { m1 = s4[q]; i1 = q; af1 = a4[q]; }
            const int e0 = grp * 4 + i0, e1 = grp * 4 + i1; const float inv = 1.f / (af0 + af1);
            { const int lr0 = __hip_atomic_fetch_add(lcnt + e0, 1, __ATOMIC_RELAXED, __HIP_MEMORY_SCOPE_WORKGROUP), lr1 = __hip_atomic_fetch_add(lcnt + e1, 1, __ATOMIC_RELAXED, __HIP_MEMORY_SCOPE_WORKGROUP);
                LAS int* ri = rinfo + rl * 5; ri[0] = e0 | (e1 << 8); ri[1] = lr0; ri[2] = lr1; ri[3] = __builtin_bit_cast(int, af0 * inv); ri[4] = __builtin_bit_cast(int, af1 * inv); }
        }
        __syncthreads();
        if (F.tid < 16) lcnt[16 + F.tid] = (int)__hip_atomic_fetch_add(F.ctl + CW_CNT + 64 * l + 128 * dummy + F.tid, (unsigned)lcnt[F.tid], __ATOMIC_RELAXED, __HIP_MEMORY_SCOPE_AGENT);
        __syncthreads();
        int2* list = (int2*)(F.ws + (dummy ? WS_SUM : WS_LIST));
        for (int rl = F.tid; rl < r1 - r0; rl += NTHR) { const LAS int* ri = rinfo + rl * 5; const int e0 = ri[0] & 255, e1 = ri[0] >> 8, r = r0 + rl;
            list[(size_t)e0 * NT + lcnt[16 + e0] + ri[1]] = make_int2(r, ri[3]);
            list[(size_t)e1 * NT + lcnt[16 + e1] + ri[2]] = make_int2(r | (int)0x80000000, ri[4]); }
    }
}
__device__ __forceinline__ void p_transpose(Frame& F, int l) {
    const bf16* uf = (const bf16*)(F.ws + WS_RF); bf16* ut4 = (bf16*)(F.ws + WS_RG); bf16* utc = (bf16*)(F.ws + WS_UTC);
    LAS bf16* tile = (LAS bf16*)F.lds;
    for (int it = F.bid; it < 512; it += F.G) {
        const int b = it >> 6, t2b = (it >> 3) & 7, cb = it & 7;
        __syncthreads();
#pragma unroll
        for (int i = 0; i < 8; ++i) { const int p = F.tid + NTHR * i, rr = p >> 3, c8 = (p & 7) * 8, t1 = rr >> 3, t2l = rr & 7;
            const v4u w = *(const GAS v4u*)(uf + ((size_t)b * 4096 + 64 * t1 + 8 * t2b + t2l) * 512 + cb * 64 + c8);
            LAS unsigned* d = (LAS unsigned*)(tile + (t2l * 64 + t1) * 66 + c8); d[0] = w.x; d[1] = w.y; d[2] = w.z; d[3] = w.w; }
        __syncthreads();
#pragma unroll
        for (int i = 0; i < 8; ++i) { const int q = F.tid + NTHR * i, t1b = q & 7, cq = (q >> 3) & 1, cpl = (q >> 4) & 31, t2l = q >> 9; unsigned h[8];
#pragma unroll
            for (int j = 0; j < 8; ++j) h[j] = tile[(t2l * 64 + t1b * 8 + j) * 66 + 2 * cpl + cq];
            v4u o; o.x = h[0] | (h[1] << 16); o.y = h[2] | (h[3] << 16); o.z = h[4] | (h[5] << 16); o.w = h[6] | (h[7] << 16);
            *(GAS v4u*)(ut4 + ((((size_t)b * 256 + cb * 32 + cpl) * 64 + t2b * 8 + t2l) * 2 + cq) * 64 + t1b * 8) = o; }
    }
    if (l == 0) {
        LAS bf16* tl = (LAS bf16*)F.lds;
        for (int j = F.bid; j < 256; j += F.G) {
            const int b = j >> 5, tb = (j >> 3) & 3, cb = j & 7; const size_t rowbase = (size_t)NL + b * 256 + tb * 64; bf16* dst = utc + (size_t)b * 512 * 256;
            __syncthreads();
            { const int t = F.tid >> 3, c8 = (F.tid & 7) * 8; const v4u w = *(const GAS v4u*)(uf + (rowbase + t) * 512 + cb * 64 + c8);
              LAS unsigned* p = (LAS unsigned*)(tl + t * 72 + c8); p[0] = w.x; p[1] = w.y; p[2] = w.z; p[3] = w.w; }
            __syncthreads();
            { const int c = F.tid >> 3, t8 = (F.tid & 7) * 8; v4u o; unsigned h[8];
#pragma unroll
              for (int q = 0; q < 8; ++q) h[q] = tl[(t8 + q) * 72 + c];
              o.x = h[0] | (h[1] << 16); o.y = h[2] | (h[3] << 16); o.z = h[4] | (h[5] << 16); o.w = h[6] | (h[7] << 16);
              *(GAS v4u*)(dst + (size_t)(cb * 64 + c) * 256 + tb * 64 + t8) = o; }
        }
    }
    __syncthreads();
}
constexpr int SC_XRAW = 0, SC_U32 = 17408, SC_UBF = SC_U32 + 32768, SC_YT = SC_UBF + 16384, SC_CW = SC_YT + 16384;
__device__ __forceinline__ float fast_sigmoid(float x) { return __builtin_amdgcn_rcpf(1.f + __expf(-x)); }
template <int PASS, int DIAG = 0> __device__ __forceinline__ void p_scan_fast(Frame& F, int l, int cvbase) {
    LAS unsigned char* lds = F.lds;
    const int tid = F.tid, lane = F.lane, w = F.wave, fr = lane & 15, fq = lane >> 4;
    const bf16* urnn = (const bf16*)(F.ws + WS_RB); const bf16* gate = (const bf16*)(F.ws + WS_RC); bf16* yout = (bf16*)(F.ws + WS_RA);
    float* SUM = (float*)(F.ws + WS_SUM); const float* CIN = (const float*)(F.ws + WS_CIN);
    const int h = F.bid & 7, qi = F.bid >> 3, nq = (F.G - h + 7) >> 3;
    bf16x8 bw[4][4];
    float bia[4];
#pragma unroll
    for (int ty = 0; ty < 4; ++ty) { const int d = ty >> 1;
#pragma unroll
        for (int ks = 0; ks < 4; ++ks)
            bw[ty][ks] = __builtin_bit_cast(bf16x8, *(const GAS v4u*)(F.ws + WS_GW + ((((((size_t)(l * 2 + d) * 8 + h) * 2 + (ty & 1)) * 4 + ks) * 8 + w) * 64 + lane) * 16));
        bia[ty] = F.kin[(ty & 1) ? 13 : 11][((size_t)(l * 2 + d) * 8 + h) * 128 + 16 * w + fr] * -1.4426950408889634f; }
    const float n8f = ((const float*)(F.ws + WS_MODS + 512 * 1024))[(size_t)(l * 2 + 0) * 1024 + h * 128 + 16 * w + fr];
    const float n8b = ((const float*)(F.ws + WS_MODS + 512 * 1024))[(size_t)(l * 2 + 1) * 1024 + h * 128 + 16 * w + fr];
    { LAS float* CW = (LAS float*)(lds + SC_CW);
      for (int o = tid; o < 5 * 128; o += NTHR) CW[o] = o < 512 ? F.kin[8][(size_t)l * 4 * D + (size_t)(o >> 7) * D + h * 128 + (o & 127)] : F.kin[9][(size_t)l * D + h * 128 + (o & 127)]; }
    float cwa[4] = {0.f, 0.f, 0.f, 0.f}, cwb[4] = {0.f, 0.f, 0.f, 0.f}, cba = 0.f, cbb = 0.f;
    if (PASS == 1) { __syncthreads(); const LAS float* CWr = (const LAS float*)(lds + SC_CW);
#pragma unroll
        for (int k = 0; k < 4; ++k) { cwa[k] = CWr[k * 128 + 2 * lane]; cwb[k] = CWr[k * 128 + 2 * lane + 1]; }
        cba = CWr[512 + 2 * lane]; cbb = CWr[512 + 2 * lane + 1]; }
    v4u raw[3];
#define SC_RAW_GEOM(PI) const int b_ = skipctx ? ((PI) >> 6) : (PI) / 68, j_ = skipctx ? 4 + ((PI) & 63) : (PI) % 68; const bool ic_ = j_ < 4; \
        const size_t r0_ = ic_ ? (size_t)NL + b_ * 256 + j_ * 64 : (size_t)b_ * 4096 + (size_t)(j_ - 4) * 64
#define SC_RAW_OK(q3) const int p_ = tid + (q3) * 512, rr_ = p_ >> 4, c16_ = p_ & 15, tt_ = rr_ - 2; bool ok_ = p_ < 68 * 16; \
        if (ic_) { const int g_ = j_ * 64 + tt_; ok_ = ok_ && g_ >= 0 && g_ < 256; } else ok_ = ok_ && tt_ >= 0 && tt_ < 64
#define SC_LOAD_RAW(PI) do { SC_RAW_GEOM(PI); _Pragma("unroll") for (int q3 = 0; q3 < 3; ++q3) { SC_RAW_OK(q3); raw[q3] = __builtin_nontemporal_load((const GAS v4u*)(urnn + (r0_ + (ok_ ? tt_ : 0)) * D + h * 128 + c16_ * 8)); } } while (0)
#define SC_WRITE_RAW(PI) do { SC_RAW_GEOM(PI); (void)r0_; _Pragma("unroll") for (int q3 = 0; q3 < 3; ++q3) { SC_RAW_OK(q3); (void)c16_; v4u v_ = raw[q3]; if (q3 != 1) { v_.x = ok_ ? v_.x : 0u; v_.y = ok_ ? v_.y : 0u; v_.z = ok_ ? v_.z : 0u; v_.w = ok_ ? v_.w : 0u; }     \
        if (p_ < 68 * 16) *(LAS v4u*)(lds + SC_XRAW + (p_ >> 4) * 256 + (p_ & 15) * 16) = v_; } } while (0)
    const bool skipctx = PASS == 2 && l == 1;
    const int npair = skipctx ? 512 : 544;
    constexpr int CV_PER_LAYER = 16 * 3 * 1024; LAS unsigned char* cvs = lds + 90112 + w * 4096; int cv_id = -1, cv_iter = 0;
#define CV_GEOM(ID) const int cl_ = (ID) / CV_PER_LAYER, cw_ = (ID) - cl_ * CV_PER_LAYER, ce_ = cw_ / 3072, cr_ = cw_ - ce_ * 3072, cm_ = cr_ >> 10, ckb_ = (cr_ >> 5) & 31, cnb_ = cr_ & 31
#define CV_ISSUE() do { const int id_ = cvbase + (cv_iter * F.G + F.bid) * NWAVES + w; ++cv_iter; cv_id = (cvbase >= 0 && id_ < 2 * CV_PER_LAYER) ? id_ : -1; \
        if (cv_id >= 0) { CV_GEOM(cv_id); const char* src_ = (const char*)(F.kin[21 + cm_] + ((size_t)(cl_ * 16 + ce_) * D + ckb_ * 32) * D + cnb_ * 32); \
            asm volatile("s_waitcnt lgkmcnt(0)" ::: "memory"); \
            _Pragma("unroll") for (int i_ = 0; i_ < 4; ++i_) __builtin_amdgcn_global_load_lds((const unsigned*)(src_ + (size_t)(8 * i_) * D * 4 + (unsigned)((lane >> 3) * D * 4 + (lane & 7) * 16)), (LAS unsigned*)(cvs + i_ * 1024), 16, 0, 2); } } while (0)
#define CV_CONSUME() do { if (cv_id >= 0) { CV_GEOM(cv_id); asm volatile("s_waitcnt vmcnt(0)" ::: "memory"); const int n_ = lane & 31, kq_ = lane >> 5; float t_[16]; \
            _Pragma("unroll") for (int j_ = 0; j_ < 16; j_ += 2) { const f32x2 tp_ = (f32x2){*(const LAS float*)(cvs + (kq_ * 16 + j_) * 128 + n_ * 4), *(const LAS float*)(cvs + (kq_ * 16 + j_ + 1) * 128 + n_ * 4)} * MOE_WS; t_[j_] = tp_.x; t_[j_ + 1] = tp_.y; } \
            const int n0_ = cnb_ * 32, drow_ = cm_ == 2 ? n0_ : ((n0_ >> 7) * 256 + (cm_ == 1 ? 128 : 0) + (n0_ & 127)); \
            unsigned char* dst_ = (unsigned char*)F.out + (size_t)cl_ * 16 * 3 * D * D + (size_t)ce_ * 3 * D * D + (cm_ == 2 ? (size_t)2 * D * D : 0) + (size_t)(drow_ + n_) * D + ckb_ * 32 + kq_ * 16; \
            *(GAS v4u*)dst_ = (v4u){pk4_fp8(t_[0], t_[1], t_[2], t_[3]), pk4_fp8(t_[4], t_[5], t_[6], t_[7]), pk4_fp8(t_[8], t_[9], t_[10], t_[11]), pk4_fp8(t_[12], t_[13], t_[14], t_[15])}; cv_id = -1; } } while (0)
    v4u uc0 = (v4u){0u, 0u, 0u, 0u}, uc1 = uc0;
#define SC_LOAD_U(PI) do { SC_RAW_GEOM(PI); (void)ic_; const bf16* up_ = yout + (r0_ + (tid >> 3)) * D + h * 128 + (tid & 7) * 16; uc0 = *(const GAS v4u*)up_; uc1 = *(const GAS v4u*)(up_ + 8); } while (0)
    __builtin_amdgcn_sched_barrier(0);
    if (PASS == 1) { if (qi < npair) { SC_LOAD_RAW(qi); SC_WRITE_RAW(qi); { const int n1_ = qi + nq < npair ? qi + nq : qi; SC_LOAD_RAW(n1_); } } }
    else if (qi < npair) SC_LOAD_U(qi);
    if (w < 4) __builtin_amdgcn_s_setprio(2);
    for (int pi = qi; pi < npair; pi += nq) {
        const int b = skipctx ? (pi >> 6) : pi / 68, j = skipctx ? 4 + (pi & 63) : pi % 68;
        const bool isctx = j < 4; const size_t row0 = isctx ? (size_t)NL + b * 256 + j * 64 : (size_t)b * 4096 + (size_t)(j - 4) * 64;
        __syncthreads();
        v4u gt0 = (v4u){0u, 0u, 0u, 0u}, gt1 = gt0; float cinf = 0.f, cinb = 0.f;
        if (PASS == 2) {
            cinf = CIN[(((size_t)b * 2 + 0) * 68 + j) * 1024 + h * 128 + 16 * w + fr]; cinb = CIN[(((size_t)b * 2 + 1) * 68 + j) * 1024 + h * 128 + 16 * w + fr]; }
        if constexpr (!(DIAG & 8)) {
        if constexpr (PASS == 1) {
          unsigned xr[11];
#pragma unroll
          for (int r = 0; r < 11; ++r) xr[r] = *(const LAS unsigned*)(lds + SC_XRAW + (8 * w + r) * 256 + lane * 4);
          asm volatile("s_waitcnt lgkmcnt(0)" ::: "memory"); __builtin_amdgcn_sched_barrier(0);
          const int g = lane >> 3, cl = (2 * lane) & 15, slot = lane >> 2;
#pragma unroll
          for (int tt = 0; tt < 8; ++tt) { const int t = 8 * w + tt; float u0 = cba, u1 = cbb;
#pragma unroll
              for (int k = 0; k < 4; ++k) { u0 += cwa[k] * bflo(xr[tt + k]); u1 += cwb[k] * bfhi(xr[tt + k]); }
              *(LAS f32x2*)(lds + SC_U32 + t * 512 + ((g ^ ((t >> 4) & 3)) * 16 + cl) * 4) = (f32x2){u0, u1};
              const int ft = (t & 3) | (((t >> 4) & 3) << 2);
              *(LAS unsigned*)(lds + SC_UBF + t * 256 + ((slot ^ ft) << 4) + (lane & 3) * 4) = pk2(u0, u1); }
        } else
        { const int t = tid >> 3, cg = tid & 7; const LAS float* CW = (const LAS float*)(lds + SC_CW); float u[16];
          if constexpr (PASS == 2) { (void)CW; unpack8(uc0, u); unpack8(uc1, u + 8); } else {
#if SC_CONV_BATCH
#pragma unroll
          for (int hh = 0; hh < 2; ++hh) { v4u xr[4]; f32x4 cwv[5][2];
#pragma unroll
              for (int k = 0; k < 4; ++k) xr[k] = *(const LAS v4u*)(lds + SC_XRAW + (t + k) * 256 + cg * 32 + hh * 16);
#pragma unroll
              for (int k = 0; k < 5; ++k) { cwv[k][0] = *(const LAS f32x4*)(CW + k * 128 + cg * 16 + hh * 8); cwv[k][1] = *(const LAS f32x4*)(CW + k * 128 + cg * 16 + hh * 8 + 4); }
              asm volatile("s_waitcnt lgkmcnt(0)" ::: "memory"); __builtin_amdgcn_sched_barrier(0);
#pragma unroll
              for (int q = 0; q < 8; ++q) u[hh * 8 + q] = cwv[4][q >> 2][q & 3];
#pragma unroll
              for (int k = 0; k < 4; ++k) { float x[8]; unpack8(xr[k], x);
#pragma unroll
                  for (int q = 0; q < 8; ++q) u[hh * 8 + q] += cwv[k][q >> 2][q & 3] * x[q]; }
              __builtin_amdgcn_sched_barrier(0); }
#else
#pragma unroll
          for (int q = 0; q < 16; ++q) u[q] = CW[512 + cg * 16 + q];
#pragma unroll
          for (int k = 0; k < 4; ++k) { float x[16]; unpack8(*(const LAS v4u*)(lds + SC_XRAW + (t + k) * 256 + cg * 32), x); unpack8(*(const LAS v4u*)(lds + SC_XRAW + (t + k) * 256 + cg * 32 + 16), x + 8);
#pragma unroll
              for (int q = 0; q < 16; ++q) u[q] += CW[k * 128 + cg * 16 + q] * x[q]; }
#endif
          }
#pragma unroll
          for (int q = 0; q < 4; ++q) *(LAS f32x4*)(lds + SC_U32 + t * 512 + (cg ^ ((t >> 4) & 3)) * 64 + q * 16) = (f32x4){u[4 * q], u[4 * q + 1], u[4 * q + 2], u[4 * q + 3]};
          const int ft = (t & 3) | (((t >> 4) & 3) << 2); const v4u ub0 = PASS == 2 ? uc0 : pack8(u), ub1 = PASS == 2 ? uc1 : pack8(u + 8);
          *(LAS v4u*)(lds + SC_UBF + t * 256 + (((cg * 2) ^ ft) << 4)) = ub0; *(LAS v4u*)(lds + SC_UBF + t * 256 + (((cg * 2 + 1) ^ ft) << 4)) = ub1;
          } }
        __syncthreads();
        if constexpr (PASS == 1) { const int t = tid >> 3, cg = tid & 7, ft = (t & 3) | (((t >> 4) & 3) << 2);
            bf16* up = yout + (row0 + t) * D + h * 128 + cg * 16; *(GAS v4u*)up = *(const LAS v4u*)(lds + SC_UBF + t * 256 + (((cg * 2) ^ ft) << 4)); *(GAS v4u*)(up + 8) = *(const LAS v4u*)(lds + SC_UBF + t * 256 + (((cg * 2 + 1) ^ ft) << 4)); }
        if (PASS == 2) asm volatile("" : "+v"(cinf), "+v"(cinb));
        if constexpr (PASS == 1) { const int n1_ = pi + nq < npair ? pi + nq : pi; SC_WRITE_RAW(n1_); }
        CV_CONSUME();
        if constexpr (PASS == 1) { const int n2_ = pi + 2 * nq < npair ? pi + 2 * nq : pi; SC_LOAD_RAW(n2_); }
        else { const int n1_ = pi + nq < npair ? pi + nq : pi; SC_LOAD_U(n1_); }
        CV_ISSUE();
        const int c = 16 * w + fr;
        float hs[16], uu[16];
#pragma unroll
        for (int d = 0; d < 2; ++d) {
            f32x4 acc[2][4];
#pragma unroll
            for (int ty = 0; ty < 2; ++ty)
#pragma unroll
                for (int m = 0; m < 4; ++m) acc[ty][m] = (f32x4){bia[2 * d + ty], bia[2 * d + ty], bia[2 * d + ty], bia[2 * d + ty]};
            if (PASS == 2 && d == 1) { __builtin_amdgcn_sched_barrier(0); const bf16* gp = gate + (row0 + (tid >> 3)) * D + h * 128 + (tid & 7) * 16; gt0 = *(const GAS v4u*)gp; gt1 = *(const GAS v4u*)(gp + 8); }
            if (d == 0) {
#pragma unroll
                for (int q = 0; q < 16; ++q) uu[q] = *(const LAS float*)(lds + SC_U32 + (16 * fq + q) * 512 + ((w ^ fq) * 16 + fr) * 4); }
            bf16x8 af[4][4];
#define SC_MF(M) do { if constexpr (!(DIAG & 4)) { _Pragma("unroll") for (int ks = 0; ks < 4; ++ks) { acc[0][M] = __builtin_amdgcn_mfma_f32_16x16x32_bf16(af[M][ks], bw[2 * d][ks], acc[0][M], 0, 0, 0); \
                acc[1][M] = __builtin_amdgcn_mfma_f32_16x16x32_bf16(af[M][ks], bw[2 * d + 1][ks], acc[1][M], 0, 0, 0); } } } while (0)
            if constexpr (!(DIAG & 4))
            {
#pragma unroll
              for (int m = 0; m < 4; ++m) { const int tau = 16 * (fr >> 2) + 4 * m + (fr & 3);
#pragma unroll
                  for (int ks = 0; ks < 4; ++ks) af[m][ks] = *(const LAS bf16x8*)(lds + SC_UBF + tau * 256 + (((4 * ks + fq) ^ fr) << 4)); }
              asm volatile("s_waitcnt lgkmcnt(0)" ::: "memory"); __builtin_amdgcn_sched_barrier(0);
              SC_MF(0); SC_MF(1);
              __builtin_amdgcn_sched_barrier(0); }
            float av[16], bv[16]; const float n8 = d ? n8b : n8f, b_a = bia[2 * d], b_x = bia[2 * d + 1];
            typedef float f32x2 __attribute__((ext_vector_type(2)));
            const float nl2 = -1.4426950408889634f, n8l2 = n8 * 1.4426950408889634f, n82 = 2.f * n8; (void)b_a; (void)b_x;
            if constexpr (DIAG & 2) {
#pragma unroll
                for (int q = 0; q < 16; ++q) { av[q] = acc[0][q >> 2][q & 3] * n8l2 + nl2; bv[q] = acc[1][q >> 2][q & 3] * uu[q] + n82; }
            } else {
#pragma unroll
            for (int p2 = 0; p2 < 8; ++p2) { const int q0 = 2 * p2, q1 = q0 + 1;
                if (p2 == 0) SC_MF(2); else if (p2 == 2) SC_MF(3);
                const f32x2 ta = (f32x2){acc[0][q0 >> 2][q0 & 3], acc[0][q1 >> 2][q1 & 3]}, tx = (f32x2){acc[1][q0 >> 2][q0 & 3], acc[1][q1 >> 2][q1 & 3]};
                const f32x2 da = (f32x2){__builtin_amdgcn_exp2f(ta.x), __builtin_amdgcn_exp2f(ta.y)} + 1.f, dx = (f32x2){__builtin_amdgcn_exp2f(tx.x), __builtin_amdgcn_exp2f(tx.y)} + 1.f;
                const f32x2 r = (f32x2){__builtin_amdgcn_rcpf(da.x), __builtin_amdgcn_rcpf(da.y)}, ig = (f32x2){__builtin_amdgcn_rcpf(dx.x), __builtin_amdgcn_rcpf(dx.y)};
                const f32x2 l2 = r * n8l2; const f32x2 a = (f32x2){__builtin_amdgcn_exp2f(l2.x), __builtin_amdgcn_exp2f(l2.y)};
                const f32x2 om = 1.f - a * a;
                const f32x2 bb = (f32x2){__builtin_amdgcn_sqrtf(__builtin_fabsf(om.x)), __builtin_amdgcn_sqrtf(__builtin_fabsf(om.y))} * (ig * (f32x2){uu[q0], uu[q1]});
                av[q0] = a.x; av[q1] = a.y; bv[q0] = bb.x; bv[q1] = bb.y;
                if (p2 & 1) { __builtin_amdgcn_sched_barrier(0x6); } }
            }
            float P = 1.f, H = 0.f;
#pragma unroll
            for (int q = 0; q < 16; ++q) { const int t = d ? 15 - q : q; H = av[t] * H + bv[t]; P *= av[t]; }
            float Ps[4], Hs[4];
#pragma unroll
            for (int sgi = 0; sgi < 4; ++sgi) { Ps[sgi] = __builtin_bit_cast(float, __builtin_amdgcn_ds_bpermute(((sgi << 4) | fr) << 2, __builtin_bit_cast(int, P)));
                                              Hs[sgi] = __builtin_bit_cast(float, __builtin_amdgcn_ds_bpermute(((sgi << 4) | fr) << 2, __builtin_bit_cast(int, H))); }
            if (PASS == 1) {
                float Pt = 1.f, Ht = 0.f;
#pragma unroll
                for (int q = 0; q < 4; ++q) { const int sgi = d ? 3 - q : q; Ht = Ps[sgi] * Ht + Hs[sgi]; Pt *= Ps[sgi]; }
                if (fq == 0) { float* dst = SUM + ((((size_t)b * 2 + d) * 68 + j) * 2) * 1024 + h * 128 + c; dst[0] = Pt; dst[1024] = Ht; }
            } else {
                float cin = d ? cinb : cinf;
#pragma unroll
                for (int q = 0; q < 3; ++q) { const int sgi = d ? 3 - q : q; const bool before = d ? (sgi > fq) : (sgi < fq); if (before) cin = Ps[sgi] * cin + Hs[sgi]; }
                float hh = cin;
#pragma unroll
                for (int q = 0; q < 16; ++q) { const int t = d ? 15 - q : q; hh = av[t] * hh + bv[t]; if (d == 0) hs[t] = hh; else hs[t] += hh; }
            }
        }
        if constexpr (PASS == 2 && (DIAG & 1)) {
#pragma unroll
            for (int q = 0; q < 16; ++q) asm volatile("" :: "v"(hs[q]));
            asm volatile("" :: "v"(gt0), "v"(gt1));
        } else
        if (PASS == 2) {
#pragma unroll
            for (int q = 0; q < 16; q += 2) { const unsigned p_ = pk2(hs[q], hs[q + 1]);
                *(LAS bf16*)(lds + SC_YT + (16 * fq + q) * 256 + ((w ^ fq) * 16 + fr) * 2) = (bf16)p_; *(LAS bf16*)(lds + SC_YT + (16 * fq + q + 1) * 256 + ((w ^ fq) * 16 + fr) * 2) = (bf16)(p_ >> 16); }
            __syncthreads();
            { const int t = tid >> 3, cg = tid & 7; float yv[16], gv[16];
              unpack8(*(const LAS v4u*)(lds + SC_YT + t * 256 + (cg ^ ((t >> 4) & 3)) * 32), yv); unpack8(*(const LAS v4u*)(lds + SC_YT + t * 256 + (cg ^ ((t >> 4) & 3)) * 32 + 16), yv + 8);
              unpack8(gt0, gv); unpack8(gt1, gv + 8);
#pragma unroll
              for (int q = 0; q < 16; ++q) yv[q] *= gv[q];
              bf16* yp = yout + (row0 + t) * D + h * 128 + cg * 16; *(GAS v4u*)yp = pack8(yv); *(GAS v4u*)(yp + 8) = pack8(yv + 8); }
        }
    }
    __builtin_amdgcn_s_setprio(0);
    CV_CONSUME();
#undef SC_MF
#undef CV_GEOM
#undef CV_ISSUE
#undef CV_CONSUME
#undef SC_LOAD_U
#undef SC_LOAD_RAW
#undef SC_WRITE_RAW
#undef SC_RAW_GEOM
#undef SC_RAW_OK
    __syncthreads();
}
__device__ __forceinline__ void p_scan_carry(Frame& F) {
    const float* SUM = (const float*)(F.ws + WS_SUM); float* CIN = (float*)(F.ws + WS_CIN);
    for (int g = F.bid * NTHR + F.tid; g < 8 * 2 * 1024; g += F.G * NTHR) {
        const int b = g >> 11, d = (g >> 10) & 1, ch = g & 1023; float cst = 0.f;
        const float* sp = SUM + (((size_t)b * 2 + d) * 68) * 2 * 1024 + ch; float* cp = CIN + (((size_t)b * 2 + d) * 68) * 1024 + ch;
#pragma unroll 17
        for (int step = 0; step < 68; ++step) { const int j = d == 0 ? step : (step < 4 ? 3 - step : 71 - step);
            const float P = sp[(size_t)j * 2048], H = sp[(size_t)j * 2048 + 1024]; cp[(size_t)j * 1024] = cst; cst = P * cst + H; }
    }
}

__device__ __forceinline__ size_t moe_w_off(int l) { return l == 0 ? WS_CSL : WS_MOEW; }
__device__ __forceinline__ void p_moe_wconv(Frame& F, int l, int wg0) {
    __syncthreads();
    if (F.bid >= wg0)
    { const int gw = (F.bid - wg0) * NWAVES + F.wave, NGW = (F.G - wg0) * NWAVES; LAS float* scr = (LAS float*)(F.lds + F.wave * 16384);
      unsigned char* mw = F.ws + moe_w_off(l);
      for (int it = gw; it < 16 * 3 * 512; it += NGW) { const int e = it / 1536, rem = it % 1536, m = rem / 512, q = rem % 512, kb = q >> 5, nb = q & 31;
          const float* W = F.kin[m == 0 ? 21 : m == 1 ? 22 : 23] + ((size_t)l * 16 + e) * D * D; unsigned char* dst = mw + (size_t)e * 3 * D * D + (m == 2 ? (size_t)2 * D * D : 0);
          const int n0 = nb * 32; const int drow = m == 2 ? n0 : ((n0 >> 7) * 256 + (m == 1 ? 128 : 0) + (n0 & 127));
          transpose_item<1>(W, D, D, (bf16*)dst, kb * 64, n0, drow, scr, F.lane); } }
}
__device__ __forceinline__ void moe_table(Frame& F, int l, LAS int* ts, LAS int* cn) {
    __syncthreads();
    if (F.tid < 16) cn[F.tid] = (int)__hip_atomic_load(F.ctl + CW_CNT + 64 * l + F.tid, __ATOMIC_RELAXED, __HIP_MEMORY_SCOPE_AGENT);
    __syncthreads();
    if (F.tid == 0) { int acc = 0;
        for (int e = 0; e < 16; ++e) { ts[e] = acc; acc += (cn[e] + 255) >> 8; }
        ts[16] = acc; }
    __syncthreads();
}

constexpr int NPH = 24;
struct Args { const float* in[25]; float* out; unsigned char* ws; int ph_lo, ph_hi; };
__global__ void __launch_bounds__(NTHR, 2) fwd_kernel(Args args) {
    extern __shared__ __attribute__((aligned(16))) unsigned char lds[];
    Frame F;
    F.lds = (LAS unsigned char*)lds; F.tid = threadIdx.x; F.lane = F.tid & 63; F.wave = __builtin_amdgcn_readfirstlane(F.tid >> 6);
    F.G = gridDim.x; F.bid = blockIdx.x; F.ws = args.ws; F.out = args.out; F.ctl = (unsigned*)(args.ws + WS_CTL);
    F.kin = (const float* const __attribute__((address_space(4)))*)__builtin_amdgcn_kernarg_segment_ptr();
    volatile LAS unsigned* MISC = (volatile LAS unsigned*)(F.lds + MISC_OFF);
    if (F.tid < 32) MISC[F.tid] = 0u;
    __syncthreads();
    XcdBarrier bar; bar.bar = F.ctl + CW_BAR; bar.x = 0; bar.st = nullptr;
    if (MK_N_LAUNCHES == 1) bar = xcd_barrier_post(F.ctl + CW_BAR, MISC + 8);
    LAS int* ts = (LAS int*)(F.lds + MISC_OFF + 256); LAS int* cn = ts + 32;
    const int lo = args.ph_lo, hi = args.ph_hi;
#ifndef SITE_MASK
#define SITE_MASK 0xfffffu
#endif
#define SITE(j) (((SITE_MASK) >> (j)) & 1u)
#ifndef REP_MASK
#define REP_MASK 0u
#endif
#define IN(k) (lo <= (k) && (k) < hi)
#define LAUNDER() do { asm volatile("v_mbcnt_lo_u32_b32 %0, -1, 0\n\tv_mbcnt_hi_u32_b32 %0, -1, %0" : "=v"(F.lane)); asm volatile("" : "+s"(F.ws), "+s"(F.out), "+s"(F.kin), "+s"(F.ctl), "+s"(F.lds), "+s"(F.wave), "+s"(F.bid), "+s"(F.G), "+v"(F.lane)); F.tid = F.wave * 64 + F.lane; } while (0)
#define TWICE(j, stmt) do { stmt; if (((REP_MASK) >> (j)) & 1u) { __syncthreads(); LAUNDER(); stmt; } } while (0)
#define SEAM(k) do { if (MK_N_LAUNCHES == 1 && IN((k) + 1)) xcd_barrier(bar); } while (0)

    if (SITE(0) && IN(0)) { LAUNDER(); TWICE(0, p_prologue(F)); SEAM(0); }
    for (int l = 0; l < 2; ++l) {
        const int pb = 1 + 11 * l;
        if (SITE(1) && IN(pb + 0)) { LAUNDER(); if (l == 0) p_rows<0, true>(F, 0); else p_rows<0, false>(F, 1); SEAM(pb + 0); }
        if (SITE(2) && IN(pb + 1)) { LAUNDER();
            PInproj p; p.G = F.G; p.c = F.bid; p.l = l; p.hx = (const bf16*)(F.ws + WS_RA); p.wt = (const bf16*)(F.ws + WS_WIN) + (size_t)l * INW * D;
            p.urnn = (bf16*)(F.ws + WS_RB); p.gate = (bf16*)(F.ws + WS_RC);
#ifdef STAGGER_US
            { const unsigned long long t0 = __builtin_amdgcn_s_memrealtime(); const unsigned dl = (unsigned)(F.bid & 3) * (STAGGER_US * 100u); while (__builtin_amdgcn_s_memrealtime() - t0 < dl) __builtin_amdgcn_s_sleep(8); }
#endif
            TWICE(2, fast_gemm_phase(F, p));
            LAUNDER();
            PFourT ft; ft.G = F.G; ft.c = F.bid; ft.l = l; ft.rot = p.count() % F.G; ft.hx = F.ws + WS_CSL; ft.wt = F.ws + WS_WIN + ((size_t)l * INW * D + (size_t)2048 * D) * 2; ft.ut4 = (bf16*)(F.ws + WS_RG); ft.utc = (bf16*)(F.ws + WS_UTC);
            fast_gemm_phase(F, ft);
            LAUNDER();
            PInproj8 q; q.G = F.G; q.c = F.bid; q.npan = l == 1 ? NL / 256 : NPAN; q.rot = (p.count() + ft.count()) % F.G; q.hx8 = F.ws + WS_CSL; q.wt8 = F.ws + WS_WIN + ((size_t)l * INW * D + (size_t)2560 * D) * 2;
            q.sgr = F.ws + WS_RD; q.sgf = F.ws + WS_RE;
            TWICE(2, fast_gemm_phase(F, q));
            if (l == 0) {
                for (int g = F.bid * NTHR + F.tid; g < (1 << 17); g += F.G * NTHR) {
                    const int lane_ = g & 63, w_ = (g >> 6) & 7, ks_ = (g >> 9) & 3, t1_ = (g >> 11) & 1, h_ = (g >> 12) & 7, ld_ = g >> 15;
                    const float* Wg = F.kin[t1_ ? 12 : 10] + ((size_t)ld_ * 8 + h_) * 128 * 128 + (size_t)(32 * ks_ + 8 * (lane_ >> 4)) * 128 + 16 * w_ + (lane_ & 15); float t8[8];
#pragma unroll
                    for (int q = 0; q < 8; ++q) t8[q] = *(const GAS float*)(Wg + q * 128) * -1.4426950408889634f;
                    *(GAS v4u*)(F.ws + WS_GW + (size_t)g * 16) = pack8(t8); } }
            if (l == 0) { LAUNDER(); PFold f; f.first = F.G - 32; f.c = F.bid; f.wft = (const bf16*)(F.ws + WS_LRU); f.fb = (const bf16*)(F.ws + WS_CSC + 768 * 1024); f.wf = (bf16*)(F.ws + WS_WF); fast_gemm_phase(F, f); }
            SEAM(pb + 1); }
        if (SITE(3) && IN(pb + 2)) { LAUNDER(); TWICE(3, p_scan_fast<1>(F, l, (2 * l) * 34816)); SEAM(pb + 2); }
        if (SITE(4) && IN(pb + 3)) { LAUNDER(); TWICE(4, p_scan_carry(F)); LAUNDER();
            PFftA p; p.G = F.G; p.c = F.bid; p.fa = (const bf16*)(F.ws + WS_CSC + 256 * 1024); p.ut4 = (const bf16*)(F.ws + WS_RG); p.zt = F.ws + WS_CSL;
            fast_gemm_phase(F, p); SEAM(pb + 3); }
        if (SITE(5) && IN(pb + 4)) { LAUNDER();
#ifndef ONLY_SCAN2
            { PFftC p; p.G = F.G; p.c = F.bid; p.fc = F.ws + WS_CSC + 512 * 1024; p.zt = F.ws + WS_CSL; p.g = (bf16*)(F.ws + WS_RH);
              TWICE(5, fast_gemm_phase(F, p)); }
            if (l == 0) { LAUNDER();
              PDft p; p.G = F.G; p.c = F.bid; p.csc = (const bf16*)(F.ws + WS_CSC); p.ut = (const bf16*)(F.ws + WS_UTC); p.g = (bf16*)(F.ws + WS_RH);
              fast_gemm_phase(F, p); }
#endif
            LAUNDER(); TWICE(6, p_scan_fast<2>(F, l, (2 * l + 1) * 34816));
#ifdef REP6_N
            for (int rep_ = 0; rep_ < REP6_N; ++rep_) { __syncthreads(); LAUNDER(); p_scan_fast<2, REP6_DIAG>(F, l, -1); }
#endif
            SEAM(pb + 5); }
        if (SITE(7) && IN(pb + 6)) { LAUNDER();
            PMerge p; p.G = F.G; p.c = F.bid; p.npan = l == 1 ? NL / 256 : NPAN;     p.gm = F.ws + WS_RH; p.y = (const bf16*)(F.ws + WS_RA); p.wf = F.ws + WS_WF + (size_t)l * D * D; p.wr = (const bf16*)(F.ws + WS_WR) + (size_t)l * D * D;
            p.sgr = F.ws + WS_RD; p.sgf = F.ws + WS_RE; p.mg = (bf16*)(F.ws + WS_RC);
            TWICE(7, fast_gemm_phase(F, p));
            SEAM(pb + 6); }
        if (SITE(8) && IN(pb + 7)) { LAUNDER();
            PWout p; p.G = F.G; p.c = F.bid; p.npan = l == 1 ? NL / 256 : NPAN; p.mg = (const bf16*)(F.ws + WS_RC); p.wo = (const bf16*)(F.ws + WS_WO) + (size_t)l * D * D;
            p.l = l; p.xold_l = F.kin[0]; p.xold_c = F.kin[2]; p.xs = (bf16*)(F.ws + WS_XS); p.g1 = modp(F, l, 0, 2);
            TWICE(8, fast_gemm_phase(F, p)); SEAM(pb + 7); }
        if (SITE(9) && IN(pb + 8)) { LAUNDER(); p_rows<1>(F, l); if ((REP_MASK >> 13) & 1u) { __syncthreads(); LAUNDER(); p_rows<1>(F, l, 1); } SEAM(pb + 8); }
        if (SITE(10) && IN(pb + 9)) { LAUNDER();
            moe_table(F, l, ts, cn);
            PMoe1 p; p.G = F.G; p.c = F.bid; p.hx2 = F.ws + WS_RA; p.w = (const unsigned char*)F.out + (size_t)l * 16 * 3 * D * D; p.list = (const int2*)(F.ws + WS_LIST); p.he = F.ws + WS_HE; p.ts = ts; p.cn = cn;
            TWICE(10, fast_gemm_phase(F, p)); SEAM(pb + 9); }
        if (SITE(11) && IN(pb + 10)) { LAUNDER();
            PMoe2 p; p.G = F.G; p.c = F.bid; p.he = F.ws + WS_HE; p.w = (const unsigned char*)F.out + (size_t)l * 16 * 3 * D * D; p.list = (const int2*)(F.ws + WS_LIST); p.c01 = F.ws + WS_C01; p.ts = ts; p.cn = cn; p.lbuf = F.lds + MISC_OFF + 1024;
            TWICE(11, fast_gemm_phase(F, p)); SEAM(pb + 10); }
    }
    if (SITE(12) && IN(23)) { LAUNDER(); p_rows<2>(F, 1); }
#undef IN
#undef SEAM
}

extern "C" void kernel_launch(void* const* d_in, const int* in_sizes, int n_in, void* d_out, int out_size, void* d_ws, size_t ws_size, hipStream_t stream) {
    static int grid = 0;
    if (grid == 0) {
        if (n_in != 25 || out_size != NL * D || ws_size < WS_END2) { fprintf(stderr, "kernel_launch: unexpected shapes (n_in %d, out %d, ws %zu)\n", n_in, out_size, ws_size); grid = -1; return; }
        int dev = 0, cus = 0, per_cu = 0;
        if (hipGetDevice(&dev) != hipSuccess || hipDeviceGetAttribute(&cus, hipDeviceAttributeMultiprocessorCount, dev) != hipSuccess) { grid = -1; return; }
        if (hipFuncSetAttribute((const void*)fwd_kernel, hipFuncAttributeMaxDynamicSharedMemorySize, LDS_BYTES) != hipSuccess) { fprintf(stderr, "kernel_launch: hipFuncSetAttribute failed\n"); grid = -1; return; }
        if (hipOccupancyMaxActiveBlocksPerMultiprocessor(&per_cu, (const void*)fwd_kernel, NTHR, LDS_BYTES) != hipSuccess || per_cu < 1) { fprintf(stderr, "kernel_launch: occupancy query says %d\n", per_cu); }
        (void)hipGetLastError();
        grid = cus < 256 ? cus : 256;
    }
    if (grid < 0) return;
    (void)hipMemsetAsync((char*)d_ws + WS_CTL, 0, CTL_ZERO_BYTES, stream);
    Args a{};
    for (int i = 0; i < 25; ++i) a.in[i] = (const float*)d_in[i];
    a.out = (float*)d_out; a.ws = (unsigned char*)d_ws;
    if (MK_N_LAUNCHES == 1) { a.ph_lo = 0; a.ph_hi = NPH; hipLaunchKernelGGL(fwd_kernel, dim3(grid), dim3(NTHR), LDS_BYTES, stream, a); }
    else for (int p = 0; p < NPH; ++p) { a.ph_lo = p; a.ph_hi = p + 1; hipLaunchKernelGGL(fwd_kernel, dim3(grid), dim3(NTHR), LDS_BYTES, stream, a); }
}
```
